# Optimizing an MI355X kernel written in HIP

```python
import jax
import jax.numpy as jnp
from jax import lax
import numpy as np

D_MODEL = 1024
BATCH = 1
SEQ = 16384
DEPTH = 1

GRID_W = 64
CTX_LEN = 256
D_MIX = D_MODEL
D_MLSTM = D_MIX // 2
MLSTM_HEADS = 4
MLSTM_DH = D_MLSTM // MLSTM_HEADS
QKV_BLOCK = 4
N_QKV_BLOCKS = D_MLSTM // QKV_BLOCK
CONV_K = 3
CHUNK = 128
D_FOURIER = D_MIX - D_MLSTM
FOURIER_GROUPS = 4
FOURIER_CG = D_FOURIER // FOURIER_GROUPS
D_IN_PROJ = 2 * D_MLSTM + D_FOURIER
N_EXPERT_GROUPS = 4
EXPERTS_PER_GROUP = 4
N_EXPERTS = N_EXPERT_GROUPS * EXPERTS_PER_GROUP
TOP_K = 2
D_EXPERT = D_MODEL // 2
N_MOD = 6
EPS = 1e-6
POS_BASE = 10000.0
F32 = jnp.float32

kernel_name = 'hybrid_mlstm_fourier_hmoe_prefix_block'


def rmsnorm(x, g):
    x32 = x.astype(F32)
    y = x32 * lax.rsqrt(jnp.mean(x32 * x32, axis=-1, keepdims=True) + EPS)
    return (y * g.astype(F32)).astype(x.dtype)


def modulate(h, shift, scale):
    return h * (1 + scale) + shift


def sincos_2d(rows, cols):
    quarter = D_MODEL // 4
    freq = 1.0 / (POS_BASE ** (jnp.arange(quarter, dtype=F32) / quarter))
    r = jnp.arange(rows, dtype=F32)[:, None] * freq
    cl = jnp.arange(cols, dtype=F32)[:, None] * freq
    er = jnp.concatenate([jnp.sin(r), jnp.cos(r)], axis=-1)
    ec = jnp.concatenate([jnp.sin(cl), jnp.cos(cl)], axis=-1)
    half = D_MODEL // 2
    emb = jnp.concatenate([jnp.broadcast_to(er[:, None, :], (rows, cols, half)),
                           jnp.broadcast_to(ec[None, :, :], (rows, cols, half))], axis=-1)
    return emb.reshape(rows * cols, D_MODEL)


def short_conv(x, w, b):
    y = lax.conv_general_dilated(x, w[:, None, :], window_strides=(1,), padding='SAME',
                                 dimension_numbers=('NWC', 'WIO', 'NWC'),
                                 feature_group_count=x.shape[-1])
    return y + b


def headwise(x, w):
    y = jnp.einsum('btni,nio->btno', x.reshape(x.shape[:-1] + (N_QKV_BLOCKS, QKV_BLOCK)), w)
    return y.reshape(x.shape)


def to_heads(t):
    B, T, _ = t.shape
    return t.astype(F32).reshape(B, T, MLSTM_HEADS, MLSTM_DH).transpose(0, 2, 1, 3)


def flip_seq(t):
    return jnp.flip(t, axis=2)


def mixer_features(h, lp):
    proj = h @ lp['w_in']
    x_m = proj[..., :D_MLSTM]
    z = proj[..., D_MLSTM:2 * D_MLSTM]
    u = proj[..., 2 * D_MLSTM:]
    act = jax.nn.silu(short_conv(x_m, lp['conv_w'], lp['conv_b']))
    q = headwise(act, lp['w_q'])
    k = headwise(act, lp['w_k'])
    v = headwise(x_m, lp['w_v'])
    qkv = jnp.concatenate([q, k, v], axis=-1)

    def gates(w, b):
        g = (qkv @ w + b).astype(F32).transpose(0, 2, 1)
        return g[:, :MLSTM_HEADS], jax.nn.log_sigmoid(g[:, MLSTM_HEADS:])

    heads = (to_heads(q) * (MLSTM_DH ** -0.5), to_heads(k), to_heads(v))
    return heads, gates(lp['w_if_fwd'], lp['b_if_fwd']), gates(lp['w_if_bwd'], lp['b_if_bwd']), act, z, u


def mlstm_scan(k, v, ig, lf, state):
    B, H, T, DH = k.shape
    nc = T // CHUNK
    kc = k.reshape(B, H, nc, CHUNK, DH)
    vc = v.reshape(B, H, nc, CHUNK, DH)
    b = jnp.cumsum(lf.reshape(B, H, nc, CHUNK), axis=-1)
    btot = b[..., -1]
    a = btot[..., None] - b + ig.reshape(B, H, nc, CHUNK)
    amax = jnp.max(a, axis=-1)

    def step(carry, xs):
        C, n, m = carry
        k_, v_, a_, amax_, bt_ = xs
        m_new = jnp.maximum(bt_ + m, amax_)
        decay = jnp.exp(bt_ + m - m_new)
        kw = k_ * jnp.exp(a_ - m_new[..., None])[..., None]
        C_new = decay[..., None, None] * C + jnp.einsum('bhlk,bhlv->bhkv', kw, v_)
        n_new = decay[..., None] * n + jnp.sum(kw, axis=2)
        return (C_new, n_new, m_new), (C, n, m)

    xs = tuple(jnp.moveaxis(t, 2, 0) for t in (kc, vc, a, amax, btot))
    final, starts = lax.scan(step, state, xs)
    starts = tuple(jnp.moveaxis(s, 0, 2) for s in starts)
    return starts, final


def mlstm_out(q, k, v, ig, lf, starts):
    C0, n0, m0 = starts
    B, H, T, DH = q.shape
    nc = T // CHUNK
    qc = q.reshape(B, H, nc, CHUNK, DH)
    kc = k.reshape(B, H, nc, CHUNK, DH)
    vc = v.reshape(B, H, nc, CHUNK, DH)
    igc = ig.reshape(B, H, nc, CHUNK)
    b = jnp.cumsum(lf.reshape(B, H, nc, CHUNK), axis=-1)
    tri = jnp.tril(jnp.ones((CHUNK, CHUNK), dtype=bool))
    logd = jnp.where(tri, b[..., :, None] - b[..., None, :] + igc[..., None, :], -jnp.inf)
    m_inter = b + m0[..., None]
    m_t = jnp.maximum(m_inter, jnp.max(logd, axis=-1))
    w_inter = jnp.exp(m_inter - m_t)
    s = jnp.einsum('bhctd,bhcsd->bhcts', qc, kc) * jnp.exp(logd - m_t[..., None])
    num = jnp.einsum('bhcts,bhcsd->bhctd', s, vc) + w_inter[..., None] * jnp.einsum('bhctk,bhckv->bhctv', qc, C0)
    nq = jnp.sum(s, axis=-1) + w_inter * jnp.einsum('bhctk,bhck->bhct', qc, n0)
    h = num / jnp.maximum(jnp.abs(nq), jnp.exp(-m_t))[..., None]
    return h.reshape(B, H, T, DH)


def mlstm_direction(ctx_in, lat_in, with_ctx):
    qc, kc, vc, igc, lfc = ctx_in
    ql, kl, vl, igl, lfl = lat_in
    B = kl.shape[0]
    zero = (jnp.zeros((B, MLSTM_HEADS, MLSTM_DH, MLSTM_DH), F32),
            jnp.zeros((B, MLSTM_HEADS, MLSTM_DH), F32),
            jnp.zeros((B, MLSTM_HEADS), F32))
    ctx_starts, ctx_final = mlstm_scan(kc, vc, igc, lfc, zero)
    lat_starts, _ = mlstm_scan(kl, vl, igl, lfl, ctx_final)
    h_lat = mlstm_out(ql, kl, vl, igl, lfl, lat_starts)
    h_ctx = mlstm_out(qc, kc, vc, igc, lfc, ctx_starts) if with_ctx else None
    return h_lat, h_ctx


def mlstm_readout(hf, hb, act, z, norm_w, skip):
    h = hf + hb
    mu = jnp.mean(h, axis=-1, keepdims=True)
    var = jnp.mean(jnp.square(h - mu), axis=-1, keepdims=True)
    hn = (h - mu) * lax.rsqrt(var + EPS)
    B, H, T, DH = hn.shape
    hn = hn.transpose(0, 2, 1, 3).reshape(B, T, D_MLSTM) * norm_w.astype(F32)
    out = (hn + skip.astype(F32) * act.astype(F32)) * jax.nn.silu(z.astype(F32))
    return out.astype(z.dtype)


def fourier_mix(u, w_fourier):
    B, T, _ = u.shape
    ug = u.astype(F32).reshape(B, T, FOURIER_GROUPS, FOURIER_CG)
    f = jnp.fft.fft2(ug, axes=(1, 3), norm='ortho').real
    y = jnp.einsum('btgc,gcd->btgd', f, w_fourier.astype(F32))
    return y.reshape(B, T, D_FOURIER).astype(u.dtype)


def token_mix(h, hc, lp, with_ctx):
    qkv_l, gf_l, gb_l, act_l, z_l, u_l = mixer_features(h, lp)
    qkv_c, gf_c, gb_c, act_c, z_c, u_c = mixer_features(hc, lp)
    hf_l, hf_c = mlstm_direction(qkv_c + gf_c, qkv_l + gf_l, with_ctx)
    hb_l, hb_c = mlstm_direction(tuple(flip_seq(t) for t in qkv_c + gb_c),
                                 tuple(flip_seq(t) for t in qkv_l + gb_l), with_ctx)

    def merge(hf, hb, act, z, u):
        m = mlstm_readout(hf, flip_seq(hb), act, z, lp['mlstm_norm_w'], lp['mlstm_skip'])
        f = fourier_mix(u, lp['w_fourier'])
        return jnp.concatenate([m, f], axis=-1) @ lp['w_out']

    y_l = merge(hf_l, hb_l, act_l, z_l, u_l)
    y_c = merge(hf_c, hb_c, act_c, z_c, u_c) if with_ctx else None
    return y_l, y_c


def hier_moe(h, lp):
    B, T, _ = h.shape
    g_logits = (h @ lp['w_router_group'] + lp['b_router_group']).astype(F32)
    p_group = jax.nn.softmax(g_logits, axis=-1)
    g_sel = jnp.argmax(g_logits, axis=-1)
    p_sel = jnp.take_along_axis(p_group, g_sel[..., None], axis=-1)
    e_logits = (h @ lp['w_router_expert'] + lp['b_router_expert']).astype(F32)
    e_logits = e_logits.reshape(B, T, N_EXPERT_GROUPS, EXPERTS_PER_GROUP)
    e_sel = jnp.take_along_axis(e_logits, g_sel[..., None, None], axis=2)[..., 0, :]
    top_v, top_i = lax.top_k(e_sel, TOP_K)
    w_top = jax.nn.softmax(top_v, axis=-1) * p_sel
    expert_id = g_sel[..., None] * EXPERTS_PER_GROUP + top_i
    combine = jnp.sum(jax.nn.one_hot(expert_id, N_EXPERTS, dtype=F32) * w_top[..., None], axis=-2)
    combine = combine.astype(h.dtype)
    y = jnp.zeros_like(h)
    for e in range(N_EXPERTS):
        a = jax.nn.silu(h @ lp['w_gate'][e]) * (h @ lp['w_up'][e])
        y = y + combine[..., e, None] * (a @ lp['w_down'][e])
    return y


def setup_inputs(seed: int = 0) -> dict:
    key = jax.random.key(seed)
    ks = jax.random.split(key, 40)
    L = DEPTH
    H = MLSTM_HEADS

    def nrm(k, shape, s):
        return jax.random.normal(k, shape, F32) * s

    def b_if(k1, k2):
        return jnp.concatenate([nrm(k1, (L, H), 0.1),
                                jnp.linspace(3.0, 6.0, H, dtype=F32)[None, :] + nrm(k2, (L, H), 0.1)], axis=-1)

    return {
        'x': nrm(ks[0], (BATCH, SEQ, D_MODEL), 1.0),
        'c': nrm(ks[1], (BATCH, D_MODEL), 1.0),
        'ctx': nrm(ks[2], (BATCH, CTX_LEN, D_MODEL), 1.0),
        'c_ctx': nrm(ks[3], (D_MODEL,), 1.0),
        'w_ada': nrm(ks[4], (L, D_MODEL, N_MOD * D_MODEL), 0.5 * D_MODEL ** -0.5),
        'b_ada': nrm(ks[5], (L, N_MOD * D_MODEL), 0.01),
        'g_pre_mix': 1.0 + nrm(ks[6], (L, D_MODEL), 0.05),
        'g_post_mix': 1.0 + nrm(ks[7], (L, D_MODEL), 0.05),
        'g_pre_ffn': 1.0 + nrm(ks[8], (L, D_MODEL), 0.05),
        'g_post_ffn': 1.0 + nrm(ks[9], (L, D_MODEL), 0.05),
        'w_in': nrm(ks[10], (L, D_MODEL, D_IN_PROJ), D_MODEL ** -0.5),
        'conv_w': nrm(ks[11], (L, CONV_K, D_MLSTM), CONV_K ** -0.5),
        'conv_b': nrm(ks[12], (L, D_MLSTM), 0.01),
        'w_q': nrm(ks[13], (L, N_QKV_BLOCKS, QKV_BLOCK, QKV_BLOCK), QKV_BLOCK ** -0.5),
        'w_k': nrm(ks[14], (L, N_QKV_BLOCKS, QKV_BLOCK, QKV_BLOCK), QKV_BLOCK ** -0.5),
        'w_v': nrm(ks[15], (L, N_QKV_BLOCKS, QKV_BLOCK, QKV_BLOCK), QKV_BLOCK ** -0.5),
        'w_if_fwd': nrm(ks[16], (L, 3 * D_MLSTM, 2 * H), 0.02),
        'b_if_fwd': b_if(ks[17], ks[18]),
        'w_if_bwd': nrm(ks[19], (L, 3 * D_MLSTM, 2 * H), 0.02),
        'b_if_bwd': b_if(ks[20], ks[21]),
        'mlstm_norm_w': 1.0 + nrm(ks[22], (L, D_MLSTM), 0.05),
        'mlstm_skip': 1.0 + nrm(ks[23], (L, D_MLSTM), 0.05),
        'w_fourier': nrm(ks[24], (L, FOURIER_GROUPS, FOURIER_CG, FOURIER_CG), FOURIER_CG ** -0.5),
        'w_out': nrm(ks[25], (L, D_MIX, D_MODEL), D_MIX ** -0.5),
        'w_router_group': nrm(ks[26], (L, D_MODEL, N_EXPERT_GROUPS), D_MODEL ** -0.5),
        'b_router_group': nrm(ks[27], (L, N_EXPERT_GROUPS), 0.01),
        'w_router_expert': nrm(ks[28], (L, D_MODEL, N_EXPERTS), D_MODEL ** -0.5),
        'b_router_expert': nrm(ks[29], (L, N_EXPERTS), 0.01),
        'w_gate': nrm(ks[30], (L, N_EXPERTS, D_MODEL, D_EXPERT), D_MODEL ** -0.5),
        'w_up': nrm(ks[31], (L, N_EXPERTS, D_MODEL, D_EXPERT), D_MODEL ** -0.5),
        'w_down': nrm(ks[32], (L, N_EXPERTS, D_EXPERT, D_MODEL), D_EXPERT ** -0.5),
    }


def reference(x, c, ctx, c_ctx, w_ada, b_ada, g_pre_mix, g_post_mix, g_pre_ffn, g_post_ffn,
              w_in, conv_w, conv_b, w_q, w_k, w_v, w_if_fwd, b_if_fwd, w_if_bwd, b_if_bwd,
              mlstm_norm_w, mlstm_skip, w_fourier, w_out, w_router_group, b_router_group,
              w_router_expert, b_router_expert, w_gate, w_up, w_down):
    T = x.shape[1]
    rows = T // GRID_W
    x = x + sincos_2d(rows, GRID_W).astype(x.dtype)[None]
    xc = ctx
    for l in range(DEPTH):
        with_ctx = l + 1 < DEPTH
        lp = {
            'w_in': w_in[l], 'conv_w': conv_w[l], 'conv_b': conv_b[l],
            'w_q': w_q[l], 'w_k': w_k[l], 'w_v': w_v[l],
            'w_if_fwd': w_if_fwd[l], 'b_if_fwd': b_if_fwd[l],
            'w_if_bwd': w_if_bwd[l], 'b_if_bwd': b_if_bwd[l],
            'mlstm_norm_w': mlstm_norm_w[l], 'mlstm_skip': mlstm_skip[l],
            'w_fourier': w_fourier[l], 'w_out': w_out[l],
            'w_router_group': w_router_group[l], 'b_router_group': b_router_group[l],
            'w_router_expert': w_router_expert[l], 'b_router_expert': b_router_expert[l],
            'w_gate': w_gate[l], 'w_up': w_up[l], 'w_down': w_down[l],
        }
        mod = [m[:, None, :] for m in jnp.split(jax.nn.silu(c) @ w_ada[l] + b_ada[l], N_MOD, axis=-1)]
        mod_c = [m[None, :] for m in jnp.split(jax.nn.silu(c_ctx) @ w_ada[l] + b_ada[l], N_MOD, axis=-1)]
        shift1, scale1, gate1, shift2, scale2, gate2 = mod
        h = modulate(rmsnorm(x, g_pre_mix[l]), shift1, scale1)
        hc = modulate(rmsnorm(xc, g_pre_mix[l]), mod_c[0], mod_c[1])
        y, yc = token_mix(h, hc, lp, with_ctx)
        x = x + gate1 * rmsnorm(y, g_post_mix[l])
        h2 = modulate(rmsnorm(x, g_pre_ffn[l]), shift2, scale2)
        x = x + gate2 * rmsnorm(hier_moe(h2, lp), g_post_ffn[l])
        if with_ctx:
            xc = xc + mod_c[2] * rmsnorm(yc, g_post_mix[l])
            hc2 = modulate(rmsnorm(xc, g_pre_ffn[l]), mod_c[3], mod_c[4])
            xc = xc + mod_c[5] * rmsnorm(hier_moe(hc2, lp), g_post_ffn[l])
    return x
```

```cpp
#include <hip/hip_runtime.h>
#include <hip/hip_cooperative_groups.h>
#include <cstdio>

typedef unsigned short bf16;
typedef unsigned v4u __attribute__((ext_vector_type(4)));
typedef float f32x4 __attribute__((ext_vector_type(4)));

constexpr int D = 1024, T = 16384, TC = 256, NT = T + TC;
constexpr int DM = 512, NH = 4, DH = 128, CH = 128, NCL = T / CH, NCC = TC / CH, NCH = NCL + NCC;
constexpr int DIN = 1536, NE = 16, DE = 512;
constexpr float EPS = 1e-6f;
constexpr int NTHREADS = 512, NWAVES = 8;
constexpr int LDS_BYTES = 147456;

constexpr size_t MiB = 1u << 20;
constexpr size_t WS_CTL = 0;
constexpr size_t WS_MOD = 1 * MiB;
constexpr size_t WS_MODC = 1 * MiB + 32768;
constexpr size_t WS_POSR = 1 * MiB + 65536;
constexpr size_t WS_POSC = WS_POSR + 256 * 512 * 4;
constexpr size_t WS_G = 2 * MiB;
constexpr size_t WS_IG = 3 * MiB;
constexpr size_t WS_LF = 4 * MiB;
constexpr size_t WS_AMAX = 5 * MiB;
constexpr size_t WS_BTOT = 5 * MiB + 8192;
constexpr size_t WS_M0 = 5 * MiB + 16384;
constexpr size_t WS_NL = 5 * MiB + 65536;
constexpr size_t WS_N0 = 6 * MiB;
constexpr size_t WS_RE = 7 * MiB;
constexpr size_t WS_RW = 7 * MiB + 256 * 1024;
constexpr size_t WS_H = 13 * MiB;
constexpr size_t WS_XM = 46 * MiB;
constexpr size_t WS_U = WS_XM + (size_t)NT * 1024;
constexpr size_t WS_Z = 79 * MiB;
constexpr size_t WS_C0 = 46 * MiB;
constexpr size_t WS_Q = 96 * MiB, WS_K = WS_Q + (size_t)NT * 1024, WS_V = WS_K + (size_t)NT * 1024, WS_ACT = WS_V + (size_t)NT * 1024;
constexpr size_t WS_L = 163 * MiB;
constexpr size_t WS_Y = 96 * MiB;
static_assert(WS_U + (size_t)NT * 1024 <= WS_Z && WS_Z + (size_t)NT * 1024 <= WS_Q && WS_ACT + (size_t)NT * 1024 <= WS_L && WS_L + 65 * MiB <= 256 * MiB, "ws map");
static_assert(WS_C0 + 32 * MiB <= WS_Z && WS_Y + 64 * MiB <= WS_L && WS_H + (size_t)NT * 2048 <= WS_XM, "ws map 2");

struct Args { const float* in[31]; float* out; unsigned char* ws; int ph_lo, ph_hi; };

__device__ __forceinline__ float bf2f(unsigned b) { return __uint_as_float(b << 16); }
__device__ __forceinline__ unsigned f2bf(float f) { unsigned u = __float_as_uint(f); return (u + 0x7fffu + ((u >> 16) & 1u)) >> 16; }
__device__ __forceinline__ unsigned pk2(float lo, float hi) { return f2bf(lo) | (f2bf(hi) << 16); }
__device__ __forceinline__ float lo16(unsigned w) { return __uint_as_float(w << 16); }
__device__ __forceinline__ float hi16(unsigned w) { return __uint_as_float(w & 0xffff0000u); }
__device__ __forceinline__ float wave_sum(float v) {
#pragma unroll
    for (int o = 1; o < 64; o <<= 1) v += __shfl_xor(v, o);
    return v;
}
__device__ __forceinline__ float siluf(float x) { return x / (1.f + __expf(-x)); }
__device__ __forceinline__ float logsigf(float x) { return fminf(x, 0.f) - log1pf(__expf(-fabsf(x))); }
__device__ __forceinline__ void unpack8(const v4u w, float (&f)[8]) {
    f[0] = lo16(w.x); f[1] = hi16(w.x); f[2] = lo16(w.y); f[3] = hi16(w.y); f[4] = lo16(w.z); f[5] = hi16(w.z); f[6] = lo16(w.w); f[7] = hi16(w.w);
}
__device__ __forceinline__ int chunk_row0(int d, int j) {
    if (d == 0) return j < NCC ? T + j * CH : (j - NCC) * CH;
    return j < NCC ? T + (NCC - 1 - j) * CH : (NCL - 1 - (j - NCC)) * CH;
}

struct Ctx {
    int tid, lane, wave, gw, NGW, gtid, NTHR, G, bid;
    unsigned char* ws; float* out; const float* const* in;
    float* lds;
};

template <int K>
__device__ __forceinline__ void gemm_8x64(const bf16* a0, const bf16* a1, const bf16* a2, const bf16* a3, const bf16* a4, const bf16* a5, const bf16* a6, const bf16* a7,
                                          const float* B, int ldb, int col, float (&acc)[8]) {
    for (int k0 = 0; k0 < K; k0 += 8) {
        float a[8][8];
        unpack8(*(const v4u*)(a0 + k0), a[0]); unpack8(*(const v4u*)(a1 + k0), a[1]); unpack8(*(const v4u*)(a2 + k0), a[2]); unpack8(*(const v4u*)(a3 + k0), a[3]);
        unpack8(*(const v4u*)(a4 + k0), a[4]); unpack8(*(const v4u*)(a5 + k0), a[5]); unpack8(*(const v4u*)(a6 + k0), a[6]); unpack8(*(const v4u*)(a7 + k0), a[7]);
#pragma unroll
        for (int kk = 0; kk < 8; ++kk) {
            const float b = B[(size_t)(k0 + kk) * ldb + col];
#pragma unroll
            for (int r = 0; r < 8; ++r) acc[r] += a[r][kk] * b;
        }
    }
}

__device__ __forceinline__ void p0_prologue(const Ctx& c) {
    const float* cvec = c.in[1]; const float* ccvec = c.in[3]; const float* w_ada = c.in[4]; const float* b_ada = c.in[5];
    float* mod = (float*)(c.ws + WS_MOD); float* modc = (float*)(c.ws + WS_MODC);
    for (int it = c.bid; it < 96; it += c.G) {
        const int col = it * 64 + c.lane; float al = 0.f, ac = 0.f;
        for (int k = c.wave * 128; k < c.wave * 128 + 128; ++k) {
            const float w = w_ada[(size_t)k * 6144 + col];
            al += siluf(cvec[k]) * w; ac += siluf(ccvec[k]) * w;
        }
        c.lds[(c.wave * 64 + c.lane) * 2] = al; c.lds[(c.wave * 64 + c.lane) * 2 + 1] = ac;
        __syncthreads();
        if (c.wave == 0) {
            float sl = 0.f, sc = 0.f;
            for (int w = 0; w < 8; ++w) { sl += c.lds[(w * 64 + c.lane) * 2]; sc += c.lds[(w * 64 + c.lane) * 2 + 1]; }
            mod[col] = sl + b_ada[col];
            if (col < 2048) modc[col] = sc + b_ada[col];
        }
        __syncthreads();
    }
    float* posR = (float*)(c.ws + WS_POSR);
    for (int i = c.gtid; i < 320 * 512; i += c.NTHR) {
        const int r = i >> 9, j = i & 511, p = r < 256 ? r : r - 256, fi = j & 255;
        const float freq = 1.0f / powf(10000.0f, (float)fi / 256.0f);
        const float ang = (float)p * freq;
        posR[i] = j < 256 ? sinf(ang) : cosf(ang);
    }
    const float* wf = c.in[22]; float* Gm = (float*)(c.ws + WS_G);
    const float scale = 1.0f / sqrtf(16384.0f * 128.0f);
    for (int i = c.gtid; i < 4 * 256 * 128; i += c.NTHR) {
        const int g = i >> 15, row = (i >> 7) & 255, d = i & 127, cc = row & 127; float s = 0.f;
        for (int c2 = 0; c2 < 128; ++c2) {
            const float ph = (float)((cc * c2) & 127) * (1.0f / 64.0f);
            const float tr = row < 128 ? cospif(ph) : sinpif(ph);
            s += tr * wf[(g * 128 + c2) * 128 + d];
        }
        Gm[i] = s * scale;
    }
}

__device__ __forceinline__ void p1_hrows(const Ctx& c) {
    const float* x = c.in[0]; const float* ctx = c.in[2]; const float* g = c.in[6];
    const float* mod = (const float*)(c.ws + WS_MOD); const float* modc = (const float*)(c.ws + WS_MODC);
    const float* posR = (const float*)(c.ws + WS_POSR); const float* posC = (const float*)(c.ws + WS_POSC);
    bf16* H = (bf16*)(c.ws + WS_H);
    for (int r = c.gw; r < NT; r += c.NGW) {
        const bool lat = r < T;
        const float* src = lat ? x + (size_t)r * D : ctx + (size_t)(r - T) * D;
        const float* md = lat ? mod : modc;
        f32x4 v[4]; float ss = 0.f;
#pragma unroll
        for (int j = 0; j < 4; ++j) {
            const int col = 256 * j + 4 * c.lane;
            v[j] = *(const f32x4*)(src + col);
            if (lat) { const float* pp = col < 512 ? posR + (r >> 6) * 512 + col : posC + (r & 63) * 512 + (col - 512); v[j] += *(const f32x4*)pp; }
            ss += v[j].x * v[j].x + v[j].y * v[j].y + v[j].z * v[j].z + v[j].w * v[j].w;
        }
        const float rinv = rsqrtf(wave_sum(ss) * (1.f / D) + EPS);
#pragma unroll
        for (int j = 0; j < 4; ++j) {
            const int col = 256 * j + 4 * c.lane;
            const f32x4 gg = *(const f32x4*)(g + col), sh = *(const f32x4*)(md + col), sc = *(const f32x4*)(md + 1024 + col);
            const f32x4 o = v[j] * rinv * gg * (sc + 1.f) + sh;
            uint2 w; w.x = pk2(o.x, o.y); w.y = pk2(o.z, o.w);
            *(uint2*)(H + (size_t)r * D + col) = w;
        }
    }
}

__device__ __forceinline__ void p2_gemm1(const Ctx& c) {
    const bf16* H = (const bf16*)(c.ws + WS_H); const float* w_in = c.in[10];
    constexpr int NCG = DIN / 64, NRG = NT / 8;
    for (int it = c.gw; it < NCG * NRG; it += c.NGW) {
        const int rg = it / NCG, cg = it % NCG, col = cg * 64 + c.lane; const bf16* a = H + (size_t)rg * 8 * D;
        float acc[8] = {0, 0, 0, 0, 0, 0, 0, 0};
        gemm_8x64<D>(a, a + D, a + 2 * D, a + 3 * D, a + 4 * D, a + 5 * D, a + 6 * D, a + 7 * D, w_in, DIN, col, acc);
        bf16* dst = (bf16*)(c.ws + (col < 512 ? WS_XM : (col < 1024 ? WS_Z : WS_U))) + (col & 511);
#pragma unroll
        for (int r = 0; r < 8; ++r) dst[(size_t)(rg * 8 + r) * DM] = (bf16)f2bf(acc[r]);
    }
}

__device__ __forceinline__ void p3_features(const Ctx& c) {
    const bf16* XM = (const bf16*)(c.ws + WS_XM);
    const float* conv_w = c.in[11]; const float* conv_b = c.in[12]; const float* wq = c.in[13]; const float* wk = c.in[14]; const float* wv = c.in[15];
    bf16* Q = (bf16*)(c.ws + WS_Q); bf16* Kb = (bf16*)(c.ws + WS_K); bf16* Vb = (bf16*)(c.ws + WS_V); bf16* ACT = (bf16*)(c.ws + WS_ACT);
    float* IG = (float*)(c.ws + WS_IG); float* LF = (float*)(c.ws + WS_LF);
    const int ch0 = 8 * c.lane;
    for (int r = c.gw; r < NT; r += c.NGW) {
        const bool lat = r < T;
        const bool hasp = lat ? (r > 0) : (r > T), hasn = lat ? (r < T - 1) : (r < NT - 1);
        float xc[8], xp[8], xn[8];
        unpack8(*(const v4u*)(XM + (size_t)r * DM + ch0), xc);
        if (hasp) unpack8(*(const v4u*)(XM + (size_t)(r - 1) * DM + ch0), xp); else { for (int i = 0; i < 8; ++i) xp[i] = 0.f; }
        if (hasn) unpack8(*(const v4u*)(XM + (size_t)(r + 1) * DM + ch0), xn); else { for (int i = 0; i < 8; ++i) xn[i] = 0.f; }
        float act[8], q[8], k[8], v[8];
#pragma unroll
        for (int i = 0; i < 8; ++i) {
            const float y = conv_w[ch0 + i] * xp[i] + conv_w[DM + ch0 + i] * xc[i] + conv_w[2 * DM + ch0 + i] * xn[i] + conv_b[ch0 + i];
            act[i] = siluf(y);
        }
#pragma unroll
        for (int b = 0; b < 2; ++b) {
            const int n = 2 * c.lane + b;
#pragma unroll
            for (int o = 0; o < 4; ++o) {
                float sq = 0.f, sk = 0.f, sv = 0.f;
#pragma unroll
                for (int i = 0; i < 4; ++i) { sq += act[4 * b + i] * wq[n * 16 + i * 4 + o]; sk += act[4 * b + i] * wk[n * 16 + i * 4 + o]; sv += xc[4 * b + i] * wv[n * 16 + i * 4 + o]; }
                q[4 * b + o] = sq; k[4 * b + o] = sk; v[4 * b + o] = sv;
            }
        }
#pragma unroll 1
        for (int d = 0; d < 2; ++d) {
            const float* wd = d ? c.in[18] : c.in[16]; const float* bd = d ? c.in[19] : c.in[17];
            float val = 0.f;
#pragma unroll
            for (int j = 0; j < 8; ++j) {
                float s = 0.f;
#pragma unroll
                for (int i = 0; i < 8; ++i) s += q[i] * wd[(ch0 + i) * 8 + j] + k[i] * wd[(512 + ch0 + i) * 8 + j] + v[i] * wd[(1024 + ch0 + i) * 8 + j];
                s = wave_sum(s) + bd[j];
                val = (c.lane == j) ? s : val;
            }
            if (c.lane < 8) {
                if (c.lane < 4) IG[(size_t)(d * 4 + c.lane) * NT + r] = val; else LF[(size_t)(d * 4 + (c.lane - 4)) * NT + r] = logsigf(val);
            }
        }
        const float qs = 0.08838834764831845f;
        v4u w;
        w.x = pk2(q[0] * qs, q[1] * qs); w.y = pk2(q[2] * qs, q[3] * qs); w.z = pk2(q[4] * qs, q[5] * qs); w.w = pk2(q[6] * qs, q[7] * qs); *(v4u*)(Q + (size_t)r * DM + ch0) = w;
        w.x = pk2(k[0], k[1]); w.y = pk2(k[2], k[3]); w.z = pk2(k[4], k[5]); w.w = pk2(k[6], k[7]); *(v4u*)(Kb + (size_t)r * DM + ch0) = w;
        w.x = pk2(v[0], v[1]); w.y = pk2(v[2], v[3]); w.z = pk2(v[4], v[5]); w.w = pk2(v[6], v[7]); *(v4u*)(Vb + (size_t)r * DM + ch0) = w;
        w.x = pk2(act[0], act[1]); w.y = pk2(act[2], act[3]); w.z = pk2(act[4], act[5]); w.w = pk2(act[6], act[7]); *(v4u*)(ACT + (size_t)r * DM + ch0) = w;
    }
}

__device__ __forceinline__ void p4_summaries(const Ctx& c) {
    const bf16* Kb = (const bf16*)(c.ws + WS_K); const bf16* Vb = (const bf16*)(c.ws + WS_V);
    const float* IG = (const float*)(c.ws + WS_IG); const float* LF = (const float*)(c.ws + WS_LF);
    float* LT = (float*)(c.ws + WS_L); float* NL = (float*)(c.ws + WS_NL); float* AMAX = (float*)(c.ws + WS_AMAX); float* BTOT = (float*)(c.ws + WS_BTOT);
    float* Ks = c.lds; float* Vs = c.lds + 16384; float* lfs = c.lds + 32768; float* as = lfs + 128; float* red = as + 128;
    for (int it = c.bid; it < 2 * NH * NCH; it += c.G) {
        const int d = it / (NH * NCH), h = (it / NCH) % NH, j = it % NCH, r0 = chunk_row0(d, j);
        const float* lf = LF + (size_t)(d * 4 + h) * NT + r0; const float* ig = IG + (size_t)(d * 4 + h) * NT + r0;
        if (c.tid < 128) lfs[c.tid] = lf[c.tid];
        __syncthreads();
        if (c.tid < 128) {
            float b = 0.f, tot = 0.f;
            for (int i = 0; i < 128; ++i) { const float x = lfs[i]; tot += x; if (d == 0 ? (i <= c.tid) : (i >= c.tid)) b += x; }
            as[c.tid] = tot - b + ig[c.tid];
            if (c.tid == 0) red[0] = tot;
        }
        __syncthreads();
        if (c.tid == 0) { float m = as[0]; for (int i = 1; i < 128; ++i) m = fmaxf(m, as[i]); red[1] = m; }
        __syncthreads();
        const float amax = red[1], btot = red[0];
        for (int e = c.tid; e < 128 * 16; e += NTHREADS) {
            const int l = e >> 4, c8 = (e & 15) * 8; const float w = __expf(as[l] - amax);
            float f[8];
            unpack8(*(const v4u*)(Kb + (size_t)(r0 + l) * DM + h * DH + c8), f);
#pragma unroll
            for (int i = 0; i < 8; ++i) Ks[l * 128 + c8 + i] = f[i] * w;
            unpack8(*(const v4u*)(Vb + (size_t)(r0 + l) * DM + h * DH + c8), f);
#pragma unroll
            for (int i = 0; i < 8; ++i) Vs[l * 128 + c8 + i] = f[i];
        }
        __syncthreads();
        {
            const int v = c.tid >> 2, kq = (c.tid & 3) * 32;
            float acc[32];
#pragma unroll
            for (int i = 0; i < 32; ++i) acc[i] = 0.f;
            for (int l = 0; l < 128; ++l) {
                const float vv = Vs[l * 128 + v];
#pragma unroll
                for (int i = 0; i < 32; ++i) acc[i] += Ks[l * 128 + kq + i] * vv;
            }
            float* dst = LT + ((size_t)((d * 4 + h) * NCH + j) * 128 + v) * 128 + kq;
#pragma unroll
            for (int i = 0; i < 32; i += 4) *(f32x4*)(dst + i) = (f32x4){acc[i], acc[i + 1], acc[i + 2], acc[i + 3]};
        }
        if (c.tid < 128) {
            float s = 0.f;
            for (int l = 0; l < 128; ++l) s += Ks[l * 128 + c.tid];
            NL[(size_t)((d * 4 + h) * NCH + j) * 128 + c.tid] = s;
            if (c.tid == 0) { AMAX[(d * 4 + h) * NCH + j] = amax; BTOT[(d * 4 + h) * NCH + j] = btot; }
        }
        __syncthreads();
    }
}

__device__ __forceinline__ void p5_scan(const Ctx& c) {
    const float* LT = (const float*)(c.ws + WS_L); const float* NL = (const float*)(c.ws + WS_NL);
    const float* AMAX = (const float*)(c.ws + WS_AMAX); const float* BTOT = (const float*)(c.ws + WS_BTOT);
    bf16* C0 = (bf16*)(c.ws + WS_C0); float* N0 = (float*)(c.ws + WS_N0); float* M0 = (float*)(c.ws + WS_M0);
    constexpr int PER = 16384 + 128;
    for (int e = c.gtid; e < 8 * PER; e += c.NTHR) {
        const int dh = e / PER, rem = e % PER; const bool isC = rem < 16384; const int idx = isC ? rem : rem - 16384;
        float m = 0.f, val = 0.f;
        for (int j = 0; j < NCH; ++j) {
            if (j >= NCC) {
                if (isC) C0[((size_t)(dh * NCL + (j - NCC))) * 16384 + idx] = (bf16)f2bf(val);
                else N0[(size_t)(dh * NCL + (j - NCC)) * 128 + idx] = val;
                if (rem == 0) M0[dh * NCL + (j - NCC)] = m;
            }
            const float bt = BTOT[dh * NCH + j], am = AMAX[dh * NCH + j];
            const float mn = fmaxf(bt + m, am), dec = __expf(bt + m - mn), sc = __expf(am - mn);
            const float lv = isC ? LT[(size_t)(dh * NCH + j) * 16384 + idx] : NL[(size_t)(dh * NCH + j) * 128 + idx];
            val = dec * val + sc * lv; m = mn;
        }
    }
}

__device__ __forceinline__ void p6_fourier_a(const Ctx& c) {
    const bf16* U = (const bf16*)(c.ws + WS_U); bf16* FB = (bf16*)c.out;
    float* Us = c.lds; float* ct = c.lds + 8192; float* st = ct + 128;
    if (c.tid < 128) { ct[c.tid] = cospif((float)c.tid * (1.f / 64.f)); st[c.tid] = sinpif((float)c.tid * (1.f / 64.f)); }
    __syncthreads();
    for (int it = c.bid; it < 128 * 8; it += c.G) {
        const int t2 = it >> 3, chg = it & 7;
        for (int e = c.tid; e < 128 * 8; e += NTHREADS) {
            const int t1 = e >> 3, c8 = (e & 7) * 8; float f[8];
            unpack8(*(const v4u*)(U + (size_t)(128 * t1 + t2) * DM + chg * 64 + c8), f);
#pragma unroll
            for (int i = 0; i < 8; ++i) Us[t1 * 64 + c8 + i] = f[i];
        }
        __syncthreads();
        const int k1 = c.tid >> 2, cq = (c.tid & 3) * 16;
        float ar[16], ai[16];
#pragma unroll
        for (int i = 0; i < 16; ++i) { ar[i] = 0.f; ai[i] = 0.f; }
        for (int t1 = 0; t1 < 128; ++t1) {
            const int idx = (k1 * t1) & 127; const float cc = ct[idx], ss = st[idx];
#pragma unroll
            for (int i = 0; i < 16; ++i) { const float u = Us[t1 * 64 + cq + i]; ar[i] += cc * u; ai[i] -= ss * u; }
        }
        const float ph = (float)(k1 * t2) * (1.f / 8192.f); const float tc = cospif(ph), ts = sinpif(ph);
        bf16* dr = FB + ((size_t)(k1 * 128 + t2) * 2) * 512 + chg * 64 + cq; bf16* di = dr + 512;
#pragma unroll
        for (int i = 0; i < 16; i += 2) {
            const float br0 = ar[i] * tc + ai[i] * ts, bi0 = ai[i] * tc - ar[i] * ts, br1 = ar[i + 1] * tc + ai[i + 1] * ts, bi1 = ai[i + 1] * tc - ar[i + 1] * ts;
            *(unsigned*)(dr + i) = pk2(br0, br1); *(unsigned*)(di + i) = pk2(bi0, bi1);
        }
        __syncthreads();
    }
}

__device__ __forceinline__ void p7a_fourier_c(const Ctx& c) {
    const bf16* FB = (const bf16*)c.out; bf16* X = (bf16*)((unsigned char*)c.out + 32 * MiB);
    float* Brs = c.lds; float* Bis = c.lds + 8192; float* ct = c.lds + 16384; float* st = ct + 128;
    if (c.tid < 128) { ct[c.tid] = cospif((float)c.tid * (1.f / 64.f)); st[c.tid] = sinpif((float)c.tid * (1.f / 64.f)); }
    __syncthreads();
    for (int it = c.bid; it < 128 * 8; it += c.G) {
        const int k1 = it >> 3, chg = it & 7;
        for (int e = c.tid; e < 128 * 2 * 8; e += NTHREADS) {
            const int t2 = e >> 4, ri = (e >> 3) & 1, c8 = (e & 7) * 8; float f[8];
            unpack8(*(const v4u*)(FB + ((size_t)(k1 * 128 + t2) * 2 + ri) * 512 + chg * 64 + c8), f);
            float* dst = (ri ? Bis : Brs) + t2 * 64 + c8;
#pragma unroll
            for (int i = 0; i < 8; ++i) dst[i] = f[i];
        }
        __syncthreads();
        const int k2 = c.tid >> 2, cq = (c.tid & 3) * 16;
        float xr[16], xi[16];
#pragma unroll
        for (int i = 0; i < 16; ++i) { xr[i] = 0.f; xi[i] = 0.f; }
        for (int t2 = 0; t2 < 128; ++t2) {
            const int idx = (k2 * t2) & 127; const float cc = ct[idx], ss = st[idx];
#pragma unroll
            for (int i = 0; i < 16; ++i) { const float br = Brs[t2 * 64 + cq + i], bi = Bis[t2 * 64 + cq + i]; xr[i] += cc * br + ss * bi; xi[i] += cc * bi - ss * br; }
        }
        bf16* dr = X + ((size_t)(k1 + 128 * k2) * 2) * 512 + chg * 64 + cq; bf16* di = dr + 512;
#pragma unroll
        for (int i = 0; i < 16; i += 2) { *(unsigned*)(dr + i) = pk2(xr[i], xr[i + 1]); *(unsigned*)(di + i) = pk2(xi[i], xi[i + 1]); }
        __syncthreads();
    }
}

__device__ __forceinline__ void p7b_fourier_mix(const Ctx& c) {
    const bf16* X = (const bf16*)((unsigned char*)c.out + 32 * MiB); const float* Gm = (const float*)(c.ws + WS_G); bf16* A2 = (bf16*)(c.ws + WS_H);
    for (int it = c.gw; it < (T / 8) * 8; it += c.NGW) {
        const int rg = it >> 3, g = (it >> 1) & 3, hf = it & 1, col = hf * 64 + c.lane;
        const bf16* a = X + (size_t)rg * 8 * 1024 + g * 128;
        float acc[8] = {0, 0, 0, 0, 0, 0, 0, 0};
        gemm_8x64<128>(a, a + 1024, a + 2048, a + 3072, a + 4096, a + 5120, a + 6144, a + 7168, Gm + (size_t)g * 256 * 128, 128, col, acc);
        a += 512;
        gemm_8x64<128>(a, a + 1024, a + 2048, a + 3072, a + 4096, a + 5120, a + 6144, a + 7168, Gm + (size_t)g * 256 * 128 + 128 * 128, 128, col, acc);
#pragma unroll
        for (int r = 0; r < 8; ++r) A2[(size_t)(rg * 8 + r) * D + 512 + g * 128 + col] = (bf16)f2bf(acc[r]);
    }
}

__device__ __forceinline__ void p8_mlstm_out(const Ctx& c) {
    const bf16* Q = (const bf16*)(c.ws + WS_Q); const bf16* Kb = (const bf16*)(c.ws + WS_K); const bf16* Vb = (const bf16*)(c.ws + WS_V);
    const bf16* ACT = (const bf16*)(c.ws + WS_ACT); const bf16* Z = (const bf16*)(c.ws + WS_Z);
    const float* IG = (const float*)(c.ws + WS_IG); const float* LF = (const float*)(c.ws + WS_LF);
    const bf16* C0 = (const bf16*)(c.ws + WS_C0); const float* N0 = (const float*)(c.ws + WS_N0); const float* M0 = (const float*)(c.ws + WS_M0);
    const float* norm_w = c.in[20]; const float* skip = c.in[21];
    bf16* A2 = (bf16*)(c.ws + WS_H);
    constexpr int KS = 136;
    bf16* Ks = (bf16*)c.lds; bf16* Vs = Ks + 128 * KS;
    float* S = c.lds + (2 * 128 * KS * 2) / 4;
    float* bs = S + 16384; float* igs = bs + 128; float* lfs = igs + 128;
    const int t = c.tid >> 2, qd = c.tid & 3;
    for (int it = c.bid; it < NH * NCL; it += c.G) {
        const int h = it / NCL, ck = it % NCL, r0 = ck * CH;
        for (int e = c.tid; e < 128 * 16; e += NTHREADS) {
            const int l = e >> 4, c8 = (e & 15) * 8;
            *(v4u*)(Ks + l * KS + c8) = *(const v4u*)(Kb + (size_t)(r0 + l) * DM + h * DH + c8);
            *(v4u*)(Vs + l * KS + c8) = *(const v4u*)(Vb + (size_t)(r0 + l) * DM + h * DH + c8);
        }
        float hsum[32];
#pragma unroll
        for (int i = 0; i < 32; ++i) hsum[i] = 0.f;
        const bf16* qrow = Q + (size_t)(r0 + t) * DM + h * DH;
        for (int d = 0; d < 2; ++d) {
            const int sidx = (d * 4 + h) * NCL + (d == 0 ? ck : NCL - 1 - ck);
            if (c.tid < 128) { lfs[c.tid] = LF[(size_t)(d * 4 + h) * NT + r0 + c.tid]; igs[c.tid] = IG[(size_t)(d * 4 + h) * NT + r0 + c.tid]; }
            __syncthreads();
            if (c.tid < 128) {
                float b = 0.f;
                for (int i = 0; i < 128; ++i) { if (d == 0 ? (i <= c.tid) : (i >= c.tid)) b += lfs[i]; }
                bs[c.tid] = b;
            }
            __syncthreads();
            const float m0 = M0[sidx], bt = bs[t];
            float acc[32];
#pragma unroll
            for (int i = 0; i < 32; ++i) acc[i] = 0.f;
            for (int kc = 0; kc < 16; ++kc) {
                float qf[8]; unpack8(*(const v4u*)(qrow + kc * 8), qf);
#pragma unroll
                for (int i = 0; i < 32; ++i) {
                    float kf[8]; unpack8(*(const v4u*)(Ks + (32 * qd + i) * KS + kc * 8), kf);
#pragma unroll
                    for (int u = 0; u < 8; ++u) acc[i] += qf[u] * kf[u];
                }
            }
            float mloc = -INFINITY;
            float ld[32];
#pragma unroll
            for (int i = 0; i < 32; ++i) {
                const int s = 32 * qd + i; const bool ok = d == 0 ? (s <= t) : (s >= t);
                ld[i] = ok ? bt - bs[s] + igs[s] : -INFINITY; mloc = fmaxf(mloc, ld[i]);
            }
            mloc = fmaxf(mloc, __shfl_xor(mloc, 1)); mloc = fmaxf(mloc, __shfl_xor(mloc, 2));
            const float mt = fmaxf(bt + m0, mloc);
            float rs = 0.f;
#pragma unroll
            for (int i = 0; i < 32; ++i) { const float sv = acc[i] * __expf(ld[i] - mt); S[t * 128 + 32 * qd + i] = sv; rs += sv; }
            rs += __shfl_xor(rs, 1); rs += __shfl_xor(rs, 2);
            __syncthreads();
            float num[32];
#pragma unroll
            for (int i = 0; i < 32; ++i) num[i] = 0.f;
            for (int s = 0; s < 128; ++s) {
                const float sv = S[t * 128 + s];
#pragma unroll
                for (int i8 = 0; i8 < 4; ++i8) {
                    float vf[8]; unpack8(*(const v4u*)(Vs + s * KS + 32 * qd + i8 * 8), vf);
#pragma unroll
                    for (int u = 0; u < 8; ++u) num[i8 * 8 + u] += sv * vf[u];
                }
            }
            float qc[32];
#pragma unroll
            for (int i = 0; i < 32; ++i) qc[i] = 0.f;
            const bf16* c0 = C0 + (size_t)sidx * 16384;
            for (int kc = 0; kc < 16; ++kc) {
                float qf[8]; unpack8(*(const v4u*)(qrow + kc * 8), qf);
#pragma unroll
                for (int i = 0; i < 32; ++i) {
                    float cf[8]; unpack8(*(const v4u*)(c0 + (size_t)(32 * qd + i) * 128 + kc * 8), cf);
#pragma unroll
                    for (int u = 0; u < 8; ++u) qc[i] += qf[u] * cf[u];
                }
            }
            float qn = 0.f;
            {
                const float* n0 = N0 + (size_t)sidx * 128 + 32 * qd;
#pragma unroll
                for (int k8 = 0; k8 < 4; ++k8) {
                    float qf[8]; unpack8(*(const v4u*)(qrow + 32 * qd + k8 * 8), qf);
#pragma unroll
                    for (int u = 0; u < 8; ++u) qn += qf[u] * n0[k8 * 8 + u];
                }
            }
            qn += __shfl_xor(qn, 1); qn += __shfl_xor(qn, 2);
            const float wi = __expf(bt + m0 - mt), nq = rs + wi * qn, den = fmaxf(fabsf(nq), __expf(-mt)), rden = 1.f / den;
#pragma unroll
            for (int i = 0; i < 32; ++i) hsum[i] += (num[i] + wi * qc[i]) * rden;
            __syncthreads();
        }
        float sm = 0.f;
#pragma unroll
        for (int i = 0; i < 32; ++i) sm += hsum[i];
        sm += __shfl_xor(sm, 1); sm += __shfl_xor(sm, 2);
        const float mu = sm * (1.f / 128.f);
        float sv = 0.f;
#pragma unroll
        for (int i = 0; i < 32; ++i) { const float dlt = hsum[i] - mu; sv += dlt * dlt; }
        sv += __shfl_xor(sv, 1); sv += __shfl_xor(sv, 2);
        const float rstd = rsqrtf(sv * (1.f / 128.f) + EPS);
        const int col0 = h * DH + 32 * qd; const size_t row = (size_t)(r0 + t);
#pragma unroll
        for (int i8 = 0; i8 < 4; ++i8) {
            float af[8], zf[8], o[8];
            unpack8(*(const v4u*)(ACT + row * DM + col0 + i8 * 8), af); unpack8(*(const v4u*)(Z + row * DM + col0 + i8 * 8), zf);
#pragma unroll
            for (int u = 0; u < 8; ++u) {
                const int cc = col0 + i8 * 8 + u;
                const float hn = (hsum[i8 * 8 + u] - mu) * rstd * norm_w[cc];
                o[u] = (hn + skip[cc] * af[u]) * siluf(zf[u]);
            }
            v4u w; w.x = pk2(o[0], o[1]); w.y = pk2(o[2], o[3]); w.z = pk2(o[4], o[5]); w.w = pk2(o[6], o[7]);
            *(v4u*)(A2 + row * D + col0 + i8 * 8) = w;
        }
        __syncthreads();
    }
}

__device__ __forceinline__ void p9_outproj(const Ctx& c) {
    const bf16* A2 = (const bf16*)(c.ws + WS_H); const float* w_out = c.in[23]; float* Y = (float*)(c.ws + WS_Y);
    constexpr int NCG = D / 64, NRG = T / 8;
    for (int it = c.gw; it < NCG * NRG; it += c.NGW) {
        const int rg = it / NCG, cg = it % NCG, col = cg * 64 + c.lane; const bf16* a = A2 + (size_t)rg * 8 * D;
        float acc[8] = {0, 0, 0, 0, 0, 0, 0, 0};
        gemm_8x64<D>(a, a + D, a + 2 * D, a + 3 * D, a + 4 * D, a + 5 * D, a + 6 * D, a + 7 * D, w_out, D, col, acc);
#pragma unroll
        for (int r = 0; r < 8; ++r) Y[(size_t)(rg * 8 + r) * D + col] = acc[r];
    }
}

__device__ __forceinline__ void p10_token(const Ctx& c) {
    const float* x = c.in[0]; const float* g_post = c.in[7]; const float* g_ffn = c.in[8];
    const float* wrg = c.in[24]; const float* brg = c.in[25]; const float* wre = c.in[26]; const float* bre = c.in[27];
    const float* mod = (const float*)(c.ws + WS_MOD);
    const float* posR = (const float*)(c.ws + WS_POSR); const float* posC = (const float*)(c.ws + WS_POSC);
    float* Y = (float*)(c.ws + WS_Y); bf16* H2 = (bf16*)(c.ws + WS_H); int* RE = (int*)(c.ws + WS_RE); float* RW = (float*)(c.ws + WS_RW);
    for (int r = c.gw; r < T; r += c.NGW) {
        f32x4 xv[4], yv[4]; float ss = 0.f;
#pragma unroll
        for (int j = 0; j < 4; ++j) {
            const int col = 256 * j + 4 * c.lane;
            const float* pp = col < 512 ? posR + (r >> 6) * 512 + col : posC + (r & 63) * 512 + (col - 512);
            xv[j] = *(const f32x4*)(x + (size_t)r * D + col) + *(const f32x4*)pp;
            yv[j] = *(const f32x4*)(Y + (size_t)r * D + col);
            ss += yv[j].x * yv[j].x + yv[j].y * yv[j].y + yv[j].z * yv[j].z + yv[j].w * yv[j].w;
        }
        const float rinv = rsqrtf(wave_sum(ss) * (1.f / D) + EPS);
        float s2 = 0.f;
#pragma unroll
        for (int j = 0; j < 4; ++j) {
            const int col = 256 * j + 4 * c.lane;
            const f32x4 gg = *(const f32x4*)(g_post + col), g1 = *(const f32x4*)(mod + 2048 + col);
            xv[j] = xv[j] + g1 * (yv[j] * rinv * gg);
            *(f32x4*)(c.out + (size_t)r * D + col) = xv[j];
            *(f32x4*)(Y + (size_t)r * D + col) = (f32x4){0.f, 0.f, 0.f, 0.f};
            s2 += xv[j].x * xv[j].x + xv[j].y * xv[j].y + xv[j].z * xv[j].z + xv[j].w * xv[j].w;
        }
        const float rinv2 = rsqrtf(wave_sum(s2) * (1.f / D) + EPS);
        float lg[20];
#pragma unroll
        for (int i = 0; i < 20; ++i) lg[i] = 0.f;
#pragma unroll
        for (int j = 0; j < 4; ++j) {
            const int col = 256 * j + 4 * c.lane;
            const f32x4 gg = *(const f32x4*)(g_ffn + col), sh = *(const f32x4*)(mod + 3072 + col), sc = *(const f32x4*)(mod + 4096 + col);
            const f32x4 hv = xv[j] * rinv2 * gg * (sc + 1.f) + sh;
            uint2 w; w.x = pk2(hv.x, hv.y); w.y = pk2(hv.z, hv.w);
            *(uint2*)(H2 + (size_t)r * D + col) = w;
            const float he[4] = {hv.x, hv.y, hv.z, hv.w};
#pragma unroll
            for (int e = 0; e < 4; ++e) {
                const f32x4 wg4 = *(const f32x4*)(wrg + (size_t)(col + e) * 4);
                lg[0] += he[e] * wg4.x; lg[1] += he[e] * wg4.y; lg[2] += he[e] * wg4.z; lg[3] += he[e] * wg4.w;
#pragma unroll
                for (int q4 = 0; q4 < 4; ++q4) {
                    const f32x4 we4 = *(const f32x4*)(wre + (size_t)(col + e) * 16 + q4 * 4);
                    lg[4 + q4 * 4] += he[e] * we4.x; lg[5 + q4 * 4] += he[e] * we4.y; lg[6 + q4 * 4] += he[e] * we4.z; lg[7 + q4 * 4] += he[e] * we4.w;
                }
            }
        }
#pragma unroll
        for (int i = 0; i < 20; ++i) lg[i] = wave_sum(lg[i]);
        if (c.lane == 0) {
            float gl[4];
#pragma unroll
            for (int i = 0; i < 4; ++i) gl[i] = lg[i] + brg[i];
            int gs = 0; float gm = gl[0];
#pragma unroll
            for (int i = 1; i < 4; ++i) if (gl[i] > gm) { gm = gl[i]; gs = i; }
            float den = 0.f;
#pragma unroll
            for (int i = 0; i < 4; ++i) den += __expf(gl[i] - gm);
            const float psel = 1.f / den;
            float el[4];
#pragma unroll
            for (int i = 0; i < 4; ++i) {
                float v = 0.f;
#pragma unroll
                for (int g2 = 0; g2 < 4; ++g2) v = (g2 == gs) ? lg[4 + g2 * 4 + i] + bre[g2 * 4 + i] : v;
                el[i] = v;
            }
            int i1 = 0; float em1 = el[0];
#pragma unroll
            for (int i = 1; i < 4; ++i) if (el[i] > em1) { em1 = el[i]; i1 = i; }
            int i2 = -1; float em2 = -INFINITY;
#pragma unroll
            for (int i = 0; i < 4; ++i) if (i != i1 && el[i] > em2) { em2 = el[i]; i2 = i; }
            const float e2 = __expf(em2 - em1), w1 = psel / (1.f + e2), w2 = psel * e2 / (1.f + e2);
            RE[2 * r] = gs * 4 + i1; RE[2 * r + 1] = gs * 4 + i2; RW[2 * r] = w1; RW[2 * r + 1] = w2;
        }
    }
}

__device__ __forceinline__ void p11_moe(const Ctx& c) {
    const bf16* H2 = (const bf16*)(c.ws + WS_H); const int* RE = (const int*)(c.ws + WS_RE); const float* RW = (const float*)(c.ws + WS_RW);
    const float* w_gate = c.in[28]; const float* w_up = c.in[29]; const float* w_down = c.in[30]; float* YM = (float*)(c.ws + WS_Y);
    float* Hs = c.lds;
    float* As = c.lds + 8192;
    int* ltok = (int*)(c.lds + 12288); float* lw = c.lds + 12288 + 128; int* cnt = (int*)(c.lds + 12288 + 256);
    for (int it = c.bid; it < NE * (T / 128); it += c.G) {
        const int e = it / (T / 128), chunk = it % (T / 128);
        if (c.tid == 0) *cnt = 0;
        __syncthreads();
        if (c.tid < 128) {
            const int tok = chunk * 128 + c.tid; const int e0 = RE[2 * tok], e1 = RE[2 * tok + 1];
            if (e0 == e || e1 == e) { const int p = atomicAdd(cnt, 1); ltok[p] = tok; lw[p] = (e0 == e) ? RW[2 * tok] : RW[2 * tok + 1]; }
        }
        __syncthreads();
        const int n = *cnt;
        const float* Wg = w_gate + (size_t)e * D * DE; const float* Wu = w_up + (size_t)e * D * DE; const float* Wd = w_down + (size_t)e * DE * D;
        for (int base = 0; base < n; base += 8) {
            for (int idx = c.tid; idx < 8 * 128; idx += NTHREADS) {
                const int i = idx >> 7, c8 = (idx & 127) * 8; float f[8];
                if (base + i < n) unpack8(*(const v4u*)(H2 + (size_t)ltok[base + i] * D + c8), f); else { for (int u = 0; u < 8; ++u) f[u] = 0.f; }
#pragma unroll
                for (int u = 0; u < 8; ++u) Hs[i * 1024 + c8 + u] = f[u];
            }
            __syncthreads();
            {
                float g[8], u[8];
#pragma unroll
                for (int i = 0; i < 8; ++i) { g[i] = 0.f; u[i] = 0.f; }
                for (int k = 0; k < D; ++k) {
                    const float wg = Wg[(size_t)k * DE + c.tid], wu = Wu[(size_t)k * DE + c.tid];
#pragma unroll
                    for (int i = 0; i < 8; ++i) { const float hv = Hs[i * 1024 + k]; g[i] += hv * wg; u[i] += hv * wu; }
                }
#pragma unroll
                for (int i = 0; i < 8; ++i) As[i * 512 + c.tid] = (base + i < n) ? siluf(g[i]) * u[i] * lw[base + i] : 0.f;
            }
            __syncthreads();
            {
                float y0[8], y1[8];
#pragma unroll
                for (int i = 0; i < 8; ++i) { y0[i] = 0.f; y1[i] = 0.f; }
                for (int j = 0; j < DE; ++j) {
                    const float w0 = Wd[(size_t)j * D + c.tid], w1 = Wd[(size_t)j * D + 512 + c.tid];
#pragma unroll
                    for (int i = 0; i < 8; ++i) { const float av = As[i * 512 + j]; y0[i] += av * w0; y1[i] += av * w1; }
                }
#pragma unroll
                for (int i = 0; i < 8; ++i) if (base + i < n) { atomicAdd(YM + (size_t)ltok[base + i] * D + c.tid, y0[i]); atomicAdd(YM + (size_t)ltok[base + i] * D + 512 + c.tid, y1[i]); }
            }
            __syncthreads();
        }
        __syncthreads();
    }
}

__device__ __forceinline__ void p12_final(const Ctx& c) {
    const float* g_post = c.in[9]; const float* mod = (const float*)(c.ws + WS_MOD); const float* YM = (const float*)(c.ws + WS_Y);
    for (int r = c.gw; r < T; r += c.NGW) {
        f32x4 yv[4]; float ss = 0.f;
#pragma unroll
        for (int j = 0; j < 4; ++j) { const int col = 256 * j + 4 * c.lane; yv[j] = *(const f32x4*)(YM + (size_t)r * D + col); ss += yv[j].x * yv[j].x + yv[j].y * yv[j].y + yv[j].z * yv[j].z + yv[j].w * yv[j].w; }
        const float rinv = rsqrtf(wave_sum(ss) * (1.f / D) + EPS);
#pragma unroll
        for (int j = 0; j < 4; ++j) {
            const int col = 256 * j + 4 * c.lane;
            const f32x4 gg = *(const f32x4*)(g_post + col), g2 = *(const f32x4*)(mod + 5120 + col);
            f32x4* o = (f32x4*)(c.out + (size_t)r * D + col);
            *o = *o + g2 * (yv[j] * rinv * gg);
        }
    }
}

constexpr int N_PHASES = 14;
template <int PH> __device__ __forceinline__ void run_phase(const Ctx& c) {
    if constexpr (PH == 0) p0_prologue(c);
    if constexpr (PH == 1) p1_hrows(c);
    if constexpr (PH == 2) p2_gemm1(c);
    if constexpr (PH == 3) p3_features(c);
    if constexpr (PH == 4) p6_fourier_a(c);
    if constexpr (PH == 5) p4_summaries(c);
    if constexpr (PH == 6) p5_scan(c);
    if constexpr (PH == 7) p7a_fourier_c(c);
    if constexpr (PH == 8) p7b_fourier_mix(c);
    if constexpr (PH == 9) p8_mlstm_out(c);
    if constexpr (PH == 10) p9_outproj(c);
    if constexpr (PH == 11) p10_token(c);
    if constexpr (PH == 12) p11_moe(c);
    if constexpr (PH == 13) p12_final(c);
}
template <int PH> __global__ void __launch_bounds__(NTHREADS, 2) phase_kernel(Args a) {
    extern __shared__ __attribute__((aligned(16))) unsigned char lds_raw[];
    Ctx c;
    c.tid = threadIdx.x; c.lane = c.tid & 63; c.wave = __builtin_amdgcn_readfirstlane(c.tid >> 6);
    c.G = gridDim.x; c.bid = blockIdx.x; c.gw = c.bid * NWAVES + c.wave; c.NGW = c.G * NWAVES; c.gtid = c.bid * NTHREADS + c.tid; c.NTHR = c.G * NTHREADS;
    c.ws = a.ws; c.out = a.out; c.in = a.in; c.lds = (float*)lds_raw;
    run_phase<PH>(c);
}
template <int PH> static void launch_phase(int grid, hipStream_t stream, const Args& a) {
    static bool attr_done = false;
    if (!attr_done) { (void)hipFuncSetAttribute((const void*)phase_kernel<PH>, hipFuncAttributeMaxDynamicSharedMemorySize, LDS_BYTES); attr_done = true; }
    hipLaunchKernelGGL(phase_kernel<PH>, dim3(grid), dim3(NTHREADS), LDS_BYTES, stream, a);
}

extern "C" void kernel_launch(void* const* d_in, const int* in_sizes, int n_in, void* d_out, int out_size, void* d_ws, size_t ws_size, hipStream_t stream) {
    static int grid = 0;
    if (grid == 0) {
        if (n_in != 31 || out_size != T * D || ws_size < 256 * MiB) { fprintf(stderr, "kernel_launch: unexpected shapes n_in %d out %d ws %zu\n", n_in, out_size, ws_size); grid = -1; return; }
        int dev = 0, cus = 0;
        (void)hipGetDevice(&dev); (void)hipDeviceGetAttribute(&cus, hipDeviceAttributeMultiprocessorCount, dev);
        grid = cus > 0 ? cus : 256;
    }
    if (grid < 0) return;
    Args a{};
    for (int i = 0; i < 31; ++i) a.in[i] = (const float*)d_in[i];
    a.out = (float*)d_out; a.ws = (unsigned char*)d_ws;
    a.ph_lo = 0; a.ph_hi = N_PHASES;
    launch_phase<0>(grid, stream, a); launch_phase<1>(grid, stream, a); launch_phase<2>(grid, stream, a); launch_phase<3>(grid, stream, a);
    launch_phase<4>(grid, stream, a); launch_phase<5>(grid, stream, a); launch_phase<6>(grid, stream, a); launch_phase<7>(grid, stream, a);
    launch_phase<8>(grid, stream, a); launch_phase<9>(grid, stream, a); launch_phase<10>(grid, stream, a); launch_phase<11>(grid, stream, a);
    launch_phase<12>(grid, stream, a); launch_phase<13>(grid, stream, a);
}
```

```cpp
#include <hip/hip_runtime.h>
#include <hip/hip_cooperative_groups.h>
#include <cstdio>

typedef unsigned short bf16;
typedef unsigned v4u __attribute__((ext_vector_type(4)));
typedef float f32x4 __attribute__((ext_vector_type(4)));

constexpr int D = 1024, T = 16384, TC = 256, NT = T + TC;
constexpr int DM = 512, NH = 4, DH = 128, CH = 128, NCL = T / CH, NCC = TC / CH, NCH = NCL + NCC;
constexpr int DIN = 1536, NE = 16, DE = 512;
constexpr float EPS = 1e-6f;
constexpr int NTHREADS = 512, NWAVES = 8;
constexpr int LDS_BYTES = 147456;

constexpr size_t MiB = 1u << 20;
constexpr size_t WS_CTL = 0;
constexpr size_t WS_MOD = 1 * MiB;
constexpr size_t WS_MODC = 1 * MiB + 32768;
constexpr size_t WS_POSR = 1 * MiB + 65536;
constexpr size_t WS_POSC = WS_POSR + 256 * 512 * 4;
constexpr size_t WS_G = 2 * MiB;
constexpr size_t WS_IG = 3 * MiB;
constexpr size_t WS_LF = 4 * MiB;
constexpr size_t WS_AMAX = 5 * MiB;
constexpr size_t WS_BTOT = 5 * MiB + 8192;
constexpr size_t WS_M0 = 5 * MiB + 16384;
constexpr size_t WS_NL = 5 * MiB + 65536;
constexpr size_t WS_N0 = 6 * MiB;
constexpr size_t WS_RE = 7 * MiB;
constexpr size_t WS_RW = 7 * MiB + 256 * 1024;
constexpr size_t WS_H = 13 * MiB;
constexpr size_t WS_XM = 46 * MiB;
constexpr size_t WS_U = WS_XM + (size_t)NT * 1024;
constexpr size_t WS_Z = 79 * MiB;
constexpr size_t WS_C0 = 46 * MiB;
constexpr size_t WS_Q = 96 * MiB, WS_K = WS_Q + (size_t)NT * 1024, WS_V = WS_K + (size_t)NT * 1024, WS_ACT = WS_V + (size_t)NT * 1024;
constexpr size_t WS_L = 163 * MiB;
constexpr size_t WS_Y = 96 * MiB;
static_assert(WS_U + (size_t)NT * 1024 <= WS_Z && WS_Z + (size_t)NT * 1024 <= WS_Q && WS_ACT + (size_t)NT * 1024 <= WS_L && WS_L + 65 * MiB <= 256 * MiB, "ws map");
static_assert(WS_C0 + 32 * MiB <= WS_Z && WS_Y + 64 * MiB <= WS_L && WS_H + (size_t)NT * 2048 <= WS_XM, "ws map 2");

struct Args { const float* in[31]; float* out; unsigned char* ws; int ph_lo, ph_hi; };

__device__ __forceinline__ float bf2f(unsigned b) { return __uint_as_float(b << 16); }
__device__ __forceinline__ unsigned f2bf(float f) { unsigned u = __float_as_uint(f); return (u + 0x7fffu + ((u >> 16) & 1u)) >> 16; }
__device__ __forceinline__ unsigned pk2(float lo, float hi) { return f2bf(lo) | (f2bf(hi) << 16); }
__device__ __forceinline__ float lo16(unsigned w) { return __uint_as_float(w << 16); }
__device__ __forceinline__ float hi16(unsigned w) { return __uint_as_float(w & 0xffff0000u); }
__device__ __forceinline__ float wave_sum(float v) {
#pragma unroll
    for (int o = 1; o < 64; o <<= 1) v += __shfl_xor(v, o);
    return v;
}
__device__ __forceinline__ float siluf(float x) { return x / (1.f + __expf(-x)); }
__device__ __forceinline__ float logsigf(float x) { return fminf(x, 0.f) - log1pf(__expf(-fabsf(x))); }
__device__ __forceinline__ void unpack8(const v4u w, float (&f)[8]) {
    f[0] = lo16(w.x); f[1] = hi16(w.x); f[2] = lo16(w.y); f[3] = hi16(w.y); f[4] = lo16(w.z); f[5] = hi16(w.z); f[6] = lo16(w.w); f[7] = hi16(w.w);
}
__device__ __forceinline__ int chunk_row0(int d, int j) {
    if (d == 0) return j < NCC ? T + j * CH : (j - NCC) * CH;
    return j < NCC ? T + (NCC - 1 - j) * CH : (NCL - 1 - (j - NCC)) * CH;
}

struct Ctx {
    int tid, lane, wave, gw, NGW, gtid, NTHR, G, bid;
    unsigned char* ws; float* out; const float* const* in;
    float* lds;
};

template <int K>
__device__ __forceinline__ void gemm_8x64(const bf16* a0, const bf16* a1, const bf16* a2, const bf16* a3, const bf16* a4, const bf16* a5, const bf16* a6, const bf16* a7,
                                          const float* B, int ldb, int col, float (&acc)[8]) {
    for (int k0 = 0; k0 < K; k0 += 8) {
        float a[8][8];
        unpack8(*(const v4u*)(a0 + k0), a[0]); unpack8(*(const v4u*)(a1 + k0), a[1]); unpack8(*(const v4u*)(a2 + k0), a[2]); unpack8(*(const v4u*)(a3 + k0), a[3]);
        unpack8(*(const v4u*)(a4 + k0), a[4]); unpack8(*(const v4u*)(a5 + k0), a[5]); unpack8(*(const v4u*)(a6 + k0), a[6]); unpack8(*(const v4u*)(a7 + k0), a[7]);
#pragma unroll
        for (int kk = 0; kk < 8; ++kk) {
            const float b = B[(size_t)(k0 + kk) * ldb + col];
#pragma unroll
            for (int r = 0; r < 8; ++r) acc[r] += a[r][kk] * b;
        }
    }
}

__device__ __forceinline__ void p0_prologue(const Ctx& c) {
    const float* cvec = c.in[1]; const float* ccvec = c.in[3]; const float* w_ada = c.in[4]; const float* b_ada = c.in[5];
    float* mod = (float*)(c.ws + WS_MOD); float* modc = (float*)(c.ws + WS_MODC);
    for (int it = c.bid; it < 96; it += c.G) {
        const int col = it * 64 + c.lane; float al = 0.f, ac = 0.f;
        for (int k = c.wave * 128; k < c.wave * 128 + 128; ++k) {
            const float w = w_ada[(size_t)k * 6144 + col];
            al += siluf(cvec[k]) * w; ac += siluf(ccvec[k]) * w;
        }
        c.lds[(c.wave * 64 + c.lane) * 2] = al; c.lds[(c.wave * 64 + c.lane) * 2 + 1] = ac;
        __syncthreads();
        if (c.wave == 0) {
            float sl = 0.f, sc = 0.f;
            for (int w = 0; w < 8; ++w) { sl += c.lds[(w * 64 + c.lane) * 2]; sc += c.lds[(w * 64 + c.lane) * 2 + 1]; }
            mod[col] = sl + b_ada[col];
            if (col < 2048) modc[col] = sc + b_ada[col];
        }
        __syncthreads();
    }
    float* posR = (float*)(c.ws + WS_POSR);
    for (int i = c.gtid; i < 320 * 512; i += c.NTHR) {
        const int r = i >> 9, j = i & 511, p = r < 256 ? r : r - 256, fi = j & 255;
        const float freq = 1.0f / powf(10000.0f, (float)fi / 256.0f);
        const float ang = (float)p * freq;
        posR[i] = j < 256 ? sinf(ang) : cosf(ang);
    }
    const float* wf = c.in[22]; float* Gm = (float*)(c.ws + WS_G);
    const float scale = 1.0f / sqrtf(16384.0f * 128.0f);
    for (int i = c.gtid; i < 4 * 256 * 128; i += c.NTHR) {
        const int g = i >> 15, row = (i >> 7) & 255, d = i & 127, cc = row & 127; float s = 0.f;
        for (int c2 = 0; c2 < 128; ++c2) {
            const float ph = (float)((cc * c2) & 127) * (1.0f / 64.0f);
            const float tr = row < 128 ? cospif(ph) : sinpif(ph);
            s += tr * wf[(g * 128 + c2) * 128 + d];
        }
        Gm[i] = s * scale;
    }
}

__device__ __forceinline__ void p1_hrows(const Ctx& c) {
    const float* x = c.in[0]; const float* ctx = c.in[2]; const float* g = c.in[6];
    const float* mod = (const float*)(c.ws + WS_MOD); const float* modc = (const float*)(c.ws + WS_MODC);
    const float* posR = (const float*)(c.ws + WS_POSR); const float* posC = (const float*)(c.ws + WS_POSC);
    bf16* H = (bf16*)(c.ws + WS_H);
    for (int r = c.gw; r < NT; r += c.NGW) {
        const bool lat = r < T;
        const float* src = lat ? x + (size_t)r * D : ctx + (size_t)(r - T) * D;
        const float* md = lat ? mod : modc;
        f32x4 v[4]; float ss = 0.f;
#pragma unroll
        for (int j = 0; j < 4; ++j) {
            const int col = 256 * j + 4 * c.lane;
            v[j] = *(const f32x4*)(src + col);
            if (lat) { const float* pp = col < 512 ? posR + (r >> 6) * 512 + col : posC + (r & 63) * 512 + (col - 512); v[j] += *(const f32x4*)pp; }
            ss += v[j].x * v[j].x + v[j].y * v[j].y + v[j].z * v[j].z + v[j].w * v[j].w;
        }
        const float rinv = rsqrtf(wave_sum(ss) * (1.f / D) + EPS);
#pragma unroll
        for (int j = 0; j < 4; ++j) {
            const int col = 256 * j + 4 * c.lane;
            const f32x4 gg = *(const f32x4*)(g + col), sh = *(const f32x4*)(md + col), sc = *(const f32x4*)(md + 1024 + col);
            const f32x4 o = v[j] * rinv * gg * (sc + 1.f) + sh;
            uint2 w; w.x = pk2(o.x, o.y); w.y = pk2(o.z, o.w);
            *(uint2*)(H + (size_t)r * D + col) = w;
        }
    }
}

__device__ __forceinline__ void p2_gemm1(const Ctx& c) {
    const bf16* H = (const bf16*)(c.ws + WS_H); const float* w_in = c.in[10];
    constexpr int NCG = DIN / 64, NRG = NT / 8;
    for (int it = c.gw; it < NCG * NRG; it += c.NGW) {
        const int rg = it / NCG, cg = it % NCG, col = cg * 64 + c.lane; const bf16* a = H + (size_t)rg * 8 * D;
        float acc[8] = {0, 0, 0, 0, 0, 0, 0, 0};
        gemm_8x64<D>(a, a + D, a + 2 * D, a + 3 * D, a + 4 * D, a + 5 * D, a + 6 * D, a + 7 * D, w_in, DIN, col, acc);
        bf16* dst = (bf16*)(c.ws + (col < 512 ? WS_XM : (col < 1024 ? WS_Z : WS_U))) + (col & 511);
#pragma unroll
        for (int r = 0; r < 8; ++r) dst[(size_t)(rg * 8 + r) * DM] = (bf16)f2bf(acc[r]);
    }
}

__device__ __forceinline__ void p3_features(const Ctx& c) {
    const bf16* XM = (const bf16*)(c.ws + WS_XM);
    const float* conv_w = c.in[11]; const float* conv_b = c.in[12]; const float* wq = c.in[13]; const float* wk = c.in[14]; const float* wv = c.in[15];
    bf16* Q = (bf16*)(c.ws + WS_Q); bf16* Kb = (bf16*)(c.ws + WS_K); bf16* Vb = (bf16*)(c.ws + WS_V); bf16* ACT = (bf16*)(c.ws + WS_ACT);
    float* IG = (float*)(c.ws + WS_IG); float* LF = (float*)(c.ws + WS_LF);
    const int ch0 = 8 * c.lane;
    for (int r = c.gw; r < NT; r += c.NGW) {
        const bool lat = r < T;
        const bool hasp = lat ? (r > 0) : (r > T), hasn = lat ? (r < T - 1) : (r < NT - 1);
        float xc[8], xp[8], xn[8];
        unpack8(*(const v4u*)(XM + (size_t)r * DM + ch0), xc);
        if (hasp) unpack8(*(const v4u*)(XM + (size_t)(r - 1) * DM + ch0), xp); else { for (int i = 0; i < 8; ++i) xp[i] = 0.f; }
        if (hasn) unpack8(*(const v4u*)(XM + (size_t)(r + 1) * DM + ch0), xn); else { for (int i = 0; i < 8; ++i) xn[i] = 0.f; }
        float act[8], q[8], k[8], v[8];
#pragma unroll
        for (int i = 0; i < 8; ++i) {
            const float y = conv_w[ch0 + i] * xp[i] + conv_w[DM + ch0 + i] * xc[i] + conv_w[2 * DM + ch0 + i] * xn[i] + conv_b[ch0 + i];
            act[i] = siluf(y);
        }
#pragma unroll
        for (int b = 0; b < 2; ++b) {
            const int n = 2 * c.lane + b;
#pragma unroll
            for (int o = 0; o < 4; ++o) {
                float sq = 0.f, sk = 0.f, sv = 0.f;
#pragma unroll
                for (int i = 0; i < 4; ++i) { sq += act[4 * b + i] * wq[n * 16 + i * 4 + o]; sk += act[4 * b + i] * wk[n * 16 + i * 4 + o]; sv += xc[4 * b + i] * wv[n * 16 + i * 4 + o]; }
                q[4 * b + o] = sq; k[4 * b + o] = sk; v[4 * b + o] = sv;
            }
        }
#pragma unroll 1
        for (int d = 0; d < 2; ++d) {
            const float* wd = d ? c.in[18] : c.in[16]; const float* bd = d ? c.in[19] : c.in[17];
            float val = 0.f;
#pragma unroll
            for (int j = 0; j < 8; ++j) {
                float s = 0.f;
#pragma unroll
                for (int i = 0; i < 8; ++i) s += q[i] * wd[(ch0 + i) * 8 + j] + k[i] * wd[(512 + ch0 + i) * 8 + j] + v[i] * wd[(1024 + ch0 + i) * 8 + j];
                s = wave_sum(s) + bd[j];
                val = (c.lane == j) ? s : val;
            }
            if (c.lane < 8) {
                if (c.lane < 4) IG[(size_t)(d * 4 + c.lane) * NT + r] = val; else LF[(size_t)(d * 4 + (c.lane - 4)) * NT + r] = logsigf(val);
            }
        }
        const float qs = 0.08838834764831845f;
        v4u w;
        w.x = pk2(q[0] * qs, q[1] * qs); w.y = pk2(q[2] * qs, q[3] * qs); w.z = pk2(q[4] * qs, q[5] * qs); w.w = pk2(q[6] * qs, q[7] * qs); *(v4u*)(Q + (size_t)r * DM + ch0) = w;
        w.x = pk2(k[0], k[1]); w.y = pk2(k[2], k[3]); w.z = pk2(k[4], k[5]); w.w = pk2(k[6], k[7]); *(v4u*)(Kb + (size_t)r * DM + ch0) = w;
        w.x = pk2(v[0], v[1]); w.y = pk2(v[2], v[3]); w.z = pk2(v[4], v[5]); w.w = pk2(v[6], v[7]); *(v4u*)(Vb + (size_t)r * DM + ch0) = w;
        w.x = pk2(act[0], act[1]); w.y = pk2(act[2], act[3]); w.z = pk2(act[4], act[5]); w.w = pk2(act[6], act[7]); *(v4u*)(ACT + (size_t)r * DM + ch0) = w;
    }
}

__device__ __forceinline__ void p4_summaries(const Ctx& c) {
    const bf16* Kb = (const bf16*)(c.ws + WS_K); const bf16* Vb = (const bf16*)(c.ws + WS_V);
    const float* IG = (const float*)(c.ws + WS_IG); const float* LF = (const float*)(c.ws + WS_LF);
    float* LT = (float*)(c.ws + WS_L); float* NL = (float*)(c.ws + WS_NL); float* AMAX = (float*)(c.ws + WS_AMAX); float* BTOT = (float*)(c.ws + WS_BTOT);
    float* Ks = c.lds; float* Vs = c.lds + 16384; float* lfs = c.lds + 32768; float* as = lfs + 128; float* red = as + 128;
    for (int it = c.bid; it < 2 * NH * NCH; it += c.G) {
        const int d = it / (NH * NCH), h = (it / NCH) % NH, j = it % NCH, r0 = chunk_row0(d, j);
        const float* lf = LF + (size_t)(d * 4 + h) * NT + r0; const float* ig = IG + (size_t)(d * 4 + h) * NT + r0;
        if (c.tid < 128) lfs[c.tid] = lf[c.tid];
        __syncthreads();
        if (c.tid < 128) {
            float b = 0.f, tot = 0.f;
            for (int i = 0; i < 128; ++i) { const float x = lfs[i]; tot += x; if (d == 0 ? (i <= c.tid) : (i >= c.tid)) b += x; }
            as[c.tid] = tot - b + ig[c.tid];
            if (c.tid == 0) red[0] = tot;
        }
        __syncthreads();
        if (c.tid == 0) { float m = as[0]; for (int i = 1; i < 128; ++i) m = fmaxf(m, as[i]); red[1] = m; }
        __syncthreads();
        const float amax = red[1], btot = red[0];
        for (int e = c.tid; e < 128 * 16; e += NTHREADS) {
            const int l = e >> 4, c8 = (e & 15) * 8; const float w = __expf(as[l] - amax);
            float f[8];
            unpack8(*(const v4u*)(Kb + (size_t)(r0 + l) * DM + h * DH + c8), f);
#pragma unroll
            for (int i = 0; i < 8; ++i) Ks[l * 128 + c8 + i] = f[i] * w;
            unpack8(*(const v4u*)(Vb + (size_t)(r0 + l) * DM + h * DH + c8), f);
#pragma unroll
            for (int i = 0; i < 8; ++i) Vs[l * 128 + c8 + i] = f[i];
        }
        __syncthreads();
        {
            const int v = c.tid >> 2, kq = (c.tid & 3) * 32;
            float acc[32];
#pragma unroll
            for (int i = 0; i < 32; ++i) acc[i] = 0.f;
            for (int l = 0; l < 128; ++l) {
                const float vv = Vs[l * 128 + v];
#pragma unroll
                for (int i = 0; i < 32; ++i) acc[i] += Ks[l * 128 + kq + i] * vv;
            }
            float* dst = LT + ((size_t)((d * 4 + h) * NCH + j) * 128 + v) * 128 + kq;
#pragma unroll
            for (int i = 0; i < 32; i += 4) *(f32x4*)(dst + i) = (f32x4){acc[i], acc[i + 1], acc[i + 2], acc[i + 3]};
        }
        if (c.tid < 128) {
            float s = 0.f;
            for (int l = 0; l < 128; ++l) s += Ks[l * 128 + c.tid];
            NL[(size_t)((d * 4 + h) * NCH + j) * 128 + c.tid] = s;
            if (c.tid == 0) { AMAX[(d * 4 + h) * NCH + j] = amax; BTOT[(d * 4 + h) * NCH + j] = btot; }
        }
        __syncthreads();
    }
}

__device__ __forceinline__ void p5_scan(const Ctx& c) {
    const float* LT = (const float*)(c.ws + WS_L); const float* NL = (const float*)(c.ws + WS_NL);
    const float* AMAX = (const float*)(c.ws + WS_AMAX); const float* BTOT = (const float*)(c.ws + WS_BTOT);
    bf16* C0 = (bf16*)(c.ws + WS_C0); float* N0 = (float*)(c.ws + WS_N0); float* M0 = (float*)(c.ws + WS_M0);
    constexpr int PER = 16384 + 128;
    for (int e = c.gtid; e < 8 * PER; e += c.NTHR) {
        const int dh = e / PER, rem = e % PER; const bool isC = rem < 16384; const int idx = isC ? rem : rem - 16384;
        float m = 0.f, val = 0.f;
        for (int j = 0; j < NCH; ++j) {
            if (j >= NCC) {
                if (isC) C0[((size_t)(dh * NCL + (j - NCC))) * 16384 + idx] = (bf16)f2bf(val);
                else N0[(size_t)(dh * NCL + (j - NCC)) * 128 + idx] = val;
                if (rem == 0) M0[dh * NCL + (j - NCC)] = m;
            }
            const float bt = BTOT[dh * NCH + j], am = AMAX[dh * NCH + j];
            const float mn = fmaxf(bt + m, am), dec = __expf(bt + m - mn), sc = __expf(am - mn);
            const float lv = isC ? LT[(size_t)(dh * NCH + j) * 16384 + idx] : NL[(size_t)(dh * NCH + j) * 128 + idx];
            val = dec * val + sc * lv; m = mn;
        }
    }
}

__device__ __forceinline__ void p6_fourier_a(const Ctx& c) {
    const bf16* U = (const bf16*)(c.ws + WS_U); bf16* FB = (bf16*)c.out;
    float* Us = c.lds; float* ct = c.lds + 8192; float* st = ct + 128;
    if (c.tid < 128) { ct[c.tid] = cospif((float)c.tid * (1.f / 64.f)); st[c.tid] = sinpif((float)c.tid * (1.f / 64.f)); }
    __syncthreads();
    for (int it = c.bid; it < 128 * 8; it += c.G) {
        const int t2 = it >> 3, chg = it & 7;
        for (int e = c.tid; e < 128 * 8; e += NTHREADS) {
            const int t1 = e >> 3, c8 = (e & 7) * 8; float f[8];
            unpack8(*(const v4u*)(U + (size_t)(128 * t1 + t2) * DM + chg * 64 + c8), f);
#pragma unroll
            for (int i = 0; i < 8; ++i) Us[t1 * 64 + c8 + i] = f[i];
        }
        __syncthreads();
        const int k1 = c.tid >> 2, cq = (c.tid & 3) * 16;
        float ar[16], ai[16];
#pragma unroll
        for (int i = 0; i < 16; ++i) { ar[i] = 0.f; ai[i] = 0.f; }
        for (int t1 = 0; t1 < 128; ++t1) {
            const int idx = (k1 * t1) & 127; const float cc = ct[idx], ss = st[idx];
#pragma unroll
            for (int i = 0; i < 16; ++i) { const float u = Us[t1 * 64 + cq + i]; ar[i] += cc * u; ai[i] -= ss * u; }
        }
        const float ph = (float)(k1 * t2) * (1.f / 8192.f); const float tc = cospif(ph), ts = sinpif(ph);
        bf16* dr = FB + ((size_t)(k1 * 128 + t2) * 2) * 512 + chg * 64 + cq; bf16* di = dr + 512;
#pragma unroll
        for (int i = 0; i < 16; i += 2) {
            const float br0 = ar[i] * tc + ai[i] * ts, bi0 = ai[i] * tc - ar[i] * ts, br1 = ar[i + 1] * tc + ai[i + 1] * ts, bi1 = ai[i + 1] * tc - ar[i + 1] * ts;
            *(unsigned*)(dr + i) = pk2(br0, br1); *(unsigned*)(di + i) = pk2(bi0, bi1);
        }
        __syncthreads();
    }
}

__device__ __forceinline__ void p7a_fourier_c(const Ctx& c) {
    const bf16* FB = (const bf16*)c.out; bf16* X = (bf16*)((unsigned char*)c.out + 32 * MiB);
    float* Brs = c.lds; float* Bis = c.lds + 8192; float* ct = c.lds + 16384; float* st = ct + 128;
    if (c.tid < 128) { ct[c.tid] = cospif((float)c.tid * (1.f / 64.f)); st[c.tid] = sinpif((float)c.tid * (1.f / 64.f)); }
    __syncthreads();
    for (int it = c.bid; it < 128 * 8; it += c.G) {
        const int k1 = it >> 3, chg = it & 7;
        for (int e = c.tid; e < 128 * 2 * 8; e += NTHREADS) {
            const int t2 = e >> 4, ri = (e >> 3) & 1, c8 = (e & 7) * 8; float f[8];
            unpack8(*(const v4u*)(FB + ((size_t)(k1 * 128 + t2) * 2 + ri) * 512 + chg * 64 + c8), f);
            float* dst = (ri ? Bis : Brs) + t2 * 64 + c8;
#pragma unroll
            for (int i = 0; i < 8; ++i) dst[i] = f[i];
        }
        __syncthreads();
        const int k2 = c.tid >> 2, cq = (c.tid & 3) * 16;
        float xr[16], xi[16];
#pragma unroll
        for (int i = 0; i < 16; ++i) { xr[i] = 0.f; xi[i] = 0.f; }
        for (int t2 = 0; t2 < 128; ++t2) {
            const int idx = (k2 * t2) & 127; const float cc = ct[idx], ss = st[idx];
#pragma unroll
            for (int i = 0; i < 16; ++i) { const float br = Brs[t2 * 64 + cq + i], bi = Bis[t2 * 64 + cq + i]; xr[i] += cc * br + ss * bi; xi[i] += cc * bi - ss * br; }
        }
        bf16* dr = X + ((size_t)(k1 + 128 * k2) * 2) * 512 + chg * 64 + cq; bf16* di = dr + 512;
#pragma unroll
        for (int i = 0; i < 16; i += 2) { *(unsigned*)(dr + i) = pk2(xr[i], xr[i + 1]); *(unsigned*)(di + i) = pk2(xi[i], xi[i + 1]); }
        __syncthreads();
    }
}

__device__ __forceinline__ void p7b_fourier_mix(const Ctx& c) {
    const bf16* X = (const bf16*)((unsigned char*)c.out + 32 * MiB); const float* Gm = (const float*)(c.ws + WS_G); bf16* A2 = (bf16*)(c.ws + WS_H);
    for (int it = c.gw; it < (T / 8) * 8; it += c.NGW) {
        const int rg = it >> 3, g = (it >> 1) & 3, hf = it & 1, col = hf * 64 + c.lane;
        const bf16* a = X + (size_t)rg * 8 * 1024 + g * 128;
        float acc[8] = {0, 0, 0, 0, 0, 0, 0, 0};
        gemm_8x64<128>(a, a + 1024, a + 2048, a + 3072, a + 4096, a + 5120, a + 6144, a + 7168, Gm + (size_t)g * 256 * 128, 128, col, acc);
        a += 512;
        gemm_8x64<128>(a, a + 1024, a + 2048, a + 3072, a + 4096, a + 5120, a + 6144, a + 7168, Gm + (size_t)g * 256 * 128 + 128 * 128, 128, col, acc);
#pragma unroll
        for (int r = 0; r < 8; ++r) A2[(size_t)(rg * 8 + r) * D + 512 + g * 128 + col] = (bf16)f2bf(acc[r]);
    }
}

__device__ __forceinline__ void p8_mlstm_out(const Ctx& c) {
    const bf16* Q = (const bf16*)(c.ws + WS_Q); const bf16* Kb = (const bf16*)(c.ws + WS_K); const bf16* Vb = (const bf16*)(c.ws + WS_V);
    const bf16* ACT = (const bf16*)(c.ws + WS_ACT); const bf16* Z = (const bf16*)(c.ws + WS_Z);
    const float* IG = (const float*)(c.ws + WS_IG); const float* LF = (const float*)(c.ws + WS_LF);
    const bf16* C0 = (const bf16*)(c.ws + WS_C0); const float* N0 = (const float*)(c.ws + WS_N0); const float* M0 = (const float*)(c.ws + WS_M0);
    const float* norm_w = c.in[20]; const float* skip = c.in[21];
    bf16* A2 = (bf16*)(c.ws + WS_H);
    constexpr int KS = 136;
    bf16* Ks = (bf16*)c.lds; bf16* Vs = Ks + 128 * KS;
    float* S = c.lds + (2 * 128 * KS * 2) / 4;
    float* bs = S + 16384; float* igs = bs + 128; float* lfs = igs + 128;
    const int t = c.tid >> 2, qd = c.tid & 3;
    for (int it = c.bid; it < NH * NCL; it += c.G) {
        const int h = it / NCL, ck = it % NCL, r0 = ck * CH;
        for (int e = c.tid; e < 128 * 16; e += NTHREADS) {
            const int l = e >> 4, c8 = (e & 15) * 8;
            *(v4u*)(Ks + l * KS + c8) = *(const v4u*)(Kb + (size_t)(r0 + l) * DM + h * DH + c8);
            *(v4u*)(Vs + l * KS + c8) = *(const v4u*)(Vb + (size_t)(r0 + l) * DM + h * DH + c8);
        }
        float hsum[32];
#pragma unroll
        for (int i = 0; i < 32; ++i) hsum[i] = 0.f;
        const bf16* qrow = Q + (size_t)(r0 + t) * DM + h * DH;
        for (int d = 0; d < 2; ++d) {
            const int sidx = (d * 4 + h) * NCL + (d == 0 ? ck : NCL - 1 - ck);
            if (c.tid < 128) { lfs[c.tid] = LF[(size_t)(d * 4 + h) * NT + r0 + c.tid]; igs[c.tid] = IG[(size_t)(d * 4 + h) * NT + r0 + c.tid]; }
            __syncthreads();
            if (c.tid < 128) {
                float b = 0.f;
                for (int i = 0; i < 128; ++i) { if (d == 0 ? (i <= c.tid) : (i >= c.tid)) b += lfs[i]; }
                bs[c.tid] = b;
            }
            __syncthreads();
            const float m0 = M0[sidx], bt = bs[t];
            float acc[32];
#pragma unroll
            for (int i = 0; i < 32; ++i) acc[i] = 0.f;
            for (int kc = 0; kc < 16; ++kc) {
                float qf[8]; unpack8(*(const v4u*)(qrow + kc * 8), qf);
#pragma unroll
                for (int i = 0; i < 32; ++i) {
                    float kf[8]; unpack8(*(const v4u*)(Ks + (32 * qd + i) * KS + kc * 8), kf);
#pragma unroll
                    for (int u = 0; u < 8; ++u) acc[i] += qf[u] * kf[u];
                }
            }
            float mloc = -INFINITY;
            float ld[32];
#pragma unroll
            for (int i = 0; i < 32; ++i) {
                const int s = 32 * qd + i; const bool ok = d == 0 ? (s <= t) : (s >= t);
                ld[i] = ok ? bt - bs[s] + igs[s] : -INFINITY; mloc = fmaxf(mloc, ld[i]);
            }
            mloc = fmaxf(mloc, __shfl_xor(mloc, 1)); mloc = fmaxf(mloc, __shfl_xor(mloc, 2));
            const float mt = fmaxf(bt + m0, mloc);
            float rs = 0.f;
#pragma unroll
            for (int i = 0; i < 32; ++i) { const float sv = acc[i] * __expf(ld[i] - mt); S[t * 128 + 32 * qd + i] = sv; rs += sv; }
            rs += __shfl_xor(rs, 1); rs += __shfl_xor(rs, 2);
            __syncthreads();
            float num[32];
#pragma unroll
            for (int i = 0; i < 32; ++i) num[i] = 0.f;
            for (int s = 0; s < 128; ++s) {
                const float sv = S[t * 128 + s];
#pragma unroll
                for (int i8 = 0; i8 < 4; ++i8) {
                    float vf[8]; unpack8(*(const v4u*)(Vs + s * KS + 32 * qd + i8 * 8), vf);
#pragma unroll
                    for (int u = 0; u < 8; ++u) num[i8 * 8 + u] += sv * vf[u];
                }
            }
            float qc[32];
#pragma unroll
            for (int i = 0; i < 32; ++i) qc[i] = 0.f;
            const bf16* c0 = C0 + (size_t)sidx * 16384;
            for (int kc = 0; kc < 16; ++kc) {
                float qf[8]; unpack8(*(const v4u*)(qrow + kc * 8), qf);
#pragma unroll
                for (int i = 0; i < 32; ++i) {
                    float cf[8]; unpack8(*(const v4u*)(c0 + (size_t)(32 * qd + i) * 128 + kc * 8), cf);
#pragma unroll
                    for (int u = 0; u < 8; ++u) qc[i] += qf[u] * cf[u];
                }
            }
            float qn = 0.f;
            {
                const float* n0 = N0 + (size_t)sidx * 128 + 32 * qd;
#pragma unroll
                for (int k8 = 0; k8 < 4; ++k8) {
                    float qf[8]; unpack8(*(const v4u*)(qrow + 32 * qd + k8 * 8), qf);
#pragma unroll
                    for (int u = 0; u < 8; ++u) qn += qf[u] * n0[k8 * 8 + u];
                }
            }
            qn += __shfl_xor(qn, 1); qn += __shfl_xor(qn, 2);
            const float wi = __expf(bt + m0 - mt), nq = rs + wi * qn, den = fmaxf(fabsf(nq), __expf(-mt)), rden = 1.f / den;
#pragma unroll
            for (int i = 0; i < 32; ++i) hsum[i] += (num[i] + wi * qc[i]) * rden;
            __syncthreads();
        }
        float sm = 0.f;
#pragma unroll
        for (int i = 0; i < 32; ++i) sm += hsum[i];
        sm += __shfl_xor(sm, 1); sm += __shfl_xor(sm, 2);
        const float mu = sm * (1.f / 128.f);
        float sv = 0.f;
#pragma unroll
        for (int i = 0; i < 32; ++i) { const float dlt = hsum[i] - mu; sv += dlt * dlt; }
        sv += __shfl_xor(sv, 1); sv += __shfl_xor(sv, 2);
        const float rstd = rsqrtf(sv * (1.f / 128.f) + EPS);
        const int col0 = h * DH + 32 * qd; const size_t row = (size_t)(r0 + t);
#pragma unroll
        for (int i8 = 0; i8 < 4; ++i8) {
            float af[8], zf[8], o[8];
            unpack8(*(const v4u*)(ACT + row * DM + col0 + i8 * 8), af); unpack8(*(const v4u*)(Z + row * DM + col0 + i8 * 8), zf);
#pragma unroll
            for (int u = 0; u < 8; ++u) {
                const int cc = col0 + i8 * 8 + u;
                const float hn = (hsum[i8 * 8 + u] - mu) * rstd * norm_w[cc];
                o[u] = (hn + skip[cc] * af[u]) * siluf(zf[u]);
            }
            v4u w; w.x = pk2(o[0], o[1]); w.y = pk2(o[2], o[3]); w.z = pk2(o[4], o[5]); w.w = pk2(o[6], o[7]);
            *(v4u*)(A2 + row * D + col0 + i8 * 8) = w;
        }
        __syncthreads();
    }
}

__device__ __forceinline__ void p9_outproj(const Ctx& c) {
    const bf16* A2 = (const bf16*)(c.ws + WS_H); const float* w_out = c.in[23]; float* Y = (float*)(c.ws + WS_Y);
    constexpr int NCG = D / 64, NRG = T / 8;
    for (int it = c.gw; it < NCG * NRG; it += c.NGW) {
        const int rg = it / NCG, cg = it % NCG, col = cg * 64 + c.lane; const bf16* a = A2 + (size_t)rg * 8 * D;
        float acc[8] = {0, 0, 0, 0, 0, 0, 0, 0};
        gemm_8x64<D>(a, a + D, a + 2 * D, a + 3 * D, a + 4 * D, a + 5 * D, a + 6 * D, a + 7 * D, w_out, D, col, acc);
#pragma unroll
        for (int r = 0; r < 8; ++r) Y[(size_t)(rg * 8 + r) * D + col] = acc[r];
    }
}

__device__ __forceinline__ void p10_token(const Ctx& c) {
    const float* x = c.in[0]; const float* g_post = c.in[7]; const float* g_ffn = c.in[8];
    const float* wrg = c.in[24]; const float* brg = c.in[25]; const float* wre = c.in[26]; const float* bre = c.in[27];
    const float* mod = (const float*)(c.ws + WS_MOD);
    const float* posR = (const float*)(c.ws + WS_POSR); const float* posC = (const float*)(c.ws + WS_POSC);
    float* Y = (float*)(c.ws + WS_Y); bf16* H2 = (bf16*)(c.ws + WS_H); int* RE = (int*)(c.ws + WS_RE); float* RW = (float*)(c.ws + WS_RW);
    for (int r = c.gw; r < T; r += c.NGW) {
        f32x4 xv[4], yv[4]; float ss = 0.f;
#pragma unroll
        for (int j = 0; j < 4; ++j) {
            const int col = 256 * j + 4 * c.lane;
            const float* pp = col < 512 ? posR + (r >> 6) * 512 + col : posC + (r & 63) * 512 + (col - 512);
            xv[j] = *(const f32x4*)(x + (size_t)r * D + col) + *(const f32x4*)pp;
            yv[j] = *(const f32x4*)(Y + (size_t)r * D + col);
            ss += yv[j].x * yv[j].x + yv[j].y * yv[j].y + yv[j].z * yv[j].z + yv[j].w * yv[j].w;
        }
        const float rinv = rsqrtf(wave_sum(ss) * (1.f / D) + EPS);
        float s2 = 0.f;
#pragma unroll
        for (int j = 0; j < 4; ++j) {
            const int col = 256 * j + 4 * c.lane;
            const f32x4 gg = *(const f32x4*)(g_post + col), g1 = *(const f32x4*)(mod + 2048 + col);
            xv[j] = xv[j] + g1 * (yv[j] * rinv * gg);
            *(f32x4*)(c.out + (size_t)r * D + col) = xv[j];
            *(f32x4*)(Y + (size_t)r * D + col) = (f32x4){0.f, 0.f, 0.f, 0.f};
            s2 += xv[j].x * xv[j].x + xv[j].y * xv[j].y + xv[j].z * xv[j].z + xv[j].w * xv[j].w;
        }
        const float rinv2 = rsqrtf(wave_sum(s2) * (1.f / D) + EPS);
        float lg[20];
#pragma unroll
        for (int i = 0; i < 20; ++i) lg[i] = 0.f;
#pragma unroll
        for (int j = 0; j < 4; ++j) {
            const int col = 256 * j + 4 * c.lane;
            const f32x4 gg = *(const f32x4*)(g_ffn + col), sh = *(const f32x4*)(mod + 3072 + col), sc = *(const f32x4*)(mod + 4096 + col);
            const f32x4 hv = xv[j] * rinv2 * gg * (sc + 1.f) + sh;
            uint2 w; w.x = pk2(hv.x, hv.y); w.y = pk2(hv.z, hv.w);
            *(uint2*)(H2 + (size_t)r * D + col) = w;
            const float he[4] = {hv.x, hv.y, hv.z, hv.w};
#pragma unroll
            for (int e = 0; e < 4; ++e) {
                const f32x4 wg4 = *(const f32x4*)(wrg + (size_t)(col + e) * 4);
                lg[0] += he[e] * wg4.x; lg[1] += he[e] * wg4.y; lg[2] += he[e] * wg4.z; lg[3] += he[e] * wg4.w;
#pragma unroll
                for (int q4 = 0; q4 < 4; ++q4) {
                    const f32x4 we4 = *(const f32x4*)(wre + (size_t)(col + e) * 16 + q4 * 4);
                    lg[4 + q4 * 4] += he[e] * we4.x; lg[5 + q4 * 4] += he[e] * we4.y; lg[6 + q4 * 4] += he[e] * we4.z; lg[7 + q4 * 4] += he[e] * we4.w;
                }
            }
        }
#pragma unroll
        for (int i = 0; i < 20; ++i) lg[i] = wave_sum(lg[i]);
        if (c.lane == 0) {
            float gl[4];
#pragma unroll
            for (int i = 0; i < 4; ++i) gl[i] = lg[i] + brg[i];
            int gs = 0; float gm = gl[0];
#pragma unroll
            for (int i = 1; i < 4; ++i) if (gl[i] > gm) { gm = gl[i]; gs = i; }
            float den = 0.f;
#pragma unroll
            for (int i = 0; i < 4; ++i) den += __expf(gl[i] - gm);
            const float psel = 1.f / den;
            float el[4];
#pragma unroll
            for (int i = 0; i < 4; ++i) {
                float v = 0.f;
#pragma unroll
                for (int g2 = 0; g2 < 4; ++g2) v = (g2 == gs) ? lg[4 + g2 * 4 + i] + bre[g2 * 4 + i] : v;
                el[i] = v;
            }
            int i1 = 0; float em1 = el[0];
#pragma unroll
            for (int i = 1; i < 4; ++i) if (el[i] > em1) { em1 = el[i]; i1 = i; }
            int i2 = -1; float em2 = -INFINITY;
#pragma unroll
            for (int i = 0; i < 4; ++i) if (i != i1 && el[i] > em2) { em2 = el[i]; i2 = i; }
            const float e2 = __expf(em2 - em1), w1 = psel / (1.f + e2), w2 = psel * e2 / (1.f + e2);
            RE[2 * r] = gs * 4 + i1; RE[2 * r + 1] = gs * 4 + i2; RW[2 * r] = w1; RW[2 * r + 1] = w2;
        }
    }
}

__device__ __forceinline__ void p11_moe(const Ctx& c) {
    const bf16* H2 = (const bf16*)(c.ws + WS_H); const int* RE = (const int*)(c.ws + WS_RE); const float* RW = (const float*)(c.ws + WS_RW);
    const float* w_gate = c.in[28]; const float* w_up = c.in[29]; const float* w_down = c.in[30]; float* YM = (float*)(c.ws + WS_Y);
    float* Hs = c.lds;
    float* As = c.lds + 8192;
    int* ltok = (int*)(c.lds + 12288); float* lw = c.lds + 12288 + 128; int* cnt = (int*)(c.lds + 12288 + 256);
    for (int it = c.bid; it < NE * (T / 128); it += c.G) {
        const int e = it / (T / 128), chunk = it % (T / 128);
        if (c.tid == 0) *cnt = 0;
        __syncthreads();
        if (c.tid < 128) {
            const int tok = chunk * 128 + c.tid; const int e0 = RE[2 * tok], e1 = RE[2 * tok + 1];
            if (e0 == e || e1 == e) { const int p = atomicAdd(cnt, 1); ltok[p] = tok; lw[p] = (e0 == e) ? RW[2 * tok] : RW[2 * tok + 1]; }
        }
        __syncthreads();
        const int n = *cnt;
        const float* Wg = w_gate + (size_t)e * D * DE; const float* Wu = w_up + (size_t)e * D * DE; const float* Wd = w_down + (size_t)e * DE * D;
        for (int base = 0; base < n; base += 8) {
            for (int idx = c.tid; idx < 8 * 128; idx += NTHREADS) {
                const int i = idx >> 7, c8 = (idx & 127) * 8; float f[8];
                if (base + i < n) unpack8(*(const v4u*)(H2 + (size_t)ltok[base + i] * D + c8), f); else { for (int u = 0; u < 8; ++u) f[u] = 0.f; }
#pragma unroll
                for (int u = 0; u < 8; ++u) Hs[i * 1024 + c8 + u] = f[u];
            }
            __syncthreads();
            {
                float g[8], u[8];
#pragma unroll
                for (int i = 0; i < 8; ++i) { g[i] = 0.f; u[i] = 0.f; }
                for (int k = 0; k < D; ++k) {
                    const float wg = Wg[(size_t)k * DE + c.tid], wu = Wu[(size_t)k * DE + c.tid];
#pragma unroll
                    for (int i = 0; i < 8; ++i) { const float hv = Hs[i * 1024 + k]; g[i] += hv * wg; u[i] += hv * wu; }
                }
#pragma unroll
                for (int i = 0; i < 8; ++i) As[i * 512 + c.tid] = (base + i < n) ? siluf(g[i]) * u[i] * lw[base + i] : 0.f;
            }
            __syncthreads();
            {
                float y0[8], y1[8];
#pragma unroll
                for (int i = 0; i < 8; ++i) { y0[i] = 0.f; y1[i] = 0.f; }
                for (int j = 0; j < DE; ++j) {
                    const float w0 = Wd[(size_t)j * D + c.tid], w1 = Wd[(size_t)j * D + 512 + c.tid];
#pragma unroll
                    for (int i = 0; i < 8; ++i) { const float av = As[i * 512 + j]; y0[i] += av * w0; y1[i] += av * w1; }
                }
#pragma unroll
                for (int i = 0; i < 8; ++i) if (base + i < n) { atomicAdd(YM + (size_t)ltok[base + i] * D + c.tid, y0[i]); atomicAdd(YM + (size_t)ltok[base + i] * D + 512 + c.tid, y1[i]); }
            }
            __syncthreads();
        }
        __syncthreads();
    }
}

__device__ __forceinline__ void p12_final(const Ctx& c) {
    const float* g_post = c.in[9]; const float* mod = (const float*)(c.ws + WS_MOD); const float* YM = (const float*)(c.ws + WS_Y);
    for (int r = c.gw; r < T; r += c.NGW) {
        f32x4 yv[4]; float ss = 0.f;
#pragma unroll
        for (int j = 0; j < 4; ++j) { const int col = 256 * j + 4 * c.lane; yv[j] = *(const f32x4*)(YM + (size_t)r * D + col); ss += yv[j].x * yv[j].x + yv[j].y * yv[j].y + yv[j].z * yv[j].z + yv[j].w * yv[j].w; }
        const float rinv = rsqrtf(wave_sum(ss) * (1.f / D) + EPS);
#pragma unroll
        for (int j = 0; j < 4; ++j) {
            const int col = 256 * j + 4 * c.lane;
            const f32x4 gg = *(const f32x4*)(g_post + col), g2 = *(const f32x4*)(mod + 5120 + col);
            f32x4* o = (f32x4*)(c.out + (size_t)r * D + col);
            *o = *o + g2 * (yv[j] * rinv * gg);
        }
    }
}

#define LAS __attribute__((address_space(3)))
#define XB_TMO      128
#define XB_XCNT(j)  (256  + 64 * (j))
#define XB_XSUB(j)  (1280 + 64 * (j))
#define XB_XGEN(j)  (2304 + 64 * (j))
#define XB_TOP      3328
#define XB_TOPGEN   3392
#define XCD_BAR_WORDS 3456
#define XB_SPIN_CAP (1u << 18)
__device__ __forceinline__ unsigned xb_ld(unsigned* p)              { return __hip_atomic_load(p, __ATOMIC_RELAXED, __HIP_MEMORY_SCOPE_AGENT); }
__device__ __forceinline__ unsigned xb_add(unsigned* p, unsigned v) { return __hip_atomic_fetch_add(p, v, __ATOMIC_RELAXED, __HIP_MEMORY_SCOPE_AGENT); }
__device__ __forceinline__ unsigned xb_xcc_id() { return (unsigned)__builtin_amdgcn_s_getreg((3 << 11) | 20) & 0xFu; }
#define XB_SPIN(cond, bar) do { unsigned _sp = 0; while (cond) { __builtin_amdgcn_s_sleep(1); \
    if ((++_sp & 255u) == 0u) { if (xb_ld(&(bar)[XB_TMO])) break; if (_sp > XB_SPIN_CAP) { atomicAdd(&(bar)[XB_TMO], 1u); break; } } } } while (0)
struct XcdBarrier { unsigned* bar; unsigned x; volatile LAS unsigned* st; };
__device__ __forceinline__ XcdBarrier xcd_barrier_post(unsigned* bar, volatile LAS unsigned* st) {
    XcdBarrier b; b.bar = bar; b.x = xb_xcc_id(); b.st = st;
    if (threadIdx.x == 0) (void)xb_add(&bar[XB_XCNT(b.x)], 1u);
    return b;
}
__device__ __forceinline__ void xcd_barrier_complete(unsigned* bar, unsigned x, unsigned& nloc, unsigned& nx) {
    const unsigned G = gridDim.x * gridDim.y * gridDim.z;
    unsigned sum, cnt, mine, sp = 0u;
    for (;;) {
        sum = 0u; cnt = 0u; mine = 0u;
#pragma unroll
        for (unsigned j = 0; j < 16; ++j) { const unsigned c = xb_ld(&bar[XB_XCNT(j)]); sum += c; cnt += (c > 0u) ? 1u : 0u; mine = (j == x) ? c : mine; }
        if (sum == G) break;
        __builtin_amdgcn_s_sleep(1);
        if ((++sp & 255u) == 0u) { if (xb_ld(&bar[XB_TMO])) break; if (sp > XB_SPIN_CAP) { atomicAdd(&bar[XB_TMO], 1u); break; } }
    }
    nloc = mine > 0u ? mine : 1u; nx = cnt > 0u ? cnt : 1u;
}
__device__ __forceinline__ void xcd_barrier(const XcdBarrier& b) {
    asm volatile("s_waitcnt vmcnt(0)" ::: "memory");
    __syncthreads();
    if (threadIdx.x == 0) {
        unsigned* bar = b.bar;
        __builtin_amdgcn_s_waitcnt(0);
        unsigned nloc = b.st[0], nx = b.st[1];
        if (nloc == 0u) { xcd_barrier_complete(bar, b.x, nloc, nx); b.st[0] = nloc; b.st[1] = nx; }
        const unsigned old = xb_add(&bar[XB_XSUB(b.x)], 1u);
        const unsigned gen = old / nloc;
        if (old + 1u == (gen + 1u) * nloc) {
            __builtin_amdgcn_fence(__ATOMIC_RELEASE, "agent");
            asm volatile("s_waitcnt vmcnt(0)" ::: "memory");
            const unsigned og = xb_add(&bar[XB_TOP], 1u);
            const unsigned tg = og / nx;
            if (og + 1u == (tg + 1u) * nx) xb_add(&bar[XB_TOPGEN], 1u);
            else XB_SPIN(xb_ld(&bar[XB_TOPGEN]) == tg, bar);
            __builtin_amdgcn_fence(__ATOMIC_ACQUIRE, "agent");
            xb_add(&bar[XB_XGEN(b.x)], 1u);
            asm volatile("s_waitcnt vmcnt(0)" ::: "memory");
        } else {
            XB_SPIN(xb_ld(&bar[XB_XGEN(b.x)]) == gen, bar);
            __builtin_amdgcn_fence(__ATOMIC_ACQUIRE, "agent");
            asm volatile("s_waitcnt vmcnt(0)" ::: "memory");
        }
    }
    __syncthreads();
}

#ifndef MK_CG_SYNC
#define MK_CG_SYNC 1
#endif
constexpr int MISC_OFF = LDS_BYTES - 256;
__global__ void __launch_bounds__(NTHREADS, 2) fwd_kernel(Args a) {
    extern __shared__ __attribute__((aligned(16))) unsigned char lds_raw[];
    Ctx c;
    c.tid = threadIdx.x; c.lane = c.tid & 63; c.wave = __builtin_amdgcn_readfirstlane(c.tid >> 6);
    c.G = gridDim.x; c.bid = blockIdx.x; c.gw = c.bid * NWAVES + c.wave; c.NGW = c.G * NWAVES; c.gtid = c.bid * NTHREADS + c.tid; c.NTHR = c.G * NTHREADS;
    c.ws = a.ws; c.out = a.out; c.in = a.in; c.lds = (float*)lds_raw;
#if MK_CG_SYNC
    cooperative_groups::grid_group grid = cooperative_groups::this_grid();
#define GRID_BAR() do { grid.sync(); } while (0)
#else
    volatile LAS unsigned* misc = (volatile LAS unsigned*)((LAS unsigned char*)lds_raw + MISC_OFF);
    if (c.tid < 64) misc[c.tid] = 0u;
    __syncthreads();
    const XcdBarrier bar = xcd_barrier_post((unsigned*)(a.ws + WS_CTL) + 4096, misc + 8);
#define GRID_BAR() do { xcd_barrier(bar); } while (0)
#endif
    p0_prologue(c);            GRID_BAR();
    p1_hrows(c);               GRID_BAR();
    p2_gemm1(c);               GRID_BAR();
    p3_features(c); p6_fourier_a(c);   GRID_BAR();
    p4_summaries(c);           GRID_BAR();
    p5_scan(c); p7a_fourier_c(c);      GRID_BAR();
    p7b_fourier_mix(c); p8_mlstm_out(c);   GRID_BAR();
    p9_outproj(c);             GRID_BAR();
    p10_token(c);              GRID_BAR();
    p11_moe(c);                GRID_BAR();
    p12_final(c);
}

extern "C" void kernel_launch(void* const* d_in, const int* in_sizes, int n_in, void* d_out, int out_size, void* d_ws, size_t ws_size, hipStream_t stream) {
    static int grid = 0;
    if (grid == 0) {
        if (n_in != 31 || out_size != T * D || ws_size < 256 * MiB) { fprintf(stderr, "kernel_launch: unexpected shapes n_in %d out %d ws %zu\n", n_in, out_size, ws_size); grid = -1; return; }
        int dev = 0, cus = 0, per_cu = 0;
        (void)hipGetDevice(&dev); (void)hipDeviceGetAttribute(&cus, hipDeviceAttributeMultiprocessorCount, dev);
        if (hipFuncSetAttribute((const void*)fwd_kernel, hipFuncAttributeMaxDynamicSharedMemorySize, LDS_BYTES) != hipSuccess) { fprintf(stderr, "kernel_launch: hipFuncSetAttribute failed\n"); grid = -1; return; }
        if (hipOccupancyMaxActiveBlocksPerMultiprocessor(&per_cu, (const void*)fwd_kernel, NTHREADS, LDS_BYTES) != hipSuccess || per_cu < 1) { fprintf(stderr, "kernel_launch: occupancy query says %d blocks per CU\n", per_cu); (void)hipGetLastError(); per_cu = 1; }
        grid = (cus > 0 ? cus : 256);
        fprintf(stderr, "kernel_launch: cus %d occupancy %d grid %d\n", cus, per_cu, grid);
    }
    if (grid < 0) return;
    (void)hipMemsetAsync((char*)d_ws + WS_CTL, 0, 65536, stream);
    Args a{};
    for (int i = 0; i < 31; ++i) a.in[i] = (const float*)d_in[i];
    a.out = (float*)d_out; a.ws = (unsigned char*)d_ws; a.ph_lo = 0; a.ph_hi = 0;
    void* kargs[] = {&a};
    hipError_t e = hipLaunchCooperativeKernel((const void*)fwd_kernel, dim3(grid), dim3(NTHREADS), kargs, LDS_BYTES, stream);
    if (e != hipSuccess) fprintf(stderr, "kernel_launch: cooperative launch failed: %s (grid %d)\n", hipGetErrorString(e), grid);
}
```

```cpp
#include <hip/hip_runtime.h>
#include <hip/hip_cooperative_groups.h>
#include <cstdio>

typedef unsigned short bf16;
typedef unsigned v4u __attribute__((ext_vector_type(4)));
typedef float f32x4 __attribute__((ext_vector_type(4)));

constexpr int D = 1024, T = 16384, TC = 256, NT = T + TC;
constexpr int DM = 512, NH = 4, DH = 128, CH = 128, NCL = T / CH, NCC = TC / CH, NCH = NCL + NCC;
constexpr int DIN = 1536, NE = 16, DE = 512;
constexpr float EPS = 1e-6f;
constexpr int NTHREADS = 512, NWAVES = 8;
constexpr int LDS_BYTES = 147456;

constexpr size_t MiB = 1u << 20;
constexpr size_t WS_CTL = 0;
constexpr size_t WS_MOD = 1 * MiB;
constexpr size_t WS_MODC = 1 * MiB + 32768;
constexpr size_t WS_POSR = 1 * MiB + 65536;
constexpr size_t WS_POSC = WS_POSR + 256 * 512 * 4;
constexpr size_t WS_G = 2 * MiB;
constexpr size_t WS_IG = 3 * MiB;
constexpr size_t WS_LF = 4 * MiB;
constexpr size_t WS_AMAX = 5 * MiB;
constexpr size_t WS_BTOT = 5 * MiB + 8192;
constexpr size_t WS_M0 = 5 * MiB + 16384;
constexpr size_t WS_NL = 5 * MiB + 65536;
constexpr size_t WS_N0 = 6 * MiB;
constexpr size_t WS_RE = 7 * MiB;
constexpr size_t WS_RW = 7 * MiB + 256 * 1024;
constexpr size_t WS_H = 13 * MiB;
constexpr size_t WS_XM = 46 * MiB;
constexpr size_t WS_U = WS_XM + (size_t)NT * 1024;
constexpr size_t WS_Z = 79 * MiB;
constexpr size_t WS_C0 = 46 * MiB;
constexpr size_t WS_Q = 96 * MiB, WS_K = WS_Q + (size_t)NT * 1024, WS_V = WS_K + (size_t)NT * 1024, WS_ACT = WS_V + (size_t)NT * 1024;
constexpr size_t WS_L = 163 * MiB;
constexpr size_t WS_Y = 96 * MiB;
static_assert(WS_U + (size_t)NT * 1024 <= WS_Z && WS_Z + (size_t)NT * 1024 <= WS_Q && WS_ACT + (size_t)NT * 1024 <= WS_L && WS_L + 65 * MiB <= 256 * MiB, "ws map");
static_assert(WS_C0 + 32 * MiB <= WS_Z && WS_Y + 64 * MiB <= WS_L && WS_H + (size_t)NT * 2048 <= WS_XM, "ws map 2");
constexpr size_t WS_WIN_T = 8 * MiB;
constexpr size_t WS_WOUT_T = 11 * MiB;
constexpr size_t WS_WGU_T = 168 * MiB;
constexpr size_t WS_WD_T = 200 * MiB;
constexpr size_t WS_ASORT = 96 * MiB;
constexpr size_t WS_YROW = 96 * MiB;
constexpr size_t WS_ACTS = 46 * MiB;
constexpr size_t WS_RS = 7 * MiB + 512 * 1024;
constexpr size_t WS_ROWW = 216 * MiB;
constexpr int CW_CNT = 8192;
static_assert(WS_ASORT + 72 * MiB <= WS_WGU_T && WS_WD_T + 16 * MiB <= WS_ROWW && WS_ACTS + 36 * MiB <= WS_ASORT, "ws map 3");

#define LAS __attribute__((address_space(3)))
struct Args { const float* in[31]; float* out; unsigned char* ws; int ph_lo, ph_hi; };

__device__ __forceinline__ float bf2f(unsigned b) { return __uint_as_float(b << 16); }
__device__ __forceinline__ unsigned f2bf(float f) { unsigned u = __float_as_uint(f); return (u + 0x7fffu + ((u >> 16) & 1u)) >> 16; }
__device__ __forceinline__ unsigned pk2(float lo, float hi) { return f2bf(lo) | (f2bf(hi) << 16); }
__device__ __forceinline__ float lo16(unsigned w) { return __uint_as_float(w << 16); }
__device__ __forceinline__ float hi16(unsigned w) { return __uint_as_float(w & 0xffff0000u); }
__device__ __forceinline__ float wave_sum(float v) {
#pragma unroll
    for (int o = 1; o < 64; o <<= 1) v += __shfl_xor(v, o);
    return v;
}
__device__ __forceinline__ float siluf(float x) { return x / (1.f + __expf(-x)); }
__device__ __forceinline__ float logsigf(float x) { return fminf(x, 0.f) - log1pf(__expf(-fabsf(x))); }
__device__ __forceinline__ void unpack8(const v4u w, float (&f)[8]) {
    f[0] = lo16(w.x); f[1] = hi16(w.x); f[2] = lo16(w.y); f[3] = hi16(w.y); f[4] = lo16(w.z); f[5] = hi16(w.z); f[6] = lo16(w.w); f[7] = hi16(w.w);
}
__device__ __forceinline__ int chunk_row0(int d, int j) {
    if (d == 0) return j < NCC ? T + j * CH : (j - NCC) * CH;
    return j < NCC ? T + (NCC - 1 - j) * CH : (NCL - 1 - (j - NCC)) * CH;
}

struct Ctx {
    int tid, lane, wave, gw, NGW, gtid, NTHR, G, bid;
    unsigned char* ws; float* out; const volatile LAS unsigned* tab;
    float* lds;
};

__device__ __forceinline__ const void* tab_ptr(const volatile LAS unsigned* tab, int i) {
    unsigned lo = tab[2 * i], hi = tab[2 * i + 1];
    lo = __builtin_amdgcn_readfirstlane(lo); hi = __builtin_amdgcn_readfirstlane(hi);
    return (const void*)(((size_t)hi << 32) | lo);
}
__device__ __forceinline__ const float* inp(const Ctx& c, int i) { return (const float*)tab_ptr(c.tab, i); }
__device__ __forceinline__ Ctx fresh(const Ctx& c0) {
    Ctx c = c0;
    int t = threadIdx.x; asm volatile("" : "+v"(t));
    c.tid = t; c.lane = t & 63; c.wave = __builtin_amdgcn_readfirstlane(t >> 6);
    c.gw = c.bid * NWAVES + c.wave; c.gtid = c.bid * NTHREADS + t;
    c.ws = (unsigned char*)tab_ptr(c0.tab, 31); c.out = (float*)tab_ptr(c0.tab, 32);
    return c;
}
template <int K>
__device__ __forceinline__ void gemm_8x64(const bf16* a0, const bf16* a1, const bf16* a2, const bf16* a3, const bf16* a4, const bf16* a5, const bf16* a6, const bf16* a7,
                                          const float* B, int ldb, int col, float (&acc)[8]) {
    for (int k0 = 0; k0 < K; k0 += 8) {
        float a[8][8];
        unpack8(*(const v4u*)(a0 + k0), a[0]); unpack8(*(const v4u*)(a1 + k0), a[1]); unpack8(*(const v4u*)(a2 + k0), a[2]); unpack8(*(const v4u*)(a3 + k0), a[3]);
        unpack8(*(const v4u*)(a4 + k0), a[4]); unpack8(*(const v4u*)(a5 + k0), a[5]); unpack8(*(const v4u*)(a6 + k0), a[6]); unpack8(*(const v4u*)(a7 + k0), a[7]);
#pragma unroll
        for (int kk = 0; kk < 8; ++kk) {
            const float b = B[(size_t)(k0 + kk) * ldb + col];
#pragma unroll
            for (int r = 0; r < 8; ++r) acc[r] += a[r][kk] * b;
        }
    }
}

__device__ __forceinline__ void p0_prologue(const Ctx& c) {
    const float* cvec = inp(c, 1); const float* ccvec = inp(c, 3); const float* w_ada = inp(c, 4); const float* b_ada = inp(c, 5);
    float* mod = (float*)(c.ws + WS_MOD); float* modc = (float*)(c.ws + WS_MODC);
    for (int it = c.bid; it < 96; it += c.G) {
        const int col = it * 64 + c.lane; float al = 0.f, ac = 0.f;
        for (int k = c.wave * 128; k < c.wave * 128 + 128; ++k) {
            const float w = w_ada[(size_t)k * 6144 + col];
            al += siluf(cvec[k]) * w; ac += siluf(ccvec[k]) * w;
        }
        c.lds[(c.wave * 64 + c.lane) * 2] = al; c.lds[(c.wave * 64 + c.lane) * 2 + 1] = ac;
        __syncthreads();
        if (c.wave == 0) {
            float sl = 0.f, sc = 0.f;
            for (int w = 0; w < 8; ++w) { sl += c.lds[(w * 64 + c.lane) * 2]; sc += c.lds[(w * 64 + c.lane) * 2 + 1]; }
            mod[col] = sl + b_ada[col];
            if (col < 2048) modc[col] = sc + b_ada[col];
        }
        __syncthreads();
    }
    float* posR = (float*)(c.ws + WS_POSR);
    for (int i = c.gtid; i < 320 * 512; i += c.NTHR) {
        const int r = i >> 9, j = i & 511, p = r < 256 ? r : r - 256, fi = j & 255;
        const float freq = 1.0f / powf(10000.0f, (float)fi / 256.0f);
        const float ang = (float)p * freq;
        posR[i] = j < 256 ? sinf(ang) : cosf(ang);
    }
    const float* wf = inp(c, 22); float* Gm = (float*)(c.ws + WS_G);
    const float scale = 1.0f / sqrtf(16384.0f * 128.0f);
    for (int i = c.gtid; i < 4 * 256 * 128; i += c.NTHR) {
        const int g = i >> 15, row = (i >> 7) & 255, d = i & 127, cc = row & 127; float s = 0.f;
        for (int c2 = 0; c2 < 128; ++c2) {
            const float ph = (float)((cc * c2) & 127) * (1.0f / 64.0f);
            const float tr = row < 128 ? cospif(ph) : sinpif(ph);
            s += tr * wf[(g * 128 + c2) * 128 + d];
        }
        Gm[i] = s * scale;
    }
}

__device__ __forceinline__ void p1_hrows(const Ctx& c) {
    const float* x = inp(c, 0); const float* ctx = inp(c, 2); const float* g = inp(c, 6);
    const float* mod = (const float*)(c.ws + WS_MOD); const float* modc = (const float*)(c.ws + WS_MODC);
    const float* posR = (const float*)(c.ws + WS_POSR); const float* posC = (const float*)(c.ws + WS_POSC);
    bf16* H = (bf16*)(c.ws + WS_H);
    for (int r = c.gw; r < NT; r += c.NGW) {
        asm volatile("" ::: "memory");
        const bool lat = r < T;
        const float* src = lat ? x + (size_t)r * D : ctx + (size_t)(r - T) * D;
        const float* md = lat ? mod : modc;
        f32x4 v[4]; float ss = 0.f;
#pragma unroll
        for (int j = 0; j < 4; ++j) {
            const int col = 256 * j + 4 * c.lane;
            v[j] = *(const f32x4*)(src + col);
            if (lat) { const float* pp = col < 512 ? posR + (r >> 6) * 512 + col : posC + (r & 63) * 512 + (col - 512); v[j] += *(const f32x4*)pp; }
            ss += v[j].x * v[j].x + v[j].y * v[j].y + v[j].z * v[j].z + v[j].w * v[j].w;
        }
        const float rinv = rsqrtf(wave_sum(ss) * (1.f / D) + EPS);
#pragma unroll
        for (int j = 0; j < 4; ++j) {
            const int col = 256 * j + 4 * c.lane;
            const f32x4 gg = *(const f32x4*)(g + col), sh = *(const f32x4*)(md + col), sc = *(const f32x4*)(md + 1024 + col);
            const f32x4 o = v[j] * rinv * gg * (sc + 1.f) + sh;
            uint2 w; w.x = pk2(o.x, o.y); w.y = pk2(o.z, o.w);
            *(uint2*)(H + (size_t)r * D + col) = w;
        }
    }
}

__device__ __forceinline__ void p2_gemm1(const Ctx& c) {
    const bf16* H = (const bf16*)(c.ws + WS_H); const float* w_in = inp(c, 10);
    constexpr int NCG = DIN / 64, NRG = NT / 8;
    for (int it = c.gw; it < NCG * NRG; it += c.NGW) {
        const int rg = it / NCG, cg = it % NCG, col = cg * 64 + c.lane; const bf16* a = H + (size_t)rg * 8 * D;
        float acc[8] = {0, 0, 0, 0, 0, 0, 0, 0};
        gemm_8x64<D>(a, a + D, a + 2 * D, a + 3 * D, a + 4 * D, a + 5 * D, a + 6 * D, a + 7 * D, w_in, DIN, col, acc);
        bf16* dst = (bf16*)(c.ws + (col < 512 ? WS_XM : (col < 1024 ? WS_Z : WS_U))) + (col & 511);
#pragma unroll
        for (int r = 0; r < 8; ++r) dst[(size_t)(rg * 8 + r) * DM] = (bf16)f2bf(acc[r]);
    }
}

__device__ __forceinline__ void p3_features(const Ctx& c) {
    const bf16* XM = (const bf16*)(c.ws + WS_XM);
    const float* conv_w = inp(c, 11); const float* conv_b = inp(c, 12); const float* wq = inp(c, 13); const float* wk = inp(c, 14); const float* wv = inp(c, 15);
    bf16* Q = (bf16*)(c.ws + WS_Q); bf16* Kb = (bf16*)(c.ws + WS_K); bf16* Vb = (bf16*)(c.ws + WS_V); bf16* ACT = (bf16*)(c.ws + WS_ACT);
    float* IG = (float*)(c.ws + WS_IG); float* LF = (float*)(c.ws + WS_LF);
    const int ch0 = 8 * c.lane;
    for (int r = c.gw; r < NT; r += c.NGW) {
        asm volatile("" ::: "memory");
        const bool lat = r < T;
        const bool hasp = lat ? (r > 0) : (r > T), hasn = lat ? (r < T - 1) : (r < NT - 1);
        float xc[8], xp[8], xn[8];
        unpack8(*(const v4u*)(XM + (size_t)r * DM + ch0), xc);
        if (hasp) unpack8(*(const v4u*)(XM + (size_t)(r - 1) * DM + ch0), xp); else { for (int i = 0; i < 8; ++i) xp[i] = 0.f; }
        if (hasn) unpack8(*(const v4u*)(XM + (size_t)(r + 1) * DM + ch0), xn); else { for (int i = 0; i < 8; ++i) xn[i] = 0.f; }
        float act[8], q[8], k[8], v[8];
#pragma unroll
        for (int i = 0; i < 8; ++i) {
            const float y = conv_w[ch0 + i] * xp[i] + conv_w[DM + ch0 + i] * xc[i] + conv_w[2 * DM + ch0 + i] * xn[i] + conv_b[ch0 + i];
            act[i] = siluf(y);
        }
#pragma unroll
        for (int b = 0; b < 2; ++b) {
            const int n = 2 * c.lane + b;
#pragma unroll
            for (int o = 0; o < 4; ++o) {
                float sq = 0.f, sk = 0.f, sv = 0.f;
#pragma unroll
                for (int i = 0; i < 4; ++i) { sq += act[4 * b + i] * wq[n * 16 + i * 4 + o]; sk += act[4 * b + i] * wk[n * 16 + i * 4 + o]; sv += xc[4 * b + i] * wv[n * 16 + i * 4 + o]; }
                q[4 * b + o] = sq; k[4 * b + o] = sk; v[4 * b + o] = sv;
            }
        }
#pragma unroll 1
        for (int d = 0; d < 2; ++d) {
            const float* wd = d ? inp(c, 18) : inp(c, 16); const float* bd = d ? inp(c, 19) : inp(c, 17);
            float val = 0.f;
#pragma unroll 1
            for (int j = 0; j < 8; ++j) {
                float s = 0.f;
#pragma unroll
                for (int i = 0; i < 8; ++i) s += q[i] * wd[(ch0 + i) * 8 + j] + k[i] * wd[(512 + ch0 + i) * 8 + j] + v[i] * wd[(1024 + ch0 + i) * 8 + j];
                s = wave_sum(s) + bd[j];
                val = (c.lane == j) ? s : val;
            }
            if (c.lane < 8) {
                if (c.lane < 4) IG[(size_t)(d * 4 + c.lane) * NT + r] = val; else LF[(size_t)(d * 4 + (c.lane - 4)) * NT + r] = logsigf(val);
            }
        }
        const float qs = 0.08838834764831845f;
        v4u w;
        w.x = pk2(q[0] * qs, q[1] * qs); w.y = pk2(q[2] * qs, q[3] * qs); w.z = pk2(q[4] * qs, q[5] * qs); w.w = pk2(q[6] * qs, q[7] * qs); *(v4u*)(Q + (size_t)r * DM + ch0) = w;
        w.x = pk2(k[0], k[1]); w.y = pk2(k[2], k[3]); w.z = pk2(k[4], k[5]); w.w = pk2(k[6], k[7]); *(v4u*)(Kb + (size_t)r * DM + ch0) = w;
        w.x = pk2(v[0], v[1]); w.y = pk2(v[2], v[3]); w.z = pk2(v[4], v[5]); w.w = pk2(v[6], v[7]); *(v4u*)(Vb + (size_t)r * DM + ch0) = w;
        w.x = pk2(act[0], act[1]); w.y = pk2(act[2], act[3]); w.z = pk2(act[4], act[5]); w.w = pk2(act[6], act[7]); *(v4u*)(ACT + (size_t)r * DM + ch0) = w;
    }
}

__device__ __forceinline__ void p4_summaries(const Ctx& c) {
    const bf16* Kb = (const bf16*)(c.ws + WS_K); const bf16* Vb = (const bf16*)(c.ws + WS_V);
    const float* IG = (const float*)(c.ws + WS_IG); const float* LF = (const float*)(c.ws + WS_LF);
    float* LT = (float*)(c.ws + WS_L); float* NL = (float*)(c.ws + WS_NL); float* AMAX = (float*)(c.ws + WS_AMAX); float* BTOT = (float*)(c.ws + WS_BTOT);
    float* Ks = c.lds; float* Vs = c.lds + 16384; float* lfs = c.lds + 32768; float* as = lfs + 128; float* red = as + 128;
    for (int it = c.bid; it < 2 * NH * NCH; it += c.G) {
        const int d = it / (NH * NCH), h = (it / NCH) % NH, j = it % NCH, r0 = chunk_row0(d, j);
        const float* lf = LF + (size_t)(d * 4 + h) * NT + r0; const float* ig = IG + (size_t)(d * 4 + h) * NT + r0;
        if (c.tid < 128) lfs[c.tid] = lf[c.tid];
        __syncthreads();
        if (c.tid < 128) {
            float b = 0.f, tot = 0.f;
            for (int i = 0; i < 128; ++i) { const float x = lfs[i]; tot += x; if (d == 0 ? (i <= c.tid) : (i >= c.tid)) b += x; }
            as[c.tid] = tot - b + ig[c.tid];
            if (c.tid == 0) red[0] = tot;
        }
        __syncthreads();
        if (c.tid == 0) { float m = as[0]; for (int i = 1; i < 128; ++i) m = fmaxf(m, as[i]); red[1] = m; }
        __syncthreads();
        const float amax = red[1], btot = red[0];
        for (int e = c.tid; e < 128 * 16; e += NTHREADS) {
            const int l = e >> 4, c8 = (e & 15) * 8; const float w = __expf(as[l] - amax);
            float f[8];
            unpack8(*(const v4u*)(Kb + (size_t)(r0 + l) * DM + h * DH + c8), f);
#pragma unroll
            for (int i = 0; i < 8; ++i) Ks[l * 128 + c8 + i] = f[i] * w;
            unpack8(*(const v4u*)(Vb + (size_t)(r0 + l) * DM + h * DH + c8), f);
#pragma unroll
            for (int i = 0; i < 8; ++i) Vs[l * 128 + c8 + i] = f[i];
        }
        __syncthreads();
        {
            const int v = c.tid >> 2, kq = (c.tid & 3) * 32;
            float acc[32];
#pragma unroll
            for (int i = 0; i < 32; ++i) acc[i] = 0.f;
            for (int l = 0; l < 128; ++l) {
                const float vv = Vs[l * 128 + v];
#pragma unroll
                for (int i = 0; i < 32; ++i) acc[i] += Ks[l * 128 + kq + i] * vv;
            }
            float* dst = LT + ((size_t)((d * 4 + h) * NCH + j) * 128 + v) * 128 + kq;
#pragma unroll
            for (int i = 0; i < 32; i += 4) *(f32x4*)(dst + i) = (f32x4){acc[i], acc[i + 1], acc[i + 2], acc[i + 3]};
        }
        if (c.tid < 128) {
            float s = 0.f;
            for (int l = 0; l < 128; ++l) s += Ks[l * 128 + c.tid];
            NL[(size_t)((d * 4 + h) * NCH + j) * 128 + c.tid] = s;
            if (c.tid == 0) { AMAX[(d * 4 + h) * NCH + j] = amax; BTOT[(d * 4 + h) * NCH + j] = btot; }
        }
        __syncthreads();
    }
}

__device__ __forceinline__ void p5_scan(const Ctx& c) {
    const float* LT = (const float*)(c.ws + WS_L); const float* NL = (const float*)(c.ws + WS_NL);
    const float* AMAX = (const float*)(c.ws + WS_AMAX); const float* BTOT = (const float*)(c.ws + WS_BTOT);
    bf16* C0 = (bf16*)(c.ws + WS_C0); float* N0 = (float*)(c.ws + WS_N0); float* M0 = (float*)(c.ws + WS_M0);
    constexpr int PER = 16384 + 128;
    for (int e = c.gtid; e < 8 * PER; e += c.NTHR) {
        const int dh = e / PER, rem = e % PER; const bool isC = rem < 16384; const int idx = isC ? rem : rem - 16384;
        float m = 0.f, val = 0.f;
        for (int j = 0; j < NCH; ++j) {
            if (j >= NCC) {
                if (isC) C0[((size_t)(dh * NCL + (j - NCC))) * 16384 + idx] = (bf16)f2bf(val);
                else N0[(size_t)(dh * NCL + (j - NCC)) * 128 + idx] = val;
                if (rem == 0) M0[dh * NCL + (j - NCC)] = m;
            }
            const float bt = BTOT[dh * NCH + j], am = AMAX[dh * NCH + j];
            const float mn = fmaxf(bt + m, am), dec = __expf(bt + m - mn), sc = __expf(am - mn);
            const float lv = isC ? LT[(size_t)(dh * NCH + j) * 16384 + idx] : NL[(size_t)(dh * NCH + j) * 128 + idx];
            val = dec * val + sc * lv; m = mn;
        }
    }
}

__device__ __forceinline__ void p6_fourier_a(const Ctx& c) {
    const bf16* U = (const bf16*)(c.ws + WS_U); bf16* FB = (bf16*)c.out;
    float* Us = c.lds; float* ct = c.lds + 8192; float* st = ct + 128;
    if (c.tid < 128) { ct[c.tid] = cospif((float)c.tid * (1.f / 64.f)); st[c.tid] = sinpif((float)c.tid * (1.f / 64.f)); }
    __syncthreads();
    for (int it = c.bid; it < 128 * 8; it += c.G) {
        const int t2 = it >> 3, chg = it & 7;
        for (int e = c.tid; e < 128 * 8; e += NTHREADS) {
            const int t1 = e >> 3, c8 = (e & 7) * 8; float f[8];
            unpack8(*(const v4u*)(U + (size_t)(128 * t1 + t2) * DM + chg * 64 + c8), f);
#pragma unroll
            for (int i = 0; i < 8; ++i) Us[t1 * 64 + c8 + i] = f[i];
        }
        __syncthreads();
        const int k1 = c.tid >> 2, cq = (c.tid & 3) * 16;
        float ar[16], ai[16];
#pragma unroll
        for (int i = 0; i < 16; ++i) { ar[i] = 0.f; ai[i] = 0.f; }
        for (int t1 = 0; t1 < 128; ++t1) {
            const int idx = (k1 * t1) & 127; const float cc = ct[idx], ss = st[idx];
#pragma unroll
            for (int i = 0; i < 16; ++i) { const float u = Us[t1 * 64 + cq + i]; ar[i] += cc * u; ai[i] -= ss * u; }
        }
        const float ph = (float)(k1 * t2) * (1.f / 8192.f); const float tc = cospif(ph), ts = sinpif(ph);
        bf16* dr = FB + ((size_t)(k1 * 128 + t2) * 2) * 512 + chg * 64 + cq; bf16* di = dr + 512;
#pragma unroll
        for (int i = 0; i < 16; i += 2) {
            const float br0 = ar[i] * tc + ai[i] * ts, bi0 = ai[i] * tc - ar[i] * ts, br1 = ar[i + 1] * tc + ai[i + 1] * ts, bi1 = ai[i + 1] * tc - ar[i + 1] * ts;
            *(unsigned*)(dr + i) = pk2(br0, br1); *(unsigned*)(di + i) = pk2(bi0, bi1);
        }
        __syncthreads();
    }
}

__device__ __forceinline__ void p7a_fourier_c(const Ctx& c) {
    const bf16* FB = (const bf16*)c.out; bf16* X = (bf16*)((unsigned char*)c.out + 32 * MiB);
    float* Brs = c.lds; float* Bis = c.lds + 8192; float* ct = c.lds + 16384; float* st = ct + 128;
    if (c.tid < 128) { ct[c.tid] = cospif((float)c.tid * (1.f / 64.f)); st[c.tid] = sinpif((float)c.tid * (1.f / 64.f)); }
    __syncthreads();
    for (int it = c.bid; it < 128 * 8; it += c.G) {
        const int k1 = it >> 3, chg = it & 7;
        for (int e = c.tid; e < 128 * 2 * 8; e += NTHREADS) {
            const int t2 = e >> 4, ri = (e >> 3) & 1, c8 = (e & 7) * 8; float f[8];
            unpack8(*(const v4u*)(FB + ((size_t)(k1 * 128 + t2) * 2 + ri) * 512 + chg * 64 + c8), f);
            float* dst = (ri ? Bis : Brs) + t2 * 64 + c8;
#pragma unroll
            for (int i = 0; i < 8; ++i) dst[i] = f[i];
        }
        __syncthreads();
        const int k2 = c.tid >> 2, cq = (c.tid & 3) * 16;
        float xr[16], xi[16];
#pragma unroll
        for (int i = 0; i < 16; ++i) { xr[i] = 0.f; xi[i] = 0.f; }
        for (int t2 = 0; t2 < 128; ++t2) {
            const int idx = (k2 * t2) & 127; const float cc = ct[idx], ss = st[idx];
#pragma unroll
            for (int i = 0; i < 16; ++i) { const float br = Brs[t2 * 64 + cq + i], bi = Bis[t2 * 64 + cq + i]; xr[i] += cc * br + ss * bi; xi[i] += cc * bi - ss * br; }
        }
        bf16* dr = X + ((size_t)(k1 + 128 * k2) * 2) * 512 + chg * 64 + cq; bf16* di = dr + 512;
#pragma unroll
        for (int i = 0; i < 16; i += 2) { *(unsigned*)(dr + i) = pk2(xr[i], xr[i + 1]); *(unsigned*)(di + i) = pk2(xi[i], xi[i + 1]); }
        __syncthreads();
    }
}

__device__ __forceinline__ void p7b_fourier_mix(const Ctx& c) {
    const bf16* X = (const bf16*)((unsigned char*)c.out + 32 * MiB); const float* Gm = (const float*)(c.ws + WS_G); bf16* A2 = (bf16*)(c.ws + WS_H);
    for (int it = c.gw; it < (T / 8) * 8; it += c.NGW) {
        const int rg = it >> 3, g = (it >> 1) & 3, hf = it & 1, col = hf * 64 + c.lane;
        const bf16* a = X + (size_t)rg * 8 * 1024 + g * 128;
        float acc[8] = {0, 0, 0, 0, 0, 0, 0, 0};
        gemm_8x64<128>(a, a + 1024, a + 2048, a + 3072, a + 4096, a + 5120, a + 6144, a + 7168, Gm + (size_t)g * 256 * 128, 128, col, acc);
        a += 512;
        gemm_8x64<128>(a, a + 1024, a + 2048, a + 3072, a + 4096, a + 5120, a + 6144, a + 7168, Gm + (size_t)g * 256 * 128 + 128 * 128, 128, col, acc);
#pragma unroll
        for (int r = 0; r < 8; ++r) A2[(size_t)(rg * 8 + r) * D + 512 + g * 128 + col] = (bf16)f2bf(acc[r]);
    }
}

__device__ __forceinline__ void p8_mlstm_out(const Ctx& c) {
    const bf16* Q = (const bf16*)(c.ws + WS_Q); const bf16* Kb = (const bf16*)(c.ws + WS_K); const bf16* Vb = (const bf16*)(c.ws + WS_V);
    const bf16* ACT = (const bf16*)(c.ws + WS_ACT); const bf16* Z = (const bf16*)(c.ws + WS_Z);
    const float* IG = (const float*)(c.ws + WS_IG); const float* LF = (const float*)(c.ws + WS_LF);
    const bf16* C0 = (const bf16*)(c.ws + WS_C0); const float* N0 = (const float*)(c.ws + WS_N0); const float* M0 = (const float*)(c.ws + WS_M0);
    const float* norm_w = inp(c, 20); const float* skip = inp(c, 21);
    bf16* A2 = (bf16*)(c.ws + WS_H);
    constexpr int KS = 136;
    bf16* Ks = (bf16*)c.lds; bf16* Vs = Ks + 128 * KS;
    float* S = c.lds + (2 * 128 * KS * 2) / 4;
    float* bs = S + 16384; float* igs = bs + 128; float* lfs = igs + 128;
    const int t = c.tid >> 2, qd = c.tid & 3;
    for (int it = c.bid; it < NH * NCL; it += c.G) {
        const int h = it / NCL, ck = it % NCL, r0 = ck * CH;
        for (int e = c.tid; e < 128 * 16; e += NTHREADS) {
            const int l = e >> 4, c8 = (e & 15) * 8;
            *(v4u*)(Ks + l * KS + c8) = *(const v4u*)(Kb + (size_t)(r0 + l) * DM + h * DH + c8);
            *(v4u*)(Vs + l * KS + c8) = *(const v4u*)(Vb + (size_t)(r0 + l) * DM + h * DH + c8);
        }
        float hsum[32];
#pragma unroll
        for (int i = 0; i < 32; ++i) hsum[i] = 0.f;
        const bf16* qrow = Q + (size_t)(r0 + t) * DM + h * DH;
        for (int d = 0; d < 2; ++d) {
            const int sidx = (d * 4 + h) * NCL + (d == 0 ? ck : NCL - 1 - ck);
            if (c.tid < 128) { lfs[c.tid] = LF[(size_t)(d * 4 + h) * NT + r0 + c.tid]; igs[c.tid] = IG[(size_t)(d * 4 + h) * NT + r0 + c.tid]; }
            __syncthreads();
            if (c.tid < 128) {
                float b = 0.f;
                for (int i = 0; i < 128; ++i) { if (d == 0 ? (i <= c.tid) : (i >= c.tid)) b += lfs[i]; }
                bs[c.tid] = b;
            }
            __syncthreads();
            const float m0 = M0[sidx], bt = bs[t];
            float acc[32];
#pragma unroll
            for (int i = 0; i < 32; ++i) acc[i] = 0.f;
#pragma unroll 1
            for (int kc = 0; kc < 16; ++kc) {
                float qf[8]; unpack8(*(const v4u*)(qrow + kc * 8), qf);
#pragma unroll
                for (int i = 0; i < 32; ++i) {
                    float kf[8]; unpack8(*(const v4u*)(Ks + (32 * qd + i) * KS + kc * 8), kf);
#pragma unroll
                    for (int u = 0; u < 8; ++u) acc[i] += qf[u] * kf[u];
                }
            }
            float mloc = -INFINITY;
            float ld[32];
#pragma unroll
            for (int i = 0; i < 32; ++i) {
                const int s = 32 * qd + i; const bool ok = d == 0 ? (s <= t) : (s >= t);
                ld[i] = ok ? bt - bs[s] + igs[s] : -INFINITY; mloc = fmaxf(mloc, ld[i]);
            }
            mloc = fmaxf(mloc, __shfl_xor(mloc, 1)); mloc = fmaxf(mloc, __shfl_xor(mloc, 2));
            const float mt = fmaxf(bt + m0, mloc);
            float rs = 0.f;
#pragma unroll
            for (int i = 0; i < 32; ++i) { const float sv = acc[i] * __expf(ld[i] - mt); S[t * 128 + 32 * qd + i] = sv; rs += sv; }
            rs += __shfl_xor(rs, 1); rs += __shfl_xor(rs, 2);
            __syncthreads();
            float num[32];
#pragma unroll
            for (int i = 0; i < 32; ++i) num[i] = 0.f;
#pragma unroll 2
            for (int s = 0; s < 128; ++s) {
                const float sv = S[t * 128 + s];
#pragma unroll
                for (int i8 = 0; i8 < 4; ++i8) {
                    float vf[8]; unpack8(*(const v4u*)(Vs + s * KS + 32 * qd + i8 * 8), vf);
#pragma unroll
                    for (int u = 0; u < 8; ++u) num[i8 * 8 + u] += sv * vf[u];
                }
            }
            float qc[32];
#pragma unroll
            for (int i = 0; i < 32; ++i) qc[i] = 0.f;
            const bf16* c0 = C0 + (size_t)sidx * 16384;
#pragma unroll 1
            for (int kc = 0; kc < 16; ++kc) {
                float qf[8]; unpack8(*(const v4u*)(qrow + kc * 8), qf);
#pragma unroll
                for (int i = 0; i < 32; ++i) {
                    float cf[8]; unpack8(*(const v4u*)(c0 + (size_t)(32 * qd + i) * 128 + kc * 8), cf);
#pragma unroll
                    for (int u = 0; u < 8; ++u) qc[i] += qf[u] * cf[u];
                }
            }
            float qn = 0.f;
            {
                const float* n0 = N0 + (size_t)sidx * 128 + 32 * qd;
#pragma unroll
                for (int k8 = 0; k8 < 4; ++k8) {
                    float qf[8]; unpack8(*(const v4u*)(qrow + 32 * qd + k8 * 8), qf);
#pragma unroll
                    for (int u = 0; u < 8; ++u) qn += qf[u] * n0[k8 * 8 + u];
                }
            }
            qn += __shfl_xor(qn, 1); qn += __shfl_xor(qn, 2);
            const float wi = __expf(bt + m0 - mt), nq = rs + wi * qn, den = fmaxf(fabsf(nq), __expf(-mt)), rden = 1.f / den;
#pragma unroll
            for (int i = 0; i < 32; ++i) hsum[i] += (num[i] + wi * qc[i]) * rden;
            __syncthreads();
        }
        float sm = 0.f;
#pragma unroll
        for (int i = 0; i < 32; ++i) sm += hsum[i];
        sm += __shfl_xor(sm, 1); sm += __shfl_xor(sm, 2);
        const float mu = sm * (1.f / 128.f);
        float sv = 0.f;
#pragma unroll
        for (int i = 0; i < 32; ++i) { const float dlt = hsum[i] - mu; sv += dlt * dlt; }
        sv += __shfl_xor(sv, 1); sv += __shfl_xor(sv, 2);
        const float rstd = rsqrtf(sv * (1.f / 128.f) + EPS);
        const int col0 = h * DH + 32 * qd; const size_t row = (size_t)(r0 + t);
#pragma unroll
        for (int i8 = 0; i8 < 4; ++i8) {
            float af[8], zf[8], o[8];
            unpack8(*(const v4u*)(ACT + row * DM + col0 + i8 * 8), af); unpack8(*(const v4u*)(Z + row * DM + col0 + i8 * 8), zf);
#pragma unroll
            for (int u = 0; u < 8; ++u) {
                const int cc = col0 + i8 * 8 + u;
                const float hn = (hsum[i8 * 8 + u] - mu) * rstd * norm_w[cc];
                o[u] = (hn + skip[cc] * af[u]) * siluf(zf[u]);
            }
            v4u w; w.x = pk2(o[0], o[1]); w.y = pk2(o[2], o[3]); w.z = pk2(o[4], o[5]); w.w = pk2(o[6], o[7]);
            *(v4u*)(A2 + row * D + col0 + i8 * 8) = w;
        }
        __syncthreads();
    }
}

__device__ __forceinline__ void p9_outproj(const Ctx& c) {
    const bf16* A2 = (const bf16*)(c.ws + WS_H); const float* w_out = inp(c, 23); float* Y = (float*)(c.ws + WS_Y);
    constexpr int NCG = D / 64, NRG = T / 8;
    for (int it = c.gw; it < NCG * NRG; it += c.NGW) {
        const int rg = it / NCG, cg = it % NCG, col = cg * 64 + c.lane; const bf16* a = A2 + (size_t)rg * 8 * D;
        float acc[8] = {0, 0, 0, 0, 0, 0, 0, 0};
        gemm_8x64<D>(a, a + D, a + 2 * D, a + 3 * D, a + 4 * D, a + 5 * D, a + 6 * D, a + 7 * D, w_out, D, col, acc);
#pragma unroll
        for (int r = 0; r < 8; ++r) Y[(size_t)(rg * 8 + r) * D + col] = acc[r];
    }
}

__device__ __forceinline__ void p10_token(const Ctx& c) {
    const float* x = inp(c, 0); const float* g_post = inp(c, 7); const float* g_ffn = inp(c, 8);
    const float* wrg = inp(c, 24); const float* brg = inp(c, 25); const float* wre = inp(c, 26); const float* bre = inp(c, 27);
    const float* mod = (const float*)(c.ws + WS_MOD);
    const float* posR = (const float*)(c.ws + WS_POSR); const float* posC = (const float*)(c.ws + WS_POSC);
    float* Y = (float*)(c.ws + WS_Y); bf16* H2 = (bf16*)(c.ws + WS_H); int* RE = (int*)(c.ws + WS_RE); float* RW = (float*)(c.ws + WS_RW);
    for (int r = c.gw; r < T; r += c.NGW) {
        f32x4 xv[4], yv[4]; float ss = 0.f;
#pragma unroll
        for (int j = 0; j < 4; ++j) {
            const int col = 256 * j + 4 * c.lane;
            const float* pp = col < 512 ? posR + (r >> 6) * 512 + col : posC + (r & 63) * 512 + (col - 512);
            xv[j] = *(const f32x4*)(x + (size_t)r * D + col) + *(const f32x4*)pp;
            yv[j] = *(const f32x4*)(Y + (size_t)r * D + col);
            ss += yv[j].x * yv[j].x + yv[j].y * yv[j].y + yv[j].z * yv[j].z + yv[j].w * yv[j].w;
        }
        const float rinv = rsqrtf(wave_sum(ss) * (1.f / D) + EPS);
        float s2 = 0.f;
#pragma unroll
        for (int j = 0; j < 4; ++j) {
            const int col = 256 * j + 4 * c.lane;
            const f32x4 gg = *(const f32x4*)(g_post + col), g1 = *(const f32x4*)(mod + 2048 + col);
            xv[j] = xv[j] + g1 * (yv[j] * rinv * gg);
            *(f32x4*)(c.out + (size_t)r * D + col) = xv[j];
            *(f32x4*)(Y + (size_t)r * D + col) = (f32x4){0.f, 0.f, 0.f, 0.f};
            s2 += xv[j].x * xv[j].x + xv[j].y * xv[j].y + xv[j].z * xv[j].z + xv[j].w * xv[j].w;
        }
        const float rinv2 = rsqrtf(wave_sum(s2) * (1.f / D) + EPS);
        float lg[20];
#pragma unroll
        for (int i = 0; i < 20; ++i) lg[i] = 0.f;
#pragma unroll
        for (int j = 0; j < 4; ++j) {
            const int col = 256 * j + 4 * c.lane;
            const f32x4 gg = *(const f32x4*)(g_ffn + col), sh = *(const f32x4*)(mod + 3072 + col), sc = *(const f32x4*)(mod + 4096 + col);
            const f32x4 hv = xv[j] * rinv2 * gg * (sc + 1.f) + sh;
            uint2 w; w.x = pk2(hv.x, hv.y); w.y = pk2(hv.z, hv.w);
            *(uint2*)(H2 + (size_t)r * D + col) = w;
            const float he[4] = {hv.x, hv.y, hv.z, hv.w};
#pragma unroll
            for (int e = 0; e < 4; ++e) {
                const f32x4 wg4 = *(const f32x4*)(wrg + (size_t)(col + e) * 4);
                lg[0] += he[e] * wg4.x; lg[1] += he[e] * wg4.y; lg[2] += he[e] * wg4.z; lg[3] += he[e] * wg4.w;
#pragma unroll
                for (int q4 = 0; q4 < 4; ++q4) {
                    const f32x4 we4 = *(const f32x4*)(wre + (size_t)(col + e) * 16 + q4 * 4);
                    lg[4 + q4 * 4] += he[e] * we4.x; lg[5 + q4 * 4] += he[e] * we4.y; lg[6 + q4 * 4] += he[e] * we4.z; lg[7 + q4 * 4] += he[e] * we4.w;
                }
            }
        }
#pragma unroll
        for (int i = 0; i < 20; ++i) lg[i] = wave_sum(lg[i]);
        if (c.lane == 0) {
            float gl[4];
#pragma unroll
            for (int i = 0; i < 4; ++i) gl[i] = lg[i] + brg[i];
            int gs = 0; float gm = gl[0];
#pragma unroll
            for (int i = 1; i < 4; ++i) if (gl[i] > gm) { gm = gl[i]; gs = i; }
            float den = 0.f;
#pragma unroll
            for (int i = 0; i < 4; ++i) den += __expf(gl[i] - gm);
            const float psel = 1.f / den;
            float el[4];
#pragma unroll
            for (int i = 0; i < 4; ++i) {
                float v = 0.f;
#pragma unroll
                for (int g2 = 0; g2 < 4; ++g2) v = (g2 == gs) ? lg[4 + g2 * 4 + i] + bre[g2 * 4 + i] : v;
                el[i] = v;
            }
            int i1 = 0; float em1 = el[0];
#pragma unroll
            for (int i = 1; i < 4; ++i) if (el[i] > em1) { em1 = el[i]; i1 = i; }
            int i2 = -1; float em2 = -INFINITY;
#pragma unroll
            for (int i = 0; i < 4; ++i) if (i != i1 && el[i] > em2) { em2 = el[i]; i2 = i; }
            const float e2 = __expf(em2 - em1), w1 = psel / (1.f + e2), w2 = psel * e2 / (1.f + e2);
            RE[2 * r] = gs * 4 + i1; RE[2 * r + 1] = gs * 4 + i2; RW[2 * r] = w1; RW[2 * r + 1] = w2;
        }
    }
}

__device__ __forceinline__ void p11_moe(const Ctx& c) {
    const bf16* H2 = (const bf16*)(c.ws + WS_H); const int* RE = (const int*)(c.ws + WS_RE); const float* RW = (const float*)(c.ws + WS_RW);
    const float* w_gate = inp(c, 28); const float* w_up = inp(c, 29); const float* w_down = inp(c, 30); float* YM = (float*)(c.ws + WS_Y);
    float* Hs = c.lds;
    float* As = c.lds + 8192;
    int* ltok = (int*)(c.lds + 12288); float* lw = c.lds + 12288 + 128; int* cnt = (int*)(c.lds + 12288 + 256);
    for (int it = c.bid; it < NE * (T / 128); it += c.G) {
        const int e = it / (T / 128), chunk = it % (T / 128);
        if (c.tid == 0) *cnt = 0;
        __syncthreads();
        if (c.tid < 128) {
            const int tok = chunk * 128 + c.tid; const int e0 = RE[2 * tok], e1 = RE[2 * tok + 1];
            if (e0 == e || e1 == e) { const int p = atomicAdd(cnt, 1); ltok[p] = tok; lw[p] = (e0 == e) ? RW[2 * tok] : RW[2 * tok + 1]; }
        }
        __syncthreads();
        const int n = *cnt;
        const float* Wg = w_gate + (size_t)e * D * DE; const float* Wu = w_up + (size_t)e * D * DE; const float* Wd = w_down + (size_t)e * DE * D;
        for (int base = 0; base < n; base += 8) {
            for (int idx = c.tid; idx < 8 * 128; idx += NTHREADS) {
                const int i = idx >> 7, c8 = (idx & 127) * 8; float f[8];
                if (base + i < n) unpack8(*(const v4u*)(H2 + (size_t)ltok[base + i] * D + c8), f); else { for (int u = 0; u < 8; ++u) f[u] = 0.f; }
#pragma unroll
                for (int u = 0; u < 8; ++u) Hs[i * 1024 + c8 + u] = f[u];
            }
            __syncthreads();
            {
                float g[8], u[8];
#pragma unroll
                for (int i = 0; i < 8; ++i) { g[i] = 0.f; u[i] = 0.f; }
                for (int k = 0; k < D; ++k) {
                    const float wg = Wg[(size_t)k * DE + c.tid], wu = Wu[(size_t)k * DE + c.tid];
#pragma unroll
                    for (int i = 0; i < 8; ++i) { const float hv = Hs[i * 1024 + k]; g[i] += hv * wg; u[i] += hv * wu; }
                }
#pragma unroll
                for (int i = 0; i < 8; ++i) As[i * 512 + c.tid] = (base + i < n) ? siluf(g[i]) * u[i] * lw[base + i] : 0.f;
            }
            __syncthreads();
            {
                float y0[8], y1[8];
#pragma unroll
                for (int i = 0; i < 8; ++i) { y0[i] = 0.f; y1[i] = 0.f; }
                for (int j = 0; j < DE; ++j) {
                    const float w0 = Wd[(size_t)j * D + c.tid], w1 = Wd[(size_t)j * D + 512 + c.tid];
#pragma unroll
                    for (int i = 0; i < 8; ++i) { const float av = As[i * 512 + j]; y0[i] += av * w0; y1[i] += av * w1; }
                }
#pragma unroll
                for (int i = 0; i < 8; ++i) if (base + i < n) { atomicAdd(YM + (size_t)ltok[base + i] * D + c.tid, y0[i]); atomicAdd(YM + (size_t)ltok[base + i] * D + 512 + c.tid, y1[i]); }
            }
            __syncthreads();
        }
        __syncthreads();
    }
}

__device__ __forceinline__ void p12_final(const Ctx& c) {
    const float* g_post = inp(c, 9); const float* mod = (const float*)(c.ws + WS_MOD); const float* YM = (const float*)(c.ws + WS_Y);
    for (int r = c.gw; r < T; r += c.NGW) {
        f32x4 yv[4]; float ss = 0.f;
#pragma unroll
        for (int j = 0; j < 4; ++j) { const int col = 256 * j + 4 * c.lane; yv[j] = *(const f32x4*)(YM + (size_t)r * D + col); ss += yv[j].x * yv[j].x + yv[j].y * yv[j].y + yv[j].z * yv[j].z + yv[j].w * yv[j].w; }
        const float rinv = rsqrtf(wave_sum(ss) * (1.f / D) + EPS);
#pragma unroll
        for (int j = 0; j < 4; ++j) {
            const int col = 256 * j + 4 * c.lane;
            const f32x4 gg = *(const f32x4*)(g_post + col), g2 = *(const f32x4*)(mod + 5120 + col);
            f32x4* o = (f32x4*)(c.out + (size_t)r * D + col);
            *o = *o + g2 * (yv[j] * rinv * gg);
        }
    }
}

namespace pg8 {
#define PG8_LAS __attribute__((address_space(3)))
typedef unsigned short bf16_t;
typedef short bf16x8 __attribute__((ext_vector_type(8)));
typedef float f32x4 __attribute__((ext_vector_type(4)));
typedef unsigned u32x4 __attribute__((ext_vector_type(4)));
constexpr int BM = 256, BK = 64, HALF = 128, HTB = HALF * BK * 2  , STAGE_BYTES = 8 * HTB, NXCD = 8, WGM = 8;

__host__ __device__ __forceinline__ int lds_byte(int r, int c) { const int st = (r >> 4) * 2 + (c >> 5), rr = r & 15, cc = c & 31, ob = rr * 64 + cc * 2; return st * 1024 + (ob ^ (((ob >> 9) & 1) << 5)); }
__host__ __device__ __forceinline__ void stage_rc(int b, int& R, int& C) { const int st = b / 1024, sb = b % 1024, swz = sb ^ (((sb >> 9) & 1) << 5); R = (st >> 1) * 16 + swz / 64; C = (st & 1) * 32 + (swz % 64) / 2; }
__host__ __device__ __forceinline__ int perm32(int rho) { const int n = rho >> 4, i = rho & 15; return 8 * (i >> 2) + 4 * n + (i & 3); }

struct Unit { int pm, pn; };
struct Gemm { const bf16_t* A; const bf16_t* Bt; int M, N, K; };

struct StaticOrder {
    int nM, nN, nwg, G, c;
    __host__ __device__ void init(int M, int N, int G_, int c_) { nM = M / BM; nN = N / BM; nwg = nM * nN; G = G_; c = c_; }
    __host__ __device__ bool next(int i, Unit& u) const {
        const long L = (long)i * G + c; if (L >= nwg) return false;
        int wgid = (int)L; { const int q = nwg / NXCD, r = nwg % NXCD, xcd = wgid % NXCD, off = wgid / NXCD; wgid = (xcd < r ? xcd * (q + 1) : r * (q + 1) + (xcd - r) * q) + off; }
        const int nig = WGM * nN, gid = wgid / nig, fm = gid * WGM, gsz = (nM - fm) < WGM ? (nM - fm) : WGM;
        u.pm = fm + ((wgid % nig) % gsz); u.pn = (wgid % nig) / gsz; return true;
    }
    __device__ __forceinline__ void a_ready(const Unit&) const {}
    __device__ __forceinline__ void done(const Unit&) const {}
};
__device__ __forceinline__ unsigned cvt_pk_bf16(float lo, float hi) { unsigned r; asm volatile("v_cvt_pk_bf16_f32 %0, %1, %2" : "=v"(r) : "v"(lo), "v"(hi)); return r; }
template <class Epi, class Sched, bool ALIGN_EPI = false, bool SP2 = false>
__device__ __forceinline__ void gemm_phase(PG8_LAS unsigned char* lds, const Gemm g, const Sched& S, const Epi& E) {
    int tid_ = threadIdx.x; asm volatile("" : "+v"(tid_));
    const int tid = tid_, wid = __builtin_amdgcn_readfirstlane(tid >> 6), lane = tid & 63, wr = wid >> 2, wc = wid & 3, fr = lane & 15, fq = lane >> 4;
    const int K = g.K, nt = K / BK;
    unsigned voffA[2], voffB[2];
#pragma unroll
    for (int i = 0; i < 2; ++i) { int R, C; stage_rc(tid * 16 + i * 8192, R, C); const int Rb = Epi::PERM ? ((R & ~31) + perm32(R & 31)) : R;
        voffA[i] = (unsigned)(R * K + C) * 2u; voffB[i] = (unsigned)(Rb * K + C) * 2u; }
    const size_t kstep = (size_t)(BK * 2);
    const size_t hstep = (size_t)HALF * K * 2;
    const size_t tstep = 2 * hstep;
    const unsigned ldsw = (unsigned)wid * 1024u;
    const int aoff = lds_byte(wr * 64 + fr, fq * 8), boff = lds_byte(wc * 32 + fr, fq * 8);
#define PG8_SA(b, h) (((b) * 2 + (h)) * HTB)
#define PG8_SB(b, h) ((4 + (b) * 2 + (h)) * HTB)
#define PG8_STAGE(bufoff, gbase, voff) do { _Pragma("unroll") for (int _i = 0; _i < 2; ++_i) \
        __builtin_amdgcn_global_load_lds((const unsigned*)((const char*)(gbase) + (voff)[_i]), (PG8_LAS unsigned*)(lds + (bufoff) + ldsw + _i * 8192), 16, 0, 0); } while (0)
#define PG8_LDA(dst, b, h) do { _Pragma("unroll") for (int m = 0; m < 4; ++m) _Pragma("unroll") for (int k = 0; k < 2; ++k) dst[m][k] = *(const PG8_LAS bf16x8*)(lds + PG8_SA(b, h) + aoff + m * 2048 + k * 1024); } while (0)
#define PG8_LDB(dst, b, h) do { _Pragma("unroll") for (int n = 0; n < 2; ++n) _Pragma("unroll") for (int k = 0; k < 2; ++k) dst[n][k] = *(const PG8_LAS bf16x8*)(lds + PG8_SB(b, h) + boff + n * 2048 + k * 1024); } while (0)
#define PG8_MMA(ai, bj, At, Bt) do { __builtin_amdgcn_s_setprio(1); _Pragma("unroll") for (int m = 0; m < 4; ++m) _Pragma("unroll") for (int n = 0; n < 2; ++n) _Pragma("unroll") for (int k = 0; k < 2; ++k) \
        acc[ai][bj][m][n] = __builtin_amdgcn_mfma_f32_16x16x32_bf16(Bt[n][k], At[m][k], acc[ai][bj][m][n], 0, 0, 0); __builtin_amdgcn_s_setprio(0); } while (0)
#define PG8_WAIT_V(n) asm volatile("s_waitcnt vmcnt(" #n ")" ::: "memory")
#define PG8_WAIT_L(n) asm volatile("s_waitcnt lgkmcnt(" #n ")" ::: "memory")
#define PG8_BAR __builtin_amdgcn_s_barrier()
#define PG8_SCHED __builtin_amdgcn_sched_barrier(0)
    Unit cur, nxt; int ui = 0;
    if (!S.next(0, cur)) return;
    f32x4 acc[2][2][4][2];
#pragma unroll
    for (int a = 0; a < 2; ++a)
#pragma unroll
        for (int b = 0; b < 2; ++b)
#pragma unroll
            for (int m = 0; m < 4; ++m)
#pragma unroll
                for (int n = 0; n < 2; ++n) acc[a][b][m][n] = (f32x4){0.f, 0.f, 0.f, 0.f};
    bf16x8 At[4][2], B0[2][2], B1[2][2];
    const char* cA = (const char*)g.A + (size_t)cur.pm * tstep; const char* cB = (const char*)g.Bt + (size_t)cur.pn * tstep;
    S.a_ready(cur);
    if constexpr (SP2) {
        PG8_STAGE(PG8_SB(0, 0), cB, voffB); PG8_STAGE(PG8_SB(0, 1), cB + hstep, voffB); PG8_STAGE(PG8_SA(0, 0), cA, voffA); PG8_STAGE(PG8_SA(0, 1), cA + hstep, voffA);
        if (wr == 1) PG8_BAR;
        PG8_WAIT_V(2); PG8_BAR;
        PG8_STAGE(PG8_SB(1, 0), cB + kstep, voffB); PG8_STAGE(PG8_SA(1, 0), cA + kstep, voffA); PG8_STAGE(PG8_SB(1, 1), cB + hstep + kstep, voffB);
        PG8_WAIT_V(6); PG8_BAR;
    } else {
        PG8_STAGE(PG8_SB(0, 0), cB, voffB); PG8_STAGE(PG8_SA(0, 0), cA, voffA); PG8_STAGE(PG8_SB(0, 1), cB + hstep, voffB); PG8_STAGE(PG8_SA(0, 1), cA + hstep, voffA);
        if (wr == 1) PG8_BAR;
        PG8_WAIT_V(4); PG8_BAR;
        PG8_STAGE(PG8_SB(1, 0), cB + kstep, voffB); PG8_STAGE(PG8_SA(1, 0), cA + kstep, voffA); PG8_STAGE(PG8_SB(1, 1), cB + hstep + kstep, voffB);
        PG8_WAIT_V(6); PG8_BAR;
    }
    for (;;) {
        const bool has_next = S.next(ui + 1, nxt);
        const char* nA = has_next ? (const char*)g.A + (size_t)nxt.pm * tstep : cA; const char* nB = has_next ? (const char*)g.Bt + (size_t)nxt.pn * tstep : cB;
        for (int t = 0; t < nt; t += 2) {
            const bool last = (t == nt - 2);
            const char* a1 = cA + (size_t)(t + 1) * kstep;
            const char* a2 = last ? nA : cA + (size_t)(t + 2) * kstep; const char* b2 = last ? nB : cB + (size_t)(t + 2) * kstep;
            const char* a3 = a2 + kstep; const char* b3 = b2 + kstep;
            if (last && has_next) S.a_ready(nxt);
            if constexpr (SP2) {
            PG8_LDB(B0, 0, 0); PG8_LDB(B1, 0, 1); PG8_SCHED; PG8_LDA(At, 0, 0); PG8_STAGE(PG8_SA(1, 1), a1 + hstep, voffA);
            PG8_WAIT_V(8); PG8_WAIT_L(0); PG8_BAR; PG8_MMA(0, 0, At, B0); PG8_MMA(0, 1, At, B1); PG8_BAR; PG8_SCHED;
            PG8_LDA(At, 0, 1); PG8_STAGE(PG8_SB(0, 0), b2, voffB); PG8_STAGE(PG8_SB(0, 1), b2 + hstep, voffB); PG8_STAGE(PG8_SA(0, 0), a2, voffA);
            PG8_WAIT_V(8); PG8_WAIT_L(0); PG8_BAR; PG8_MMA(1, 0, At, B0); PG8_MMA(1, 1, At, B1); PG8_BAR; PG8_SCHED;
            PG8_LDB(B0, 1, 0); PG8_LDB(B1, 1, 1); PG8_SCHED; PG8_LDA(At, 1, 0); PG8_STAGE(PG8_SA(0, 1), a2 + hstep, voffA);
            PG8_WAIT_V(8); PG8_WAIT_L(0); PG8_BAR; PG8_MMA(0, 0, At, B0); PG8_MMA(0, 1, At, B1); PG8_BAR; PG8_SCHED;
            PG8_LDA(At, 1, 1); PG8_STAGE(PG8_SB(1, 0), b3, voffB); PG8_STAGE(PG8_SB(1, 1), b3 + hstep, voffB); PG8_STAGE(PG8_SA(1, 0), a3, voffA);
            PG8_WAIT_V(8); PG8_WAIT_L(0); PG8_BAR; PG8_MMA(1, 0, At, B0); PG8_MMA(1, 1, At, B1); PG8_BAR; PG8_SCHED;
            } else {
            PG8_LDB(B0, 0, 0); PG8_SCHED; PG8_LDA(At, 0, 0); PG8_STAGE(PG8_SA(1, 1), a1 + hstep, voffA);
            PG8_WAIT_L(8); PG8_BAR; PG8_WAIT_L(0); PG8_MMA(0, 0, At, B0); PG8_BAR; PG8_SCHED;
            PG8_LDB(B1, 0, 1); PG8_STAGE(PG8_SB(0, 0), b2, voffB);
            PG8_BAR; PG8_WAIT_L(0); PG8_MMA(0, 1, At, B1); PG8_BAR;
            PG8_LDA(At, 0, 1); PG8_STAGE(PG8_SA(0, 0), a2, voffA);
            PG8_BAR; PG8_WAIT_L(0); PG8_MMA(1, 0, At, B0); PG8_BAR; PG8_SCHED;
            PG8_STAGE(PG8_SB(0, 1), b2 + hstep, voffB);
            PG8_WAIT_V(6); PG8_BAR; PG8_MMA(1, 1, At, B1); PG8_BAR;
            PG8_LDB(B0, 1, 0); PG8_SCHED; PG8_LDA(At, 1, 0); PG8_STAGE(PG8_SA(0, 1), a2 + hstep, voffA);
            PG8_WAIT_L(8); PG8_BAR; PG8_WAIT_L(0); PG8_MMA(0, 0, At, B0); PG8_BAR; PG8_SCHED;
            PG8_LDB(B1, 1, 1); PG8_STAGE(PG8_SB(1, 0), b3, voffB);
            PG8_BAR; PG8_WAIT_L(0); PG8_MMA(0, 1, At, B1); PG8_BAR;
            PG8_LDA(At, 1, 1); PG8_STAGE(PG8_SA(1, 0), a3, voffA);
            PG8_BAR; PG8_WAIT_L(0); PG8_MMA(1, 0, At, B0); PG8_BAR; PG8_SCHED;
            PG8_STAGE(PG8_SB(1, 1), b3 + hstep, voffB);
            PG8_WAIT_V(6); PG8_BAR; PG8_MMA(1, 1, At, B1); PG8_BAR;
            }
        }
        if constexpr (ALIGN_EPI) { if (wr == 0) PG8_BAR; }
        if constexpr (!Epi::AFTER_DRAIN) { E(acc, cur, wr, wc, fr, fq); S.done(cur); }
        if (!has_next) break;
#pragma unroll
        for (int a = 0; a < 2; ++a)
#pragma unroll
            for (int b = 0; b < 2; ++b)
#pragma unroll
                for (int m = 0; m < 4; ++m)
#pragma unroll
                    for (int n = 0; n < 2; ++n) acc[a][b][m][n] = (f32x4){0.f, 0.f, 0.f, 0.f};
        cur = nxt; cA = nA; cB = nB; ++ui;
        if constexpr (ALIGN_EPI) { if (wr == 1) PG8_BAR; }
    }
    PG8_WAIT_V(0);
    if constexpr (!ALIGN_EPI) { if (wr == 0) PG8_BAR; }
    PG8_BAR;
    if constexpr (Epi::AFTER_DRAIN) { E.fused(acc, cur, wr, wc, fr, fq, lds, wid, lane); S.done(cur); }
#undef PG8_SA
#undef PG8_SB
#undef PG8_STAGE
#undef PG8_LDA
#undef PG8_LDB
#undef PG8_MMA
#undef PG8_WAIT_V
#undef PG8_WAIT_L
#undef PG8_BAR
#undef PG8_SCHED
}
}

#define PG8_SP2 true
#define PG8_ALIGN true
template <class RowMap>
__device__ __forceinline__ void transpose_item(const float* W, int K, int N, bf16* WT, const RowMap& rm, LAS float* scr, int item, int lane) {
    const int nblk = N / 32, kb = item / nblk, nb = item % nblk, k0 = 64 * kb, n0 = 32 * nb;
#pragma unroll 8
    for (int i = 0; i < 32; ++i) { const int kk = 2 * i + (lane >> 5); scr[kk * 33 + (lane & 31)] = W[(size_t)(k0 + kk) * N + n0 + (lane & 31)]; }
    asm volatile("s_waitcnt lgkmcnt(0)" ::: "memory");
    const int c = lane & 7;
#pragma unroll
    for (int j = 0; j < 4; ++j) { const int n = (lane >> 3) + 8 * j; const LAS float* sp = scr + (8 * c) * 33 + n;
        v4u o; o.x = pk2(sp[0 * 33], sp[1 * 33]); o.y = pk2(sp[2 * 33], sp[3 * 33]); o.z = pk2(sp[4 * 33], sp[5 * 33]); o.w = pk2(sp[6 * 33], sp[7 * 33]);
        *(v4u*)(WT + (size_t)rm(n0 + n) * K + k0 + 8 * c) = o; }
    asm volatile("s_waitcnt lgkmcnt(0)" ::: "memory");
}
struct RowId { __device__ __forceinline__ int operator()(int n) const { return n; } };
struct RowGU { int off; __device__ __forceinline__ int operator()(int n) const { return 256 * (n >> 7) + (n & 127) + off; } };
__device__ __forceinline__ void conv_small_weights(const Ctx& c) {
    LAS float* scr = (LAS float*)c.lds + c.wave * 4096;
    constexpr int I_IN = (D / 64) * (DIN / 32), I_OUT = (D / 64) * (D / 32);
    for (int it = c.gw; it < I_IN + I_OUT; it += c.NGW) {
        if (it < I_IN) transpose_item(inp(c, 10), D, DIN, (bf16*)(c.ws + WS_WIN_T), RowId{}, scr, it, c.lane);
        else transpose_item(inp(c, 23), D, D, (bf16*)(c.ws + WS_WOUT_T), RowId{}, scr, it - I_IN, c.lane);
    }
}
__device__ __forceinline__ void conv_moe_weights(const Ctx& c) {
    LAS float* scr = (LAS float*)c.lds + c.wave * 4096;
    constexpr int I_G = (D / 64) * (DE / 32), I_D = (DE / 64) * (D / 32), PER_E = 2 * I_G + I_D;
    for (int it = c.gw; it < NE * PER_E; it += c.NGW) {
        const int e = it / PER_E; int r = it % PER_E;
        bf16* gu = (bf16*)(c.ws + WS_WGU_T) + (size_t)e * 1024 * 1024; bf16* dn = (bf16*)(c.ws + WS_WD_T) + (size_t)e * 1024 * 512;
        if (r < I_G) { transpose_item(inp(c, 28) + (size_t)e * D * DE, D, DE, gu, RowGU{0}, scr, r, c.lane); continue; } r -= I_G;
        if (r < I_G) { transpose_item(inp(c, 29) + (size_t)e * D * DE, D, DE, gu, RowGU{128}, scr, r, c.lane); continue; } r -= I_G;
        transpose_item(inp(c, 30) + (size_t)e * DE * D, DE, D, dn, RowId{}, scr, r, c.lane);
    }
}
__device__ __forceinline__ v4u pack8(const f32x4 a, const f32x4 b) { v4u w; w.x = pg8::cvt_pk_bf16(a[0], a[1]); w.y = pg8::cvt_pk_bf16(a[2], a[3]); w.z = pg8::cvt_pk_bf16(b[0], b[1]); w.w = pg8::cvt_pk_bf16(b[2], b[3]); return w; }
struct EpiProj {
    static constexpr bool PERM = true, AFTER_DRAIN = false;
    unsigned char* ws;
    __device__ __forceinline__ void operator()(const f32x4 (&acc)[2][2][4][2], const pg8::Unit& un, int wr, int wc, int fr, int fq) const {
        const int colt = un.pn * 256, reg = colt >> 9;
        const size_t off = WS_XM + (size_t)(reg & 1) * (WS_Z - WS_XM) + (size_t)(reg >> 1) * (WS_U - WS_XM);
        bf16* base = (bf16*)(ws + off);
        const int lc0 = (colt & 511) + wc * 32 + 8 * fq, row0 = un.pm * 256 + wr * 64 + fr;
#pragma unroll
        for (int ai = 0; ai < 2; ++ai)
#pragma unroll
            for (int m = 0; m < 4; ++m) { bf16* rowp = base + (size_t)(row0 + ai * 128 + m * 16) * DM + lc0;
#pragma unroll
                for (int bj = 0; bj < 2; ++bj) *(v4u*)(rowp + bj * 128) = pack8(acc[ai][bj][m][0], acc[ai][bj][m][1]); }
    }
};
struct EpiY {
    static constexpr bool PERM = false, AFTER_DRAIN = false;
    float* Y;
    __device__ __forceinline__ void operator()(const f32x4 (&acc)[2][2][4][2], const pg8::Unit& un, int wr, int wc, int fr, int fq) const {
        const int row0 = un.pm * 256 + wr * 64 + fr, col0 = un.pn * 256 + wc * 32 + 4 * fq;
#pragma unroll
        for (int ai = 0; ai < 2; ++ai)
#pragma unroll
            for (int m = 0; m < 4; ++m) { float* rowp = Y + (size_t)(row0 + ai * 128 + m * 16) * D + col0;
#pragma unroll
                for (int bj = 0; bj < 2; ++bj)
#pragma unroll
                    for (int n = 0; n < 2; ++n) *(f32x4*)(rowp + bj * 128 + n * 16) = acc[ai][bj][m][n]; }
    }
};
struct EpiSwiGLU {
    static constexpr bool PERM = true, AFTER_DRAIN = false;
    bf16* act; const float* roww;
    __device__ __forceinline__ void operator()(const f32x4 (&acc)[2][2][4][2], const pg8::Unit& un, int wr, int wc, int fr, int fq) const {
        const int row0 = un.pm * 256 + wr * 64 + fr, col0 = (un.pn & 3) * 128 + wc * 32 + 8 * fq;
#pragma unroll
        for (int ai = 0; ai < 2; ++ai)
#pragma unroll
            for (int m = 0; m < 4; ++m) { const int row = row0 + ai * 128 + m * 16; const float w = roww[row];
                f32x4 o[2];
#pragma unroll
                for (int n = 0; n < 2; ++n)
#pragma unroll
                    for (int i = 0; i < 4; ++i) { const float g = acc[ai][0][m][n][i], uu = acc[ai][1][m][n][i]; o[n][i] = siluf(g) * uu * w; }
                *(v4u*)(act + (size_t)row * DE + col0) = pack8(o[0], o[1]); }
    }
};
struct EpiDown {
    static constexpr bool PERM = true, AFTER_DRAIN = false;
    bf16* yrow;
    __device__ __forceinline__ void operator()(const f32x4 (&acc)[2][2][4][2], const pg8::Unit& un, int wr, int wc, int fr, int fq) const {
        const int row0 = un.pm * 256 + wr * 64 + fr, col0 = (un.pn & 3) * 256 + wc * 32 + 8 * fq;
#pragma unroll
        for (int ai = 0; ai < 2; ++ai)
#pragma unroll
            for (int m = 0; m < 4; ++m) { bf16* rowp = yrow + (size_t)(row0 + ai * 128 + m * 16) * D + col0;
#pragma unroll
                for (int bj = 0; bj < 2; ++bj) *(v4u*)(rowp + bj * 128) = pack8(acc[ai][bj][m][0], acc[ai][bj][m][1]); }
    }
};
struct MoeOrder {
    int G, c; const volatile LAS int* ts;
    __device__ __forceinline__ bool next(int i, pg8::Unit& u) const {
        const int L = i * G + c; if (L >= ts[16] * 4) return false;
        const int mt = L >> 2; int e = 0;
#pragma unroll
        for (int j = 1; j < 16; ++j) e += (mt >= ts[j]) ? 1 : 0;
        u.pm = mt; u.pn = e * 4 + (L & 3); return true;
    }
    __device__ __forceinline__ void a_ready(const pg8::Unit&) const {}
    __device__ __forceinline__ void done(const pg8::Unit&) const {}
};
__device__ __forceinline__ int vcu_of(const Ctx& c) { return (c.G % 8 == 0) ? (c.bid % 8) * (c.G / 8) + c.bid / 8 : c.bid; }
__device__ __forceinline__ void moe_tile_table(const Ctx& c, volatile LAS int* ts) {
    if (c.tid == 0) {
        const unsigned* cnt = (const unsigned*)(c.ws + WS_CTL) + CW_CNT; int acc = 0;
        for (int e = 0; e < 16; ++e) { ts[e] = acc; acc += (int)((__hip_atomic_load(cnt + e, __ATOMIC_RELAXED, __HIP_MEMORY_SCOPE_AGENT) + 255u) >> 8); }
        ts[16] = acc;
    }
    __syncthreads();
}

__device__ __forceinline__ void g1_gemm1(const Ctx& c) {
    pg8::Gemm g{(const bf16*)(c.ws + WS_H), (const bf16*)(c.ws + WS_WIN_T), NT, DIN, D};
    pg8::StaticOrder S; S.init(NT, DIN, c.G, c.bid);
    EpiProj E{c.ws};
    pg8::gemm_phase<EpiProj, pg8::StaticOrder, PG8_ALIGN, PG8_SP2>((LAS unsigned char*)c.lds, g, S, E);
}
__device__ __forceinline__ void g2_outproj(const Ctx& c) {
    pg8::Gemm g{(const bf16*)(c.ws + WS_H), (const bf16*)(c.ws + WS_WOUT_T), T, D, D};
    pg8::StaticOrder S; S.init(T, D, c.G, c.bid);
    EpiY E{(float*)(c.ws + WS_Y)};
    pg8::gemm_phase<EpiY, pg8::StaticOrder, PG8_ALIGN, PG8_SP2>((LAS unsigned char*)c.lds, g, S, E);
}
__device__ __forceinline__ void g3_moe_up(const Ctx& c, volatile LAS int* ts) {
    moe_tile_table(c, ts);
    pg8::Gemm g{(const bf16*)(c.ws + WS_ASORT), (const bf16*)(c.ws + WS_WGU_T), 0, 0, D};
    MoeOrder S{c.G, vcu_of(c), ts};
    EpiSwiGLU E{(bf16*)(c.ws + WS_ACTS), (const float*)(c.ws + WS_ROWW)};
    pg8::gemm_phase<EpiSwiGLU, MoeOrder, PG8_ALIGN, PG8_SP2>((LAS unsigned char*)c.lds, g, S, E);
}
__device__ __forceinline__ void g4_moe_down(const Ctx& c, volatile LAS int* ts) {
    moe_tile_table(c, ts);
    pg8::Gemm g{(const bf16*)(c.ws + WS_ACTS), (const bf16*)(c.ws + WS_WD_T), 0, 0, DE};
    MoeOrder S{c.G, vcu_of(c), ts};
    EpiDown E{(bf16*)(c.ws + WS_YROW)};
    pg8::gemm_phase<EpiDown, MoeOrder, PG8_ALIGN, PG8_SP2>((LAS unsigned char*)c.lds, g, S, E);
}

__device__ __forceinline__ void p10b_token(const Ctx& c) {
    const float* x = inp(c, 0); const float* g_post = inp(c, 7); const float* g_ffn = inp(c, 8);
    const float* wrg = inp(c, 24); const float* brg = inp(c, 25); const float* wre = inp(c, 26); const float* bre = inp(c, 27);
    const float* mod = (const float*)(c.ws + WS_MOD);
    const float* posR = (const float*)(c.ws + WS_POSR); const float* posC = (const float*)(c.ws + WS_POSC);
    const float* Y = (const float*)(c.ws + WS_Y); bf16* H2 = (bf16*)(c.ws + WS_H); int* RE = (int*)(c.ws + WS_RE); float* RW = (float*)(c.ws + WS_RW); int* RS = (int*)(c.ws + WS_RS);
    unsigned* CNT = (unsigned*)(c.ws + WS_CTL) + CW_CNT;
    int* hist = (int*)c.lds; int* gbase = hist + 16; int* tinfo = hist + 32;
    if (c.tid < 32) hist[c.tid] = 0;
    __syncthreads();
    int li = 0;
    for (int r = c.gw; r < T; r += c.NGW, ++li) {
        asm volatile("" ::: "memory");
        f32x4 xv[4], yv[4]; float ss = 0.f;
#pragma unroll
        for (int j = 0; j < 4; ++j) {
            const int col = 256 * j + 4 * c.lane;
            const float* pp = col < 512 ? posR + (r >> 6) * 512 + col : posC + (r & 63) * 512 + (col - 512);
            xv[j] = *(const f32x4*)(x + (size_t)r * D + col) + *(const f32x4*)pp;
            yv[j] = *(const f32x4*)(Y + (size_t)r * D + col);
            ss += yv[j].x * yv[j].x + yv[j].y * yv[j].y + yv[j].z * yv[j].z + yv[j].w * yv[j].w;
        }
        const float rinv = rsqrtf(wave_sum(ss) * (1.f / D) + EPS);
        float s2 = 0.f;
#pragma unroll
        for (int j = 0; j < 4; ++j) {
            const int col = 256 * j + 4 * c.lane;
            const f32x4 gg = *(const f32x4*)(g_post + col), g1 = *(const f32x4*)(mod + 2048 + col);
            xv[j] = xv[j] + g1 * (yv[j] * rinv * gg);
            *(f32x4*)(c.out + (size_t)r * D + col) = xv[j];
            s2 += xv[j].x * xv[j].x + xv[j].y * xv[j].y + xv[j].z * xv[j].z + xv[j].w * xv[j].w;
        }
        const float rinv2 = rsqrtf(wave_sum(s2) * (1.f / D) + EPS);
        float lg[20];
#pragma unroll
        for (int i = 0; i < 20; ++i) lg[i] = 0.f;
#pragma unroll
        for (int j = 0; j < 4; ++j) {
            const int col = 256 * j + 4 * c.lane;
            const f32x4 gg = *(const f32x4*)(g_ffn + col), sh = *(const f32x4*)(mod + 3072 + col), sc = *(const f32x4*)(mod + 4096 + col);
            const f32x4 hv = xv[j] * rinv2 * gg * (sc + 1.f) + sh;
            uint2 w; w.x = pk2(hv.x, hv.y); w.y = pk2(hv.z, hv.w);
            *(uint2*)(H2 + (size_t)r * D + col) = w;
            const float he[4] = {hv.x, hv.y, hv.z, hv.w};
#pragma unroll
            for (int e = 0; e < 4; ++e) {
                const f32x4 wg4 = *(const f32x4*)(wrg + (size_t)(col + e) * 4);
                lg[0] += he[e] * wg4.x; lg[1] += he[e] * wg4.y; lg[2] += he[e] * wg4.z; lg[3] += he[e] * wg4.w;
#pragma unroll
                for (int q4 = 0; q4 < 4; ++q4) {
                    const f32x4 we4 = *(const f32x4*)(wre + (size_t)(col + e) * 16 + q4 * 4);
                    lg[4 + q4 * 4] += he[e] * we4.x; lg[5 + q4 * 4] += he[e] * we4.y; lg[6 + q4 * 4] += he[e] * we4.z; lg[7 + q4 * 4] += he[e] * we4.w;
                }
            }
        }
#pragma unroll
        for (int i = 0; i < 20; ++i) lg[i] = wave_sum(lg[i]);
        if (c.lane == 0) {
            float gl[4];
#pragma unroll
            for (int i = 0; i < 4; ++i) gl[i] = lg[i] + brg[i];
            int gs = 0; float gm = gl[0];
#pragma unroll
            for (int i = 1; i < 4; ++i) if (gl[i] > gm) { gm = gl[i]; gs = i; }
            float den = 0.f;
#pragma unroll
            for (int i = 0; i < 4; ++i) den += __expf(gl[i] - gm);
            const float psel = 1.f / den;
            float el[4];
#pragma unroll
            for (int i = 0; i < 4; ++i) {
                float v = 0.f;
#pragma unroll
                for (int g2 = 0; g2 < 4; ++g2) v = (g2 == gs) ? lg[4 + g2 * 4 + i] + bre[g2 * 4 + i] : v;
                el[i] = v;
            }
            int i1 = 0; float em1 = el[0];
#pragma unroll
            for (int i = 1; i < 4; ++i) if (el[i] > em1) { em1 = el[i]; i1 = i; }
            int i2 = -1; float em2 = -INFINITY;
#pragma unroll
            for (int i = 0; i < 4; ++i) if (i != i1 && el[i] > em2) { em2 = el[i]; i2 = i; }
            const float e2 = __expf(em2 - em1), w1 = psel / (1.f + e2), w2 = psel * e2 / (1.f + e2);
            const int ea = gs * 4 + i1, eb = gs * 4 + i2;
            RE[2 * r] = ea; RE[2 * r + 1] = eb; RW[2 * r] = w1; RW[2 * r + 1] = w2;
            int* ti = tinfo + (c.wave * 8 + li) * 4;
            ti[0] = ea; ti[1] = eb; ti[2] = atomicAdd(hist + ea, 1); ti[3] = atomicAdd(hist + eb, 1);
        }
    }
    __syncthreads();
    if (c.tid < 16) gbase[c.tid] = (int)__hip_atomic_fetch_add(CNT + c.tid, (unsigned)hist[c.tid], __ATOMIC_RELAXED, __HIP_MEMORY_SCOPE_AGENT);
    __syncthreads();
    if (c.lane < li) {
        const int r = c.gw + c.lane * c.NGW; const int* ti = tinfo + (c.wave * 8 + c.lane) * 4;
        RS[2 * r] = gbase[ti[0]] + ti[2]; RS[2 * r + 1] = gbase[ti[1]] + ti[3];
    }
    __syncthreads();
}
__device__ __forceinline__ void p10c_scatter(const Ctx& c) {
    const bf16* H2 = (const bf16*)(c.ws + WS_H); bf16* AS = (bf16*)(c.ws + WS_ASORT);
    const int* RE = (const int*)(c.ws + WS_RE); const float* RW = (const float*)(c.ws + WS_RW); int* RS = (int*)(c.ws + WS_RS); float* ROWW = (float*)(c.ws + WS_ROWW);
    const unsigned* CNT = (const unsigned*)(c.ws + WS_CTL) + CW_CNT;
    for (int r = c.gw; r < T; r += c.NGW) {
        asm volatile("" ::: "memory");
        const int e0 = RE[2 * r], e1 = RE[2 * r + 1]; int b0 = 0, b1 = 0;
        for (int e = 0; e < 16; ++e) { const int tl = (int)((CNT[e] + 255u) >> 8) * 256; b0 += e < e0 ? tl : 0; b1 += e < e1 ? tl : 0; }
        const int r0 = b0 + RS[2 * r], r1 = b1 + RS[2 * r + 1];
        const v4u* src = (const v4u*)(H2 + (size_t)r * D);
        const v4u a = src[c.lane], b = src[c.lane + 64];
        v4u* d0 = (v4u*)(AS + (size_t)r0 * D); v4u* d1 = (v4u*)(AS + (size_t)r1 * D);
        d0[c.lane] = a; d0[c.lane + 64] = b; d1[c.lane] = a; d1[c.lane + 64] = b;
        if (c.lane == 0) { ROWW[r0] = RW[2 * r]; ROWW[r1] = RW[2 * r + 1]; RS[2 * r] = r0; RS[2 * r + 1] = r1; }
    }
}
__device__ __forceinline__ void p12b_final(const Ctx& c) {
    const float* g_post = inp(c, 9); const float* mod = (const float*)(c.ws + WS_MOD); const bf16* YR = (const bf16*)(c.ws + WS_YROW); const int* RS = (const int*)(c.ws + WS_RS);
    for (int r = c.gw; r < T; r += c.NGW) {
        asm volatile("" ::: "memory");
        const int r0 = RS[2 * r], r1 = RS[2 * r + 1];
        f32x4 yv[4]; float ss = 0.f;
#pragma unroll
        for (int j = 0; j < 4; ++j) {
            const int col = 256 * j + 4 * c.lane;
            const uint2 a = *(const uint2*)(YR + (size_t)r0 * D + col), b = *(const uint2*)(YR + (size_t)r1 * D + col);
            yv[j] = (f32x4){lo16(a.x) + lo16(b.x), hi16(a.x) + hi16(b.x), lo16(a.y) + lo16(b.y), hi16(a.y) + hi16(b.y)};
            ss += yv[j].x * yv[j].x + yv[j].y * yv[j].y + yv[j].z * yv[j].z + yv[j].w * yv[j].w;
        }
        const float rinv = rsqrtf(wave_sum(ss) * (1.f / D) + EPS);
#pragma unroll
        for (int j = 0; j < 4; ++j) {
            const int col = 256 * j + 4 * c.lane;
            const f32x4 gg = *(const f32x4*)(g_post + col), g2 = *(const f32x4*)(mod + 5120 + col);
            f32x4* o = (f32x4*)(c.out + (size_t)r * D + col);
            *o = *o + g2 * (yv[j] * rinv * gg);
        }
    }
}

#define XB_TMO      128
#define XB_XCNT(j)  (256  + 64 * (j))
#define XB_XSUB(j)  (1280 + 64 * (j))
#define XB_XGEN(j)  (2304 + 64 * (j))
#define XB_TOP      3328
#define XB_TOPGEN   3392
#define XCD_BAR_WORDS 3456
#define XB_SPIN_CAP (1u << 18)
__device__ __forceinline__ unsigned xb_ld(unsigned* p)              { return __hip_atomic_load(p, __ATOMIC_RELAXED, __HIP_MEMORY_SCOPE_AGENT); }
__device__ __forceinline__ unsigned xb_add(unsigned* p, unsigned v) { return __hip_atomic_fetch_add(p, v, __ATOMIC_RELAXED, __HIP_MEMORY_SCOPE_AGENT); }
__device__ __forceinline__ unsigned xb_xcc_id() { return (unsigned)__builtin_amdgcn_s_getreg((3 << 11) | 20) & 0xFu; }
#define XB_SPIN(cond, bar) do { unsigned _sp = 0; while (cond) { __builtin_amdgcn_s_sleep(1); \
    if ((++_sp & 255u) == 0u) { if (xb_ld(&(bar)[XB_TMO])) break; if (_sp > XB_SPIN_CAP) { atomicAdd(&(bar)[XB_TMO], 1u); break; } } } } while (0)
struct XcdBarrier { unsigned* bar; unsigned x; volatile LAS unsigned* st; };
__device__ __forceinline__ XcdBarrier xcd_barrier_post(unsigned* bar, volatile LAS unsigned* st) {
    XcdBarrier b; b.bar = bar; b.x = xb_xcc_id(); b.st = st;
    if (threadIdx.x == 0) (void)xb_add(&bar[XB_XCNT(b.x)], 1u);
    return b;
}
__device__ __forceinline__ void xcd_barrier_complete(unsigned* bar, unsigned x, unsigned& nloc, unsigned& nx) {
    const unsigned G = gridDim.x * gridDim.y * gridDim.z;
    unsigned sum, cnt, mine, sp = 0u;
    for (;;) {
        sum = 0u; cnt = 0u; mine = 0u;
#pragma unroll
        for (unsigned j = 0; j < 16; ++j) { const unsigned c = xb_ld(&bar[XB_XCNT(j)]); sum += c; cnt += (c > 0u) ? 1u : 0u; mine = (j == x) ? c : mine; }
        if (sum == G) break;
        __builtin_amdgcn_s_sleep(1);
        if ((++sp & 255u) == 0u) { if (xb_ld(&bar[XB_TMO])) break; if (sp > XB_SPIN_CAP) { atomicAdd(&bar[XB_TMO], 1u); break; } }
    }
    nloc = mine > 0u ? mine : 1u; nx = cnt > 0u ? cnt : 1u;
}
__device__ __forceinline__ void xcd_barrier(const XcdBarrier& b) {
    asm volatile("s_waitcnt vmcnt(0)" ::: "memory");
    __syncthreads();
    if (threadIdx.x == 0) {
        unsigned* bar = b.bar;
        __builtin_amdgcn_s_waitcnt(0);
        unsigned nloc = b.st[0], nx = b.st[1];
        if (nloc == 0u) { xcd_barrier_complete(bar, b.x, nloc, nx); b.st[0] = nloc; b.st[1] = nx; }
        const unsigned old = xb_add(&bar[XB_XSUB(b.x)], 1u);
        const unsigned gen = old / nloc;
        if (old + 1u == (gen + 1u) * nloc) {
            __builtin_amdgcn_fence(__ATOMIC_RELEASE, "agent");
            asm volatile("s_waitcnt vmcnt(0)" ::: "memory");
            const unsigned og = xb_add(&bar[XB_TOP], 1u);
            const unsigned tg = og / nx;
            if (og + 1u == (tg + 1u) * nx) xb_add(&bar[XB_TOPGEN], 1u);
            else XB_SPIN(xb_ld(&bar[XB_TOPGEN]) == tg, bar);
            __builtin_amdgcn_fence(__ATOMIC_ACQUIRE, "agent");
            xb_add(&bar[XB_XGEN(b.x)], 1u);
            asm volatile("s_waitcnt vmcnt(0)" ::: "memory");
        } else {
            XB_SPIN(xb_ld(&bar[XB_XGEN(b.x)]) == gen, bar);
            __builtin_amdgcn_fence(__ATOMIC_ACQUIRE, "agent");
            asm volatile("s_waitcnt vmcnt(0)" ::: "memory");
        }
    }
    __syncthreads();
}

#ifndef MK_CG_SYNC
#define MK_CG_SYNC 0
#endif
constexpr int MISC_OFF = LDS_BYTES - 256;
constexpr int TAB_OFF = LDS_BYTES - 1024;
__global__ void __launch_bounds__(NTHREADS, 2) fwd_kernel(Args a) {
    extern __shared__ __attribute__((aligned(16))) unsigned char lds_raw[];
    Ctx c;
    c.tid = threadIdx.x; c.lane = c.tid & 63; c.wave = __builtin_amdgcn_readfirstlane(c.tid >> 6);
    c.G = gridDim.x; c.bid = blockIdx.x; c.gw = c.bid * NWAVES + c.wave; c.NGW = c.G * NWAVES; c.gtid = c.bid * NTHREADS + c.tid; c.NTHR = c.G * NTHREADS;
    c.lds = (float*)lds_raw;
    {
        volatile LAS unsigned* tabw = (volatile LAS unsigned*)((LAS unsigned char*)lds_raw + TAB_OFF);
        if (c.tid == 0) {
#define PUT(i, p) do { tabw[2 * (i)] = (unsigned)(size_t)(p); tabw[2 * (i) + 1] = (unsigned)((size_t)(p) >> 32); } while (0)
            PUT(0, a.in[0]); PUT(1, a.in[1]); PUT(2, a.in[2]); PUT(3, a.in[3]); PUT(4, a.in[4]); PUT(5, a.in[5]); PUT(6, a.in[6]); PUT(7, a.in[7]);
            PUT(8, a.in[8]); PUT(9, a.in[9]); PUT(10, a.in[10]); PUT(11, a.in[11]); PUT(12, a.in[12]); PUT(13, a.in[13]); PUT(14, a.in[14]); PUT(15, a.in[15]);
            PUT(16, a.in[16]); PUT(17, a.in[17]); PUT(18, a.in[18]); PUT(19, a.in[19]); PUT(20, a.in[20]); PUT(21, a.in[21]); PUT(22, a.in[22]); PUT(23, a.in[23]);
            PUT(24, a.in[24]); PUT(25, a.in[25]); PUT(26, a.in[26]); PUT(27, a.in[27]); PUT(28, a.in[28]); PUT(29, a.in[29]); PUT(30, a.in[30]); PUT(31, a.ws); PUT(32, a.out);
#undef PUT
        }
        c.tab = tabw; c.ws = a.ws; c.out = a.out;
    }
    __syncthreads();
#if MK_CG_SYNC
    cooperative_groups::grid_group grid = cooperative_groups::this_grid();
#define GRID_BAR() do { grid.sync(); } while (0)
#else
    volatile LAS unsigned* misc = (volatile LAS unsigned*)((LAS unsigned char*)lds_raw + MISC_OFF);
    if (c.tid < 64) misc[c.tid] = 0u;
    __syncthreads();
    const XcdBarrier bar = xcd_barrier_post((unsigned*)(a.ws + WS_CTL) + 4096, misc + 8);
#define GRID_BAR() do { xcd_barrier(bar); } while (0)
#endif
    volatile LAS int* ts = (volatile LAS int*)((LAS unsigned char*)lds_raw + MISC_OFF) + 16;
    p0_prologue(fresh(c)); conv_small_weights(fresh(c));   GRID_BAR();
    p1_hrows(fresh(c));               GRID_BAR();
    g1_gemm1(fresh(c));               GRID_BAR();
    p3_features(fresh(c)); p6_fourier_a(fresh(c));   GRID_BAR();
    p4_summaries(fresh(c));           GRID_BAR();
    p5_scan(fresh(c)); p7a_fourier_c(fresh(c));      GRID_BAR();
    p7b_fourier_mix(fresh(c)); p8_mlstm_out(fresh(c)); conv_moe_weights(fresh(c));   GRID_BAR();
    g2_outproj(fresh(c));             GRID_BAR();
    p10b_token(fresh(c));             GRID_BAR();
    p10c_scatter(fresh(c));           GRID_BAR();
    g3_moe_up(fresh(c), ts);          GRID_BAR();
    g4_moe_down(fresh(c), ts);        GRID_BAR();
    p12b_final(fresh(c));
}

extern "C" void kernel_launch(void* const* d_in, const int* in_sizes, int n_in, void* d_out, int out_size, void* d_ws, size_t ws_size, hipStream_t stream) {
    static int grid = 0;
    if (grid == 0) {
        if (n_in != 31 || out_size != T * D || ws_size < 256 * MiB) { fprintf(stderr, "kernel_launch: unexpected shapes n_in %d out %d ws %zu\n", n_in, out_size, ws_size); grid = -1; return; }
        int dev = 0, cus = 0, per_cu = 0;
        (void)hipGetDevice(&dev); (void)hipDeviceGetAttribute(&cus, hipDeviceAttributeMultiprocessorCount, dev);
        if (hipFuncSetAttribute((const void*)fwd_kernel, hipFuncAttributeMaxDynamicSharedMemorySize, LDS_BYTES) != hipSuccess) { fprintf(stderr, "kernel_launch: hipFuncSetAttribute failed\n"); grid = -1; return; }
        if (hipOccupancyMaxActiveBlocksPerMultiprocessor(&per_cu, (const void*)fwd_kernel, NTHREADS, LDS_BYTES) != hipSuccess || per_cu < 1) { fprintf(stderr, "kernel_launch: occupancy query says %d blocks per CU\n", per_cu); (void)hipGetLastError(); per_cu = 1; }
        grid = (cus > 0 ? cus : 256);
        fprintf(stderr, "kernel_launch: cus %d occupancy %d grid %d\n", cus, per_cu, grid);
    }
    if (grid < 0) return;
    (void)hipMemsetAsync((char*)d_ws + WS_CTL, 0, 65536, stream);
    Args a{};
    for (int i = 0; i < 31; ++i) a.in[i] = (const float*)d_in[i];
    a.out = (float*)d_out; a.ws = (unsigned char*)d_ws; a.ph_lo = 0; a.ph_hi = 0;
    void* kargs[] = {&a};
    hipError_t e = hipLaunchCooperativeKernel((const void*)fwd_kernel, dim3(grid), dim3(NTHREADS), kargs, LDS_BYTES, stream);
    if (e != hipSuccess) fprintf(stderr, "kernel_launch: cooperative launch failed: %s (grid %d)\n", hipGetErrorString(e), grid);
}
```

```cpp
#include <hip/hip_runtime.h>
#include <hip/hip_cooperative_groups.h>
#include <cstdio>

typedef unsigned short bf16;
typedef unsigned v4u __attribute__((ext_vector_type(4)));
typedef float f32x4 __attribute__((ext_vector_type(4)));

constexpr int D = 1024, T = 16384, TC = 256, NT = T + TC;
constexpr int DM = 512, NH = 4, DH = 128, CH = 128, NCL = T / CH, NCC = TC / CH, NCH = NCL + NCC;
constexpr int DIN = 1536, NE = 16, DE = 512;
constexpr float EPS = 1e-6f;
constexpr int NTHREADS = 512, NWAVES = 8;
constexpr int LDS_BYTES = 163840;

constexpr size_t MiB = 1u << 20;
constexpr size_t WS_CTL = 0;
constexpr size_t WS_MOD = 1 * MiB;
constexpr size_t WS_MODC = 1 * MiB + 32768;
constexpr size_t WS_POSR = 1 * MiB + 65536;
constexpr size_t WS_POSC = WS_POSR + 256 * 512 * 4;
constexpr size_t WS_G = 2 * MiB;
constexpr size_t WS_IG = 3 * MiB;
constexpr size_t WS_LF = 4 * MiB;
constexpr size_t WS_AMAX = 5 * MiB;
constexpr size_t WS_BTOT = 5 * MiB + 8192;
constexpr size_t WS_M0 = 5 * MiB + 16384;
constexpr size_t WS_NL = 5 * MiB + 65536;
constexpr size_t WS_N0 = 6 * MiB;
constexpr size_t WS_RE = 7 * MiB;
constexpr size_t WS_RW = 7 * MiB + 256 * 1024;
constexpr size_t WS_H = 13 * MiB;
constexpr size_t WS_XM = 46 * MiB;
constexpr size_t WS_U = WS_XM + (size_t)NT * 1024;
constexpr size_t WS_Z = 79 * MiB;
constexpr size_t WS_C0 = 46 * MiB;
constexpr size_t WS_Q = 96 * MiB, WS_K = WS_Q + (size_t)NT * 1024, WS_V = WS_K + (size_t)NT * 1024, WS_ACT = WS_V + (size_t)NT * 1024;
constexpr size_t WS_L = 163 * MiB;
constexpr size_t WS_Y = 96 * MiB;
static_assert(WS_U + (size_t)NT * 1024 <= WS_Z && WS_Z + (size_t)NT * 1024 <= WS_Q && WS_ACT + (size_t)NT * 1024 <= WS_L && WS_L + 65 * MiB <= 256 * MiB, "ws map");
static_assert(WS_C0 + 32 * MiB <= WS_Z && WS_Y + 64 * MiB <= WS_L && WS_H + (size_t)NT * 2048 <= WS_XM, "ws map 2");
constexpr size_t WS_WIN_T = 8 * MiB;
constexpr size_t WS_WOUT_T = 11 * MiB;
constexpr size_t WS_WGU_T = 168 * MiB;
constexpr size_t WS_WD_T = 200 * MiB;
constexpr size_t WS_ASORT = 96 * MiB;
constexpr size_t WS_YROW = 96 * MiB;
constexpr size_t WS_ACTS = 46 * MiB;
constexpr size_t WS_RS = 7 * MiB + 512 * 1024;
constexpr size_t WS_ROWW = 216 * MiB;
constexpr int CW_CNT = 8192;
static_assert(WS_ASORT + 72 * MiB <= WS_WGU_T && WS_WD_T + 16 * MiB <= WS_ROWW && WS_ACTS + 36 * MiB <= WS_ASORT, "ws map 3");

#define LAS __attribute__((address_space(3)))
struct Args { const float* in[31]; float* out; unsigned char* ws; int ph_lo, ph_hi; };

__device__ __forceinline__ float bf2f(unsigned b) { return __uint_as_float(b << 16); }
__device__ __forceinline__ unsigned f2bf(float f) { unsigned u = __float_as_uint(f); return (u + 0x7fffu + ((u >> 16) & 1u)) >> 16; }
__device__ __forceinline__ unsigned pk2(float lo, float hi) { return f2bf(lo) | (f2bf(hi) << 16); }
__device__ __forceinline__ float lo16(unsigned w) { return __uint_as_float(w << 16); }
__device__ __forceinline__ float hi16(unsigned w) { return __uint_as_float(w & 0xffff0000u); }
__device__ __forceinline__ float wave_sum(float v) {
#pragma unroll
    for (int o = 1; o < 64; o <<= 1) v += __shfl_xor(v, o);
    return v;
}
__device__ __forceinline__ float siluf(float x) { return x / (1.f + __expf(-x)); }
__device__ __forceinline__ float logsigf(float x) { return fminf(x, 0.f) - log1pf(__expf(-fabsf(x))); }
__device__ __forceinline__ void unpack8(const v4u w, float (&f)[8]) {
    f[0] = lo16(w.x); f[1] = hi16(w.x); f[2] = lo16(w.y); f[3] = hi16(w.y); f[4] = lo16(w.z); f[5] = hi16(w.z); f[6] = lo16(w.w); f[7] = hi16(w.w);
}
template <bool MAXOP>
__device__ __forceinline__ float scan128(float v, bool rev, LAS float* tmp, int tid, int lane, int wave) {
    float x = v;
#pragma unroll
    for (int o = 1; o < 64; o <<= 1) {
        const float y = rev ? __shfl_down(x, o) : __shfl_up(x, o);
        const bool ok = rev ? (lane + o < 64) : (lane >= o);
        if (ok) x = MAXOP ? fmaxf(x, y) : x + y;
    }
    if (wave < 2 && lane == (rev ? 0 : 63)) tmp[wave] = x;
    __syncthreads();
    if (tid < 128) {
        if (!rev && wave == 1) x = MAXOP ? fmaxf(x, tmp[0]) : x + tmp[0];
        if (rev && wave == 0) x = MAXOP ? fmaxf(x, tmp[1]) : x + tmp[1];
    }
    __syncthreads();
    return x;
}
__device__ __forceinline__ int chunk_row0(int d, int j) {
    if (d == 0) return j < NCC ? T + j * CH : (j - NCC) * CH;
    return j < NCC ? T + (NCC - 1 - j) * CH : (NCL - 1 - (j - NCC)) * CH;
}

struct Ctx {
    int tid, lane, wave, gw, NGW, gtid, NTHR, G, bid;
    unsigned char* ws; float* out; const volatile LAS unsigned* tab;
    float* lds;
};

__device__ __forceinline__ const void* tab_ptr(const volatile LAS unsigned* tab, int i) {
    unsigned lo = tab[2 * i], hi = tab[2 * i + 1];
    lo = __builtin_amdgcn_readfirstlane(lo); hi = __builtin_amdgcn_readfirstlane(hi);
    return (const void*)(((size_t)hi << 32) | lo);
}
__device__ __forceinline__ const float* inp(const Ctx& c, int i) { return (const float*)tab_ptr(c.tab, i); }
__device__ __forceinline__ Ctx fresh(const Ctx& c0) {
    Ctx c = c0;
    int t = threadIdx.x; asm volatile("" : "+v"(t));
    c.tid = t; c.lane = t & 63; c.wave = __builtin_amdgcn_readfirstlane(t >> 6);
    c.gw = c.bid * NWAVES + c.wave; c.gtid = c.bid * NTHREADS + t;
    c.ws = (unsigned char*)tab_ptr(c0.tab, 31); c.out = (float*)tab_ptr(c0.tab, 32);
    return c;
}
template <int K>
__device__ __forceinline__ void gemm_8x64(const bf16* a0, const bf16* a1, const bf16* a2, const bf16* a3, const bf16* a4, const bf16* a5, const bf16* a6, const bf16* a7,
                                          const float* B, int ldb, int col, float (&acc)[8]) {
    for (int k0 = 0; k0 < K; k0 += 8) {
        float a[8][8];
        unpack8(*(const v4u*)(a0 + k0), a[0]); unpack8(*(const v4u*)(a1 + k0), a[1]); unpack8(*(const v4u*)(a2 + k0), a[2]); unpack8(*(const v4u*)(a3 + k0), a[3]);
        unpack8(*(const v4u*)(a4 + k0), a[4]); unpack8(*(const v4u*)(a5 + k0), a[5]); unpack8(*(const v4u*)(a6 + k0), a[6]); unpack8(*(const v4u*)(a7 + k0), a[7]);
#pragma unroll
        for (int kk = 0; kk < 8; ++kk) {
            const float b = B[(size_t)(k0 + kk) * ldb + col];
#pragma unroll
            for (int r = 0; r < 8; ++r) acc[r] += a[r][kk] * b;
        }
    }
}

__device__ __forceinline__ void p0_prologue(const Ctx& c) {
    const float* cvec = inp(c, 1); const float* ccvec = inp(c, 3); const float* w_ada = inp(c, 4); const float* b_ada = inp(c, 5);
    float* mod = (float*)(c.ws + WS_MOD); float* modc = (float*)(c.ws + WS_MODC);
    for (int it = c.bid; it < 96; it += c.G) {
        const int col = it * 64 + c.lane; float al = 0.f, ac = 0.f;
#pragma unroll 16
        for (int k = c.wave * 128; k < c.wave * 128 + 128; ++k) {
            const float w = w_ada[(size_t)k * 6144 + col];
            al += siluf(cvec[k]) * w; ac += siluf(ccvec[k]) * w;
        }
        c.lds[(c.wave * 64 + c.lane) * 2] = al; c.lds[(c.wave * 64 + c.lane) * 2 + 1] = ac;
        __syncthreads();
        if (c.wave == 0) {
            float sl = 0.f, sc = 0.f;
            for (int w = 0; w < 8; ++w) { sl += c.lds[(w * 64 + c.lane) * 2]; sc += c.lds[(w * 64 + c.lane) * 2 + 1]; }
            mod[col] = sl + b_ada[col];
            if (col < 2048) modc[col] = sc + b_ada[col];
        }
        __syncthreads();
    }
    float* posR = (float*)(c.ws + WS_POSR);
    for (int i = c.gtid; i < 320 * 512; i += c.NTHR) {
        const int r = i >> 9, j = i & 511, p = r < 256 ? r : r - 256, fi = j & 255;
        const float freq = 1.0f / powf(10000.0f, (float)fi / 256.0f);
        const float ang = (float)p * freq;
        posR[i] = j < 256 ? sinf(ang) : cosf(ang);
    }
    const float* wf = inp(c, 22); bf16* Gt = (bf16*)(c.ws + WS_G);
    const float scale = 1.0f / sqrtf(16384.0f * 128.0f);
    for (int i = c.gtid; i < 4 * 128 * 256; i += c.NTHR) {
        const int g = i >> 15, d = (i >> 8) & 127, row = i & 255, cc = row & 127; float s = 0.f;
#pragma unroll 8
        for (int c2 = 0; c2 < 128; ++c2) {
            const float ph = (float)((cc * c2) & 127) * (1.0f / 64.0f);
            const float tr = row < 128 ? cospif(ph) : sinpif(ph);
            s += tr * wf[(g * 128 + c2) * 128 + d];
        }
        Gt[i] = (bf16)f2bf(s * scale);
    }
}

__device__ __forceinline__ void p1_hrows(const Ctx& c) {
    const float* x = inp(c, 0); const float* ctx = inp(c, 2); const float* g = inp(c, 6);
    const float* mod = (const float*)(c.ws + WS_MOD); const float* modc = (const float*)(c.ws + WS_MODC);
    const float* posR = (const float*)(c.ws + WS_POSR); const float* posC = (const float*)(c.ws + WS_POSC);
    bf16* H = (bf16*)(c.ws + WS_H);
    for (int r = c.gw; r < NT; r += c.NGW) {
        asm volatile("" ::: "memory");
        const bool lat = r < T;
        const float* src = lat ? x + (size_t)r * D : ctx + (size_t)(r - T) * D;
        const float* md = lat ? mod : modc;
        f32x4 v[4]; float ss = 0.f;
#pragma unroll
        for (int j = 0; j < 4; ++j) {
            const int col = 256 * j + 4 * c.lane;
            v[j] = *(const f32x4*)(src + col);
            if (lat) { const float* pp = col < 512 ? posR + (r >> 6) * 512 + col : posC + (r & 63) * 512 + (col - 512); v[j] += *(const f32x4*)pp; }
            ss += v[j].x * v[j].x + v[j].y * v[j].y + v[j].z * v[j].z + v[j].w * v[j].w;
        }
        const float rinv = rsqrtf(wave_sum(ss) * (1.f / D) + EPS);
#pragma unroll
        for (int j = 0; j < 4; ++j) {
            const int col = 256 * j + 4 * c.lane;
            const f32x4 gg = *(const f32x4*)(g + col), sh = *(const f32x4*)(md + col), sc = *(const f32x4*)(md + 1024 + col);
            const f32x4 o = v[j] * rinv * gg * (sc + 1.f) + sh;
            uint2 w; w.x = pk2(o.x, o.y); w.y = pk2(o.z, o.w);
            *(uint2*)(H + (size_t)r * D + col) = w;
        }
    }
}

__device__ __forceinline__ void p3_features(const Ctx& c) {
    const bf16* XM = (const bf16*)(c.ws + WS_XM);
    bf16* Q = (bf16*)(c.ws + WS_Q); bf16* Kb = (bf16*)(c.ws + WS_K); bf16* Vb = (bf16*)(c.ws + WS_V); bf16* ACT = (bf16*)(c.ws + WS_ACT);
    float* IG = (float*)(c.ws + WS_IG); float* LF = (float*)(c.ws + WS_LF);
    LAS float* WL = (LAS float*)c.lds; LAS float* PW = WL + 24 * 64 * 20;
    {
        const float* wf_ = inp(c, 16); const float* wb_ = inp(c, 18);
        for (int idx = c.tid; idx < 24 * 64 * 16; idx += NTHREADS) {
            const int pi = idx >> 10, ln = (idx >> 4) & 63, dj = idx & 15, part = pi >> 3, i = pi & 7, d = dj >> 3, j = dj & 7;
            WL[(pi * 64 + ln) * 20 + dj] = (d ? wb_ : wf_)[(size_t)(part * 512 + 8 * ln + i) * 8 + j];
        }
        const float* conv_w = inp(c, 11); const float* conv_b = inp(c, 12); const float* wq = inp(c, 13); const float* wk = inp(c, 14); const float* wv = inp(c, 15);
        for (int idx = c.tid; idx < 64 * 128; idx += NTHREADS) {
            const int ln = idx >> 7, k = idx & 127; float v;
            if (k < 32) v = wq[ln * 32 + k]; else if (k < 64) v = wk[ln * 32 + k - 32]; else if (k < 96) v = wv[ln * 32 + k - 64];
            else if (k < 120) v = conv_w[((k - 96) >> 3) * DM + 8 * ln + ((k - 96) & 7)]; else v = conv_b[8 * ln + k - 120];
            PW[((k >> 2) * 64 + ln) * 4 + (k & 3)] = v;
        }
    }
    __syncthreads();
    const float bias_ = 0.f; (void)bias_;
    const float* bif_f = inp(c, 17); const float* bif_b = inp(c, 19);
    const int ch0 = 8 * c.lane;
#define PWV(k4) (*(const LAS f32x4*)(PW + ((k4) * 64 + c.lane) * 4))
    for (int r = c.gw; r < NT; r += c.NGW) {
        const bool lat = r < T;
        const bool hasp = lat ? (r > 0) : (r > T), hasn = lat ? (r < T - 1) : (r < NT - 1);
        float xc[8], xp[8], xn[8];
        unpack8(*(const v4u*)(XM + (size_t)r * DM + ch0), xc);
        if (hasp) unpack8(*(const v4u*)(XM + (size_t)(r - 1) * DM + ch0), xp); else { for (int i = 0; i < 8; ++i) xp[i] = 0.f; }
        if (hasn) unpack8(*(const v4u*)(XM + (size_t)(r + 1) * DM + ch0), xn); else { for (int i = 0; i < 8; ++i) xn[i] = 0.f; }
        float act[8], q[8], k[8], v[8];
        {
            const f32x4 w0a = PWV(24), w0b = PWV(25), w1a = PWV(26), w1b = PWV(27), w2a = PWV(28), w2b = PWV(29), cba = PWV(30), cbb = PWV(31);
#pragma unroll
            for (int i = 0; i < 4; ++i) {
                act[i] = siluf(w0a[i] * xp[i] + w1a[i] * xc[i] + w2a[i] * xn[i] + cba[i]);
                act[4 + i] = siluf(w0b[i] * xp[4 + i] + w1b[i] * xc[4 + i] + w2b[i] * xn[4 + i] + cbb[i]);
            }
        }
#pragma unroll
        for (int b = 0; b < 2; ++b) {
#pragma unroll
            for (int o = 0; o < 4; ++o) { q[4 * b + o] = 0.f; k[4 * b + o] = 0.f; v[4 * b + o] = 0.f; }
#pragma unroll
            for (int i = 0; i < 4; ++i) {
                const f32x4 wq4 = PWV(b * 4 + i), wk4 = PWV(8 + b * 4 + i), wv4 = PWV(16 + b * 4 + i);
#pragma unroll
                for (int o = 0; o < 4; ++o) { q[4 * b + o] += act[4 * b + i] * wq4[o]; k[4 * b + o] += act[4 * b + i] * wk4[o]; v[4 * b + o] += xc[4 * b + i] * wv4[o]; }
            }
        }
        float sg[16];
#pragma unroll
        for (int u = 0; u < 16; ++u) sg[u] = 0.f;
#pragma unroll
        for (int part = 0; part < 3; ++part)
#pragma unroll
            for (int i = 0; i < 8; ++i) {
                const float xv = part == 0 ? q[i] : (part == 1 ? k[i] : v[i]);
                const LAS float* wp = WL + ((part * 8 + i) * 64 + c.lane) * 20;
#pragma unroll
                for (int u4 = 0; u4 < 4; ++u4) { const f32x4 w4 = *(const LAS f32x4*)(wp + 4 * u4);
#pragma unroll
                    for (int e = 0; e < 4; ++e) sg[4 * u4 + e] += xv * w4[e]; }
            }
        float t8[8], t4[4], t2[2];
        { const bool hi = (c.lane & 32) != 0;
#pragma unroll
          for (int u = 0; u < 8; ++u) { const float send = hi ? sg[u] : sg[u + 8], keep = hi ? sg[u + 8] : sg[u]; t8[u] = keep + __shfl_xor(send, 32); } }
        { const bool hi = (c.lane & 16) != 0;
#pragma unroll
          for (int u = 0; u < 4; ++u) { const float send = hi ? t8[u] : t8[u + 4], keep = hi ? t8[u + 4] : t8[u]; t4[u] = keep + __shfl_xor(send, 16); } }
        { const bool hi = (c.lane & 8) != 0;
#pragma unroll
          for (int u = 0; u < 2; ++u) { const float send = hi ? t4[u] : t4[u + 2], keep = hi ? t4[u + 2] : t4[u]; t2[u] = keep + __shfl_xor(send, 8); } }
        float gsum;
        { const bool hi = (c.lane & 4) != 0; const float send = hi ? t2[0] : t2[1], keep = hi ? t2[1] : t2[0]; gsum = keep + __shfl_xor(send, 4); }
        gsum += __shfl_xor(gsum, 2); gsum += __shfl_xor(gsum, 1);
        if ((c.lane & 3) == 0) {
            const int gi = (c.lane >> 2) & 15, d = gi >> 3, j = gi & 7;
            const float val = gsum + (d ? bif_b : bif_f)[j];
            if (j < 4) IG[(size_t)(d * 4 + j) * NT + r] = val; else LF[(size_t)(d * 4 + (j - 4)) * NT + r] = logsigf(val);
        }
        const float qs = 0.08838834764831845f;
        v4u w;
        w.x = pk2(q[0] * qs, q[1] * qs); w.y = pk2(q[2] * qs, q[3] * qs); w.z = pk2(q[4] * qs, q[5] * qs); w.w = pk2(q[6] * qs, q[7] * qs); *(v4u*)(Q + (size_t)r * DM + ch0) = w;
        w.x = pk2(k[0], k[1]); w.y = pk2(k[2], k[3]); w.z = pk2(k[4], k[5]); w.w = pk2(k[6], k[7]); *(v4u*)(Kb + (size_t)r * DM + ch0) = w;
        w.x = pk2(v[0], v[1]); w.y = pk2(v[2], v[3]); w.z = pk2(v[4], v[5]); w.w = pk2(v[6], v[7]); *(v4u*)(Vb + (size_t)r * DM + ch0) = w;
        w.x = pk2(act[0], act[1]); w.y = pk2(act[2], act[3]); w.z = pk2(act[4], act[5]); w.w = pk2(act[6], act[7]); *(v4u*)(ACT + (size_t)r * DM + ch0) = w;
    }
#undef PWV
    __syncthreads();
}

__device__ __forceinline__ void p5_scan(const Ctx& c) {
    const float* LT = (const float*)(c.ws + WS_L); const float* NL = (const float*)(c.ws + WS_NL);
    const float* AMAX = (const float*)(c.ws + WS_AMAX); const float* BTOT = (const float*)(c.ws + WS_BTOT);
    bf16* C0 = (bf16*)(c.ws + WS_C0); float* N0 = (float*)(c.ws + WS_N0); float* M0 = (float*)(c.ws + WS_M0);
    constexpr int PER = 16384 + 128, JB = 13;
    for (int e = c.gtid; e < 8 * PER; e += c.NTHR) {
        const int dh = e / PER, rem = e % PER; const bool isC = rem < 16384; const int idx = isC ? rem : rem - 16384;
        const float* src = isC ? LT + (size_t)dh * NCH * 16384 + idx : NL + (size_t)dh * NCH * 128 + idx; const size_t sstep = isC ? 16384 : 128;
        float m = 0.f, val = 0.f;
#pragma unroll 1
        for (int jb = 0; jb < NCH; jb += JB) {
            float lv[JB], bt[JB], am[JB];
#pragma unroll
            for (int u = 0; u < JB; ++u) { lv[u] = src[(size_t)(jb + u) * sstep]; bt[u] = BTOT[dh * NCH + jb + u]; am[u] = AMAX[dh * NCH + jb + u]; }
#pragma unroll
            for (int u = 0; u < JB; ++u) {
                const int j = jb + u;
                if (j >= NCC) {
                    if (isC) C0[((size_t)(dh * NCL + (j - NCC))) * 16384 + idx] = (bf16)f2bf(val);
                    else N0[(size_t)(dh * NCL + (j - NCC)) * 128 + idx] = val;
                    if (rem == 0) M0[dh * NCL + (j - NCC)] = m;
                }
                const float mn = fmaxf(bt[u] + m, am[u]), dec = __expf(bt[u] + m - mn), sc = __expf(am[u] - mn);
                val = dec * val + sc * lv[u]; m = mn;
            }
        }
    }
}

namespace pg8 {
#define PG8_LAS __attribute__((address_space(3)))
typedef unsigned short bf16_t;
typedef short bf16x8 __attribute__((ext_vector_type(8)));
typedef float f32x4 __attribute__((ext_vector_type(4)));
typedef unsigned u32x4 __attribute__((ext_vector_type(4)));
constexpr int BM = 256, BK = 64, HALF = 128, HTB = HALF * BK * 2  , STAGE_BYTES = 8 * HTB, NXCD = 8, WGM = 8;

__host__ __device__ __forceinline__ int lds_byte(int r, int c) { const int st = (r >> 4) * 2 + (c >> 5), rr = r & 15, cc = c & 31, ob = rr * 64 + cc * 2; return st * 1024 + (ob ^ (((ob >> 9) & 1) << 5)); }
__host__ __device__ __forceinline__ void stage_rc(int b, int& R, int& C) { const int st = b / 1024, sb = b % 1024, swz = sb ^ (((sb >> 9) & 1) << 5); R = (st >> 1) * 16 + swz / 64; C = (st & 1) * 32 + (swz % 64) / 2; }
__host__ __device__ __forceinline__ int perm32(int rho) { const int n = rho >> 4, i = rho & 15; return 8 * (i >> 2) + 4 * n + (i & 3); }

struct Unit { int pm, pn; };
struct Gemm { const bf16_t* A; const bf16_t* Bt; int M, N, K; };

struct StaticOrder {
    int nM, nN, nwg, G, c;
    __host__ __device__ void init(int M, int N, int G_, int c_) { nM = M / BM; nN = N / BM; nwg = nM * nN; G = G_; c = c_; }
    __host__ __device__ bool next(int i, Unit& u) const {
        const long L = (long)i * G + c; if (L >= nwg) return false;
        int wgid = (int)L; { const int q = nwg / NXCD, r = nwg % NXCD, xcd = wgid % NXCD, off = wgid / NXCD; wgid = (xcd < r ? xcd * (q + 1) : r * (q + 1) + (xcd - r) * q) + off; }
        const int nig = WGM * nN, gid = wgid / nig, fm = gid * WGM, gsz = (nM - fm) < WGM ? (nM - fm) : WGM;
        u.pm = fm + ((wgid % nig) % gsz); u.pn = (wgid % nig) / gsz; return true;
    }
    __device__ __forceinline__ void a_ready(const Unit&) const {}
    __device__ __forceinline__ void done(const Unit&) const {}
};
__device__ __forceinline__ unsigned cvt_pk_bf16(float lo, float hi) { unsigned r; asm volatile("v_cvt_pk_bf16_f32 %0, %1, %2" : "=v"(r) : "v"(lo), "v"(hi)); return r; }
template <class Epi, class Sched, bool ALIGN_EPI = false, bool SP2 = false>
__device__ __forceinline__ void gemm_phase(PG8_LAS unsigned char* lds, const Gemm g, const Sched& S, const Epi& E) {
    int tid_ = threadIdx.x; asm volatile("" : "+v"(tid_));
    const int tid = tid_, wid = __builtin_amdgcn_readfirstlane(tid >> 6), lane = tid & 63, wr = wid >> 2, wc = wid & 3, fr = lane & 15, fq = lane >> 4;
    const int K = g.K, nt = K / BK;
    unsigned voffA[2], voffB[2];
#pragma unroll
    for (int i = 0; i < 2; ++i) { int R, C; stage_rc(tid * 16 + i * 8192, R, C); const int Rb = Epi::PERM ? ((R & ~31) + perm32(R & 31)) : R;
        voffA[i] = (unsigned)(R * K + C) * 2u; voffB[i] = (unsigned)(Rb * K + C) * 2u; }
    const size_t kstep = (size_t)(BK * 2);
    const size_t hstep = (size_t)HALF * K * 2;
    const size_t tstep = 2 * hstep;
    const unsigned ldsw = (unsigned)wid * 1024u;
    const int aoff = lds_byte(wr * 64 + fr, fq * 8), boff = lds_byte(wc * 32 + fr, fq * 8);
#define PG8_SA(b, h) (((b) * 2 + (h)) * HTB)
#define PG8_SB(b, h) ((4 + (b) * 2 + (h)) * HTB)
#define PG8_STAGE(bufoff, gbase, voff) do { _Pragma("unroll") for (int _i = 0; _i < 2; ++_i) \
        __builtin_amdgcn_global_load_lds((const unsigned*)((const char*)(gbase) + (voff)[_i]), (PG8_LAS unsigned*)(lds + (bufoff) + ldsw + _i * 8192), 16, 0, 0); } while (0)
#define PG8_LDA(dst, b, h) do { _Pragma("unroll") for (int m = 0; m < 4; ++m) _Pragma("unroll") for (int k = 0; k < 2; ++k) dst[m][k] = *(const PG8_LAS bf16x8*)(lds + PG8_SA(b, h) + aoff + m * 2048 + k * 1024); } while (0)
#define PG8_LDB(dst, b, h) do { _Pragma("unroll") for (int n = 0; n < 2; ++n) _Pragma("unroll") for (int k = 0; k < 2; ++k) dst[n][k] = *(const PG8_LAS bf16x8*)(lds + PG8_SB(b, h) + boff + n * 2048 + k * 1024); } while (0)
#define PG8_MMA(ai, bj, At, Bt) do { __builtin_amdgcn_s_setprio(1); _Pragma("unroll") for (int m = 0; m < 4; ++m) _Pragma("unroll") for (int n = 0; n < 2; ++n) _Pragma("unroll") for (int k = 0; k < 2; ++k) \
        acc[ai][bj][m][n] = __builtin_amdgcn_mfma_f32_16x16x32_bf16(Bt[n][k], At[m][k], acc[ai][bj][m][n], 0, 0, 0); __builtin_amdgcn_s_setprio(0); } while (0)
#define PG8_WAIT_V(n) asm volatile("s_waitcnt vmcnt(" #n ")" ::: "memory")
#define PG8_WAIT_L(n) asm volatile("s_waitcnt lgkmcnt(" #n ")" ::: "memory")
#define PG8_BAR __builtin_amdgcn_s_barrier()
#define PG8_SCHED __builtin_amdgcn_sched_barrier(0)
    Unit cur, nxt; int ui = 0;
    if (!S.next(0, cur)) return;
    f32x4 acc[2][2][4][2];
#pragma unroll
    for (int a = 0; a < 2; ++a)
#pragma unroll
        for (int b = 0; b < 2; ++b)
#pragma unroll
            for (int m = 0; m < 4; ++m)
#pragma unroll
                for (int n = 0; n < 2; ++n) acc[a][b][m][n] = (f32x4){0.f, 0.f, 0.f, 0.f};
    bf16x8 At[4][2], B0[2][2], B1[2][2];
    const char* cA = (const char*)g.A + (size_t)cur.pm * tstep; const char* cB = (const char*)g.Bt + (size_t)cur.pn * tstep;
    S.a_ready(cur);
    if constexpr (SP2) {
        PG8_STAGE(PG8_SB(0, 0), cB, voffB); PG8_STAGE(PG8_SB(0, 1), cB + hstep, voffB); PG8_STAGE(PG8_SA(0, 0), cA, voffA); PG8_STAGE(PG8_SA(0, 1), cA + hstep, voffA);
        if (wr == 1) PG8_BAR;
        PG8_WAIT_V(2); PG8_BAR;
        PG8_STAGE(PG8_SB(1, 0), cB + kstep, voffB); PG8_STAGE(PG8_SA(1, 0), cA + kstep, voffA); PG8_STAGE(PG8_SB(1, 1), cB + hstep + kstep, voffB);
        PG8_WAIT_V(6); PG8_BAR;
    } else {
        PG8_STAGE(PG8_SB(0, 0), cB, voffB); PG8_STAGE(PG8_SA(0, 0), cA, voffA); PG8_STAGE(PG8_SB(0, 1), cB + hstep, voffB); PG8_STAGE(PG8_SA(0, 1), cA + hstep, voffA);
        if (wr == 1) PG8_BAR;
        PG8_WAIT_V(4); PG8_BAR;
        PG8_STAGE(PG8_SB(1, 0), cB + kstep, voffB); PG8_STAGE(PG8_SA(1, 0), cA + kstep, voffA); PG8_STAGE(PG8_SB(1, 1), cB + hstep + kstep, voffB);
        PG8_WAIT_V(6); PG8_BAR;
    }
    for (;;) {
        const bool has_next = S.next(ui + 1, nxt);
        const char* nA = has_next ? (const char*)g.A + (size_t)nxt.pm * tstep : cA; const char* nB = has_next ? (const char*)g.Bt + (size_t)nxt.pn * tstep : cB;
        for (int t = 0; t < nt; t += 2) {
            const bool last = (t == nt - 2);
            const char* a1 = cA + (size_t)(t + 1) * kstep;
            const char* a2 = last ? nA : cA + (size_t)(t + 2) * kstep; const char* b2 = last ? nB : cB + (size_t)(t + 2) * kstep;
            const char* a3 = a2 + kstep; const char* b3 = b2 + kstep;
            if (last && has_next) S.a_ready(nxt);
            if constexpr (SP2) {
            PG8_LDB(B0, 0, 0); PG8_LDB(B1, 0, 1); PG8_SCHED; PG8_LDA(At, 0, 0); PG8_STAGE(PG8_SA(1, 1), a1 + hstep, voffA);
            PG8_WAIT_V(8); PG8_WAIT_L(0); PG8_BAR; PG8_MMA(0, 0, At, B0); PG8_MMA(0, 1, At, B1); PG8_BAR; PG8_SCHED;
            PG8_LDA(At, 0, 1); PG8_STAGE(PG8_SB(0, 0), b2, voffB); PG8_STAGE(PG8_SB(0, 1), b2 + hstep, voffB); PG8_STAGE(PG8_SA(0, 0), a2, voffA);
            PG8_WAIT_V(8); PG8_WAIT_L(0); PG8_BAR; PG8_MMA(1, 0, At, B0); PG8_MMA(1, 1, At, B1); PG8_BAR; PG8_SCHED;
            PG8_LDB(B0, 1, 0); PG8_LDB(B1, 1, 1); PG8_SCHED; PG8_LDA(At, 1, 0); PG8_STAGE(PG8_SA(0, 1), a2 + hstep, voffA);
            PG8_WAIT_V(8); PG8_WAIT_L(0); PG8_BAR; PG8_MMA(0, 0, At, B0); PG8_MMA(0, 1, At, B1); PG8_BAR; PG8_SCHED;
            PG8_LDA(At, 1, 1); PG8_STAGE(PG8_SB(1, 0), b3, voffB); PG8_STAGE(PG8_SB(1, 1), b3 + hstep, voffB); PG8_STAGE(PG8_SA(1, 0), a3, voffA);
            PG8_WAIT_V(8); PG8_WAIT_L(0); PG8_BAR; PG8_MMA(1, 0, At, B0); PG8_MMA(1, 1, At, B1); PG8_BAR; PG8_SCHED;
            } else {
            PG8_LDB(B0, 0, 0); PG8_SCHED; PG8_LDA(At, 0, 0); PG8_STAGE(PG8_SA(1, 1), a1 + hstep, voffA);
            PG8_WAIT_L(8); PG8_BAR; PG8_WAIT_L(0); PG8_MMA(0, 0, At, B0); PG8_BAR; PG8_SCHED;
            PG8_LDB(B1, 0, 1); PG8_STAGE(PG8_SB(0, 0), b2, voffB);
            PG8_BAR; PG8_WAIT_L(0); PG8_MMA(0, 1, At, B1); PG8_BAR;
            PG8_LDA(At, 0, 1); PG8_STAGE(PG8_SA(0, 0), a2, voffA);
            PG8_BAR; PG8_WAIT_L(0); PG8_MMA(1, 0, At, B0); PG8_BAR; PG8_SCHED;
            PG8_STAGE(PG8_SB(0, 1), b2 + hstep, voffB);
            PG8_WAIT_V(6); PG8_BAR; PG8_MMA(1, 1, At, B1); PG8_BAR;
            PG8_LDB(B0, 1, 0); PG8_SCHED; PG8_LDA(At, 1, 0); PG8_STAGE(PG8_SA(0, 1), a2 + hstep, voffA);
            PG8_WAIT_L(8); PG8_BAR; PG8_WAIT_L(0); PG8_MMA(0, 0, At, B0); PG8_BAR; PG8_SCHED;
            PG8_LDB(B1, 1, 1); PG8_STAGE(PG8_SB(1, 0), b3, voffB);
            PG8_BAR; PG8_WAIT_L(0); PG8_MMA(0, 1, At, B1); PG8_BAR;
            PG8_LDA(At, 1, 1); PG8_STAGE(PG8_SA(1, 0), a3, voffA);
            PG8_BAR; PG8_WAIT_L(0); PG8_MMA(1, 0, At, B0); PG8_BAR; PG8_SCHED;
            PG8_STAGE(PG8_SB(1, 1), b3 + hstep, voffB);
            PG8_WAIT_V(6); PG8_BAR; PG8_MMA(1, 1, At, B1); PG8_BAR;
            }
        }
        if constexpr (ALIGN_EPI) { if (wr == 0) PG8_BAR; }
        if constexpr (!Epi::AFTER_DRAIN) { E(acc, cur, wr, wc, fr, fq); S.done(cur); }
        if (!has_next) break;
#pragma unroll
        for (int a = 0; a < 2; ++a)
#pragma unroll
            for (int b = 0; b < 2; ++b)
#pragma unroll
                for (int m = 0; m < 4; ++m)
#pragma unroll
                    for (int n = 0; n < 2; ++n) acc[a][b][m][n] = (f32x4){0.f, 0.f, 0.f, 0.f};
        cur = nxt; cA = nA; cB = nB; ++ui;
        if constexpr (ALIGN_EPI) { if (wr == 1) PG8_BAR; }
    }
    PG8_WAIT_V(0);
    if constexpr (!ALIGN_EPI) { if (wr == 0) PG8_BAR; }
    PG8_BAR;
    if constexpr (Epi::AFTER_DRAIN) { E.fused(acc, cur, wr, wc, fr, fq, lds, wid, lane); S.done(cur); }
#undef PG8_SA
#undef PG8_SB
#undef PG8_STAGE
#undef PG8_LDA
#undef PG8_LDB
#undef PG8_MMA
#undef PG8_WAIT_V
#undef PG8_WAIT_L
#undef PG8_BAR
#undef PG8_SCHED
}
}

#define PG8_SP2 true
#define PG8_ALIGN true
template <class RowMap>
__device__ __forceinline__ void transpose_item(const float* W, int K, int N, bf16* WT, const RowMap& rm, LAS float* scr, int item, int lane) {
    const int nblk = N / 32, kb = item / nblk, nb = item % nblk, k0 = 64 * kb, n0 = 32 * nb;
#pragma unroll 16
    for (int i = 0; i < 32; ++i) { const int kk = 2 * i + (lane >> 5); scr[kk * 33 + (lane & 31)] = W[(size_t)(k0 + kk) * N + n0 + (lane & 31)]; }
    asm volatile("s_waitcnt lgkmcnt(0)" ::: "memory");
    const int c = lane & 7;
#pragma unroll
    for (int j = 0; j < 4; ++j) { const int n = (lane >> 3) + 8 * j; const LAS float* sp = scr + (8 * c) * 33 + n;
        v4u o; o.x = pk2(sp[0 * 33], sp[1 * 33]); o.y = pk2(sp[2 * 33], sp[3 * 33]); o.z = pk2(sp[4 * 33], sp[5 * 33]); o.w = pk2(sp[6 * 33], sp[7 * 33]);
        *(v4u*)(WT + (size_t)rm(n0 + n) * K + k0 + 8 * c) = o; }
    asm volatile("s_waitcnt lgkmcnt(0)" ::: "memory");
}
struct RowId { __device__ __forceinline__ int operator()(int n) const { return n; } };
struct RowGU { int off; __device__ __forceinline__ int operator()(int n) const { return 256 * (n >> 7) + (n & 127) + off; } };
__device__ __forceinline__ void conv_small_weights(const Ctx& c) {
    LAS float* scr = (LAS float*)c.lds + c.wave * 4096;
    constexpr int I_IN = (D / 64) * (DIN / 32), I_OUT = (D / 64) * (D / 32);
    for (int it = c.gw; it < I_IN + I_OUT; it += c.NGW) {
        if (it < I_IN) transpose_item(inp(c, 10), D, DIN, (bf16*)(c.ws + WS_WIN_T), RowId{}, scr, it, c.lane);
        else transpose_item(inp(c, 23), D, D, (bf16*)(c.ws + WS_WOUT_T), RowId{}, scr, it - I_IN, c.lane);
    }
}
__device__ __forceinline__ void conv_moe_weights(const Ctx& c) {
    LAS float* scr = (LAS float*)c.lds + c.wave * 4096;
    constexpr int I_G = (D / 64) * (DE / 32), I_D = (DE / 64) * (D / 32), PER_E = 2 * I_G + I_D;
    for (int it = c.gw; it < NE * PER_E; it += c.NGW) {
        const int e = it / PER_E; int r = it % PER_E;
        bf16* gu = (bf16*)(c.ws + WS_WGU_T) + (size_t)e * 1024 * 1024; bf16* dn = (bf16*)(c.ws + WS_WD_T) + (size_t)e * 1024 * 512;
        if (r < I_G) { transpose_item(inp(c, 28) + (size_t)e * D * DE, D, DE, gu, RowGU{0}, scr, r, c.lane); continue; } r -= I_G;
        if (r < I_G) { transpose_item(inp(c, 29) + (size_t)e * D * DE, D, DE, gu, RowGU{128}, scr, r, c.lane); continue; } r -= I_G;
        transpose_item(inp(c, 30) + (size_t)e * DE * D, DE, D, dn, RowId{}, scr, r, c.lane);
    }
}
__device__ __forceinline__ v4u pack8(const f32x4 a, const f32x4 b) { v4u w; w.x = pg8::cvt_pk_bf16(a[0], a[1]); w.y = pg8::cvt_pk_bf16(a[2], a[3]); w.z = pg8::cvt_pk_bf16(b[0], b[1]); w.w = pg8::cvt_pk_bf16(b[2], b[3]); return w; }
struct EpiProj {
    static constexpr bool PERM = true, AFTER_DRAIN = false;
    unsigned char* ws;
    __device__ __forceinline__ void operator()(const f32x4 (&acc)[2][2][4][2], const pg8::Unit& un, int wr, int wc, int fr, int fq) const {
        const int colt = un.pn * 256, reg = colt >> 9;
        const size_t off = WS_XM + (size_t)(reg & 1) * (WS_Z - WS_XM) + (size_t)(reg >> 1) * (WS_U - WS_XM);
        bf16* base = (bf16*)(ws + off);
        const int lc0 = (colt & 511) + wc * 32 + 8 * fq, row0 = un.pm * 256 + wr * 64 + fr;
#pragma unroll
        for (int ai = 0; ai < 2; ++ai)
#pragma unroll
            for (int m = 0; m < 4; ++m) { bf16* rowp = base + (size_t)(row0 + ai * 128 + m * 16) * DM + lc0;
#pragma unroll
                for (int bj = 0; bj < 2; ++bj) *(v4u*)(rowp + bj * 128) = pack8(acc[ai][bj][m][0], acc[ai][bj][m][1]); }
    }
};
struct EpiY {
    static constexpr bool PERM = false, AFTER_DRAIN = false;
    float* Y;
    __device__ __forceinline__ void operator()(const f32x4 (&acc)[2][2][4][2], const pg8::Unit& un, int wr, int wc, int fr, int fq) const {
        const int row0 = un.pm * 256 + wr * 64 + fr, col0 = un.pn * 256 + wc * 32 + 4 * fq;
#pragma unroll
        for (int ai = 0; ai < 2; ++ai)
#pragma unroll
            for (int m = 0; m < 4; ++m) { float* rowp = Y + (size_t)(row0 + ai * 128 + m * 16) * D + col0;
#pragma unroll
                for (int bj = 0; bj < 2; ++bj)
#pragma unroll
                    for (int n = 0; n < 2; ++n) *(f32x4*)(rowp + bj * 128 + n * 16) = acc[ai][bj][m][n]; }
    }
};
struct EpiSwiGLU {
    static constexpr bool PERM = true, AFTER_DRAIN = false;
    bf16* act; const float* roww;
    __device__ __forceinline__ void operator()(const f32x4 (&acc)[2][2][4][2], const pg8::Unit& un, int wr, int wc, int fr, int fq) const {
        const int row0 = un.pm * 256 + wr * 64 + fr, col0 = (un.pn & 3) * 128 + wc * 32 + 8 * fq;
#pragma unroll
        for (int ai = 0; ai < 2; ++ai)
#pragma unroll
            for (int m = 0; m < 4; ++m) { const int row = row0 + ai * 128 + m * 16; const float w = roww[row];
                f32x4 o[2];
#pragma unroll
                for (int n = 0; n < 2; ++n)
#pragma unroll
                    for (int i = 0; i < 4; ++i) { const float g = acc[ai][0][m][n][i], uu = acc[ai][1][m][n][i]; o[n][i] = siluf(g) * uu * w; }
                *(v4u*)(act + (size_t)row * DE + col0) = pack8(o[0], o[1]); }
    }
};
struct EpiDown {
    static constexpr bool PERM = true, AFTER_DRAIN = false;
    bf16* yrow;
    __device__ __forceinline__ void operator()(const f32x4 (&acc)[2][2][4][2], const pg8::Unit& un, int wr, int wc, int fr, int fq) const {
        const int row0 = un.pm * 256 + wr * 64 + fr, col0 = (un.pn & 3) * 256 + wc * 32 + 8 * fq;
#pragma unroll
        for (int ai = 0; ai < 2; ++ai)
#pragma unroll
            for (int m = 0; m < 4; ++m) { bf16* rowp = yrow + (size_t)(row0 + ai * 128 + m * 16) * D + col0;
#pragma unroll
                for (int bj = 0; bj < 2; ++bj) *(v4u*)(rowp + bj * 128) = pack8(acc[ai][bj][m][0], acc[ai][bj][m][1]); }
    }
};
struct MoeOrder {
    int G, c; const volatile LAS int* ts;
    __device__ __forceinline__ bool next(int i, pg8::Unit& u) const {
        const int L = i * G + c; if (L >= ts[16] * 4) return false;
        const int mt = L >> 2; int e = 0;
#pragma unroll
        for (int j = 1; j < 16; ++j) e += (mt >= ts[j]) ? 1 : 0;
        u.pm = mt; u.pn = e * 4 + (L & 3); return true;
    }
    __device__ __forceinline__ void a_ready(const pg8::Unit&) const {}
    __device__ __forceinline__ void done(const pg8::Unit&) const {}
};
__device__ __forceinline__ int vcu_of(const Ctx& c) { return (c.G % 8 == 0) ? (c.bid % 8) * (c.G / 8) + c.bid / 8 : c.bid; }
__device__ __forceinline__ void moe_tile_table(const Ctx& c, volatile LAS int* ts) {
    if (c.tid == 0) {
        const unsigned* cnt = (const unsigned*)(c.ws + WS_CTL) + CW_CNT; int acc = 0;
        for (int e = 0; e < 16; ++e) { ts[e] = acc; acc += (int)((__hip_atomic_load(cnt + e, __ATOMIC_RELAXED, __HIP_MEMORY_SCOPE_AGENT) + 255u) >> 8); }
        ts[16] = acc;
    }
    __syncthreads();
}

__device__ __forceinline__ void g1_gemm1(const Ctx& c) {
    pg8::Gemm g{(const bf16*)(c.ws + WS_H), (const bf16*)(c.ws + WS_WIN_T), NT, DIN, D};
    pg8::StaticOrder S; S.init(NT, DIN, c.G, c.bid);
    EpiProj E{c.ws};
    pg8::gemm_phase<EpiProj, pg8::StaticOrder, PG8_ALIGN, PG8_SP2>((LAS unsigned char*)c.lds, g, S, E);
}
__device__ __forceinline__ void g2_outproj(const Ctx& c) {
    pg8::Gemm g{(const bf16*)(c.ws + WS_H), (const bf16*)(c.ws + WS_WOUT_T), T, D, D};
    pg8::StaticOrder S; S.init(T, D, c.G, c.bid);
    EpiY E{(float*)(c.ws + WS_Y)};
    pg8::gemm_phase<EpiY, pg8::StaticOrder, PG8_ALIGN, PG8_SP2>((LAS unsigned char*)c.lds, g, S, E);
}
__device__ __forceinline__ void g3_moe_up(const Ctx& c, volatile LAS int* ts) {
    moe_tile_table(c, ts);
    pg8::Gemm g{(const bf16*)(c.ws + WS_ASORT), (const bf16*)(c.ws + WS_WGU_T), 0, 0, D};
    MoeOrder S{c.G, vcu_of(c), ts};
    EpiSwiGLU E{(bf16*)(c.ws + WS_ACTS), (const float*)(c.ws + WS_ROWW)};
    pg8::gemm_phase<EpiSwiGLU, MoeOrder, PG8_ALIGN, PG8_SP2>((LAS unsigned char*)c.lds, g, S, E);
}
__device__ __forceinline__ void g4_moe_down(const Ctx& c, volatile LAS int* ts) {
    moe_tile_table(c, ts);
    pg8::Gemm g{(const bf16*)(c.ws + WS_ACTS), (const bf16*)(c.ws + WS_WD_T), 0, 0, DE};
    MoeOrder S{c.G, vcu_of(c), ts};
    EpiDown E{(bf16*)(c.ws + WS_YROW)};
    pg8::gemm_phase<EpiDown, MoeOrder, PG8_ALIGN, PG8_SP2>((LAS unsigned char*)c.lds, g, S, E);
}

__device__ __forceinline__ void p10b_token(const Ctx& c) {
    const float* x = inp(c, 0); const float* g_post = inp(c, 7); const float* g_ffn = inp(c, 8);
    const float* wrg = inp(c, 24); const float* brg = inp(c, 25); const float* wre = inp(c, 26); const float* bre = inp(c, 27);
    const float* mod = (const float*)(c.ws + WS_MOD);
    const float* posR = (const float*)(c.ws + WS_POSR); const float* posC = (const float*)(c.ws + WS_POSC);
    const float* Y = (const float*)(c.ws + WS_Y); bf16* H2 = (bf16*)(c.ws + WS_H); int* RE = (int*)(c.ws + WS_RE); float* RW = (float*)(c.ws + WS_RW); int* RS = (int*)(c.ws + WS_RS);
    unsigned* CNT = (unsigned*)(c.ws + WS_CTL) + CW_CNT;
    constexpr int WRS = 1028;
    LAS float* WRt = (LAS float*)c.lds;
    int* hist = (int*)(c.lds + 20 * WRS); int* gbase = hist + 16; int* tinfo = hist + 32;
    for (int idx = c.tid; idx < 1024 * 20; idx += NTHREADS) {
        const int col = idx / 20, o = idx % 20;
        WRt[o * WRS + col] = o < 4 ? wrg[col * 4 + o] : wre[col * 16 + (o - 4)];
    }
    if (c.tid < 32) hist[c.tid] = 0;
    __syncthreads();
    int li = 0;
    for (int r = c.gw; r < T; r += c.NGW, ++li) {
        asm volatile("" ::: "memory");
        f32x4 xv[4], yv[4]; float ss = 0.f;
#pragma unroll
        for (int j = 0; j < 4; ++j) {
            const int col = 256 * j + 4 * c.lane;
            const float* pp = col < 512 ? posR + (r >> 6) * 512 + col : posC + (r & 63) * 512 + (col - 512);
            xv[j] = *(const f32x4*)(x + (size_t)r * D + col) + *(const f32x4*)pp;
            yv[j] = *(const f32x4*)(Y + (size_t)r * D + col);
            ss += yv[j].x * yv[j].x + yv[j].y * yv[j].y + yv[j].z * yv[j].z + yv[j].w * yv[j].w;
        }
        const float rinv = rsqrtf(wave_sum(ss) * (1.f / D) + EPS);
        float s2 = 0.f;
#pragma unroll
        for (int j = 0; j < 4; ++j) {
            const int col = 256 * j + 4 * c.lane;
            const f32x4 gg = *(const f32x4*)(g_post + col), g1 = *(const f32x4*)(mod + 2048 + col);
            xv[j] = xv[j] + g1 * (yv[j] * rinv * gg);
            *(f32x4*)(c.out + (size_t)r * D + col) = xv[j];
            s2 += xv[j].x * xv[j].x + xv[j].y * xv[j].y + xv[j].z * xv[j].z + xv[j].w * xv[j].w;
        }
        const float rinv2 = rsqrtf(wave_sum(s2) * (1.f / D) + EPS);
        float lg[20];
#pragma unroll
        for (int i = 0; i < 20; ++i) lg[i] = 0.f;
#pragma unroll
        for (int j = 0; j < 4; ++j) {
            const int col = 256 * j + 4 * c.lane;
            const f32x4 gg = *(const f32x4*)(g_ffn + col), sh = *(const f32x4*)(mod + 3072 + col), sc = *(const f32x4*)(mod + 4096 + col);
            const f32x4 hv = xv[j] * rinv2 * gg * (sc + 1.f) + sh;
            uint2 w; w.x = pk2(hv.x, hv.y); w.y = pk2(hv.z, hv.w);
            *(uint2*)(H2 + (size_t)r * D + col) = w;
#pragma unroll
            for (int o = 0; o < 20; ++o) { const f32x4 w4 = *(const LAS f32x4*)(WRt + o * WRS + col); lg[o] += hv.x * w4.x + hv.y * w4.y + hv.z * w4.z + hv.w * w4.w; }
        }
#pragma unroll
        for (int i = 0; i < 20; ++i) lg[i] = wave_sum(lg[i]);
        if (c.lane == 0) {
            float gl[4];
#pragma unroll
            for (int i = 0; i < 4; ++i) gl[i] = lg[i] + brg[i];
            int gs = 0; float gm = gl[0];
#pragma unroll
            for (int i = 1; i < 4; ++i) if (gl[i] > gm) { gm = gl[i]; gs = i; }
            float den = 0.f;
#pragma unroll
            for (int i = 0; i < 4; ++i) den += __expf(gl[i] - gm);
            const float psel = 1.f / den;
            float el[4];
#pragma unroll
            for (int i = 0; i < 4; ++i) {
                float v = 0.f;
#pragma unroll
                for (int g2 = 0; g2 < 4; ++g2) v = (g2 == gs) ? lg[4 + g2 * 4 + i] + bre[g2 * 4 + i] : v;
                el[i] = v;
            }
            int i1 = 0; float em1 = el[0];
#pragma unroll
            for (int i = 1; i < 4; ++i) if (el[i] > em1) { em1 = el[i]; i1 = i; }
            int i2 = -1; float em2 = -INFINITY;
#pragma unroll
            for (int i = 0; i < 4; ++i) if (i != i1 && el[i] > em2) { em2 = el[i]; i2 = i; }
            const float e2 = __expf(em2 - em1), w1 = psel / (1.f + e2), w2 = psel * e2 / (1.f + e2);
            const int ea = gs * 4 + i1, eb = gs * 4 + i2;
            RE[2 * r] = ea; RE[2 * r + 1] = eb; RW[2 * r] = w1; RW[2 * r + 1] = w2;
            int* ti = tinfo + (c.wave * 8 + li) * 4;
            ti[0] = ea; ti[1] = eb; ti[2] = atomicAdd(hist + ea, 1); ti[3] = atomicAdd(hist + eb, 1);
        }
    }
    __syncthreads();
    if (c.tid < 16) gbase[c.tid] = (int)__hip_atomic_fetch_add(CNT + c.tid, (unsigned)hist[c.tid], __ATOMIC_RELAXED, __HIP_MEMORY_SCOPE_AGENT);
    __syncthreads();
    if (c.lane < li) {
        const int r = c.gw + c.lane * c.NGW; const int* ti = tinfo + (c.wave * 8 + c.lane) * 4;
        RS[2 * r] = gbase[ti[0]] + ti[2]; RS[2 * r + 1] = gbase[ti[1]] + ti[3];
    }
    __syncthreads();
}
__device__ __forceinline__ void p10c_scatter(const Ctx& c) {
    const bf16* H2 = (const bf16*)(c.ws + WS_H); bf16* AS = (bf16*)(c.ws + WS_ASORT);
    const int* RE = (const int*)(c.ws + WS_RE); const float* RW = (const float*)(c.ws + WS_RW); int* RS = (int*)(c.ws + WS_RS); float* ROWW = (float*)(c.ws + WS_ROWW);
    const unsigned* CNT = (const unsigned*)(c.ws + WS_CTL) + CW_CNT;
    for (int r = c.gw; r < T; r += c.NGW) {
        asm volatile("" ::: "memory");
        const int e0 = RE[2 * r], e1 = RE[2 * r + 1]; int b0 = 0, b1 = 0;
        for (int e = 0; e < 16; ++e) { const int tl = (int)((CNT[e] + 255u) >> 8) * 256; b0 += e < e0 ? tl : 0; b1 += e < e1 ? tl : 0; }
        const int r0 = b0 + RS[2 * r], r1 = b1 + RS[2 * r + 1];
        const v4u* src = (const v4u*)(H2 + (size_t)r * D);
        const v4u a = src[c.lane], b = src[c.lane + 64];
        v4u* d0 = (v4u*)(AS + (size_t)r0 * D); v4u* d1 = (v4u*)(AS + (size_t)r1 * D);
        d0[c.lane] = a; d0[c.lane + 64] = b; d1[c.lane] = a; d1[c.lane + 64] = b;
        if (c.lane == 0) { ROWW[r0] = RW[2 * r]; ROWW[r1] = RW[2 * r + 1]; RS[2 * r] = r0; RS[2 * r + 1] = r1; }
    }
}
__device__ __forceinline__ void p12b_final(const Ctx& c) {
    const float* g_post = inp(c, 9); const float* mod = (const float*)(c.ws + WS_MOD); const bf16* YR = (const bf16*)(c.ws + WS_YROW); const int* RS = (const int*)(c.ws + WS_RS);
    for (int r = c.gw; r < T; r += c.NGW) {
        asm volatile("" ::: "memory");
        const int r0 = RS[2 * r], r1 = RS[2 * r + 1];
        f32x4 yv[4]; float ss = 0.f;
#pragma unroll
        for (int j = 0; j < 4; ++j) {
            const int col = 256 * j + 4 * c.lane;
            const uint2 a = *(const uint2*)(YR + (size_t)r0 * D + col), b = *(const uint2*)(YR + (size_t)r1 * D + col);
            yv[j] = (f32x4){lo16(a.x) + lo16(b.x), hi16(a.x) + hi16(b.x), lo16(a.y) + lo16(b.y), hi16(a.y) + hi16(b.y)};
            ss += yv[j].x * yv[j].x + yv[j].y * yv[j].y + yv[j].z * yv[j].z + yv[j].w * yv[j].w;
        }
        const float rinv = rsqrtf(wave_sum(ss) * (1.f / D) + EPS);
#pragma unroll
        for (int j = 0; j < 4; ++j) {
            const int col = 256 * j + 4 * c.lane;
            const f32x4 gg = *(const f32x4*)(g_post + col), g2 = *(const f32x4*)(mod + 5120 + col);
            f32x4* o = (f32x4*)(c.out + (size_t)r * D + col);
            *o = *o + g2 * (yv[j] * rinv * gg);
        }
    }
}


typedef unsigned v2u __attribute__((ext_vector_type(2)));
typedef short s16x4 __attribute__((ext_vector_type(4)));
typedef short h8 __attribute__((ext_vector_type(8)));
constexpr int TSB = 288;
constexpr int TILE_B = 128 * TSB;
#define MFMA16(a, b, c) __builtin_amdgcn_mfma_f32_16x16x32_bf16((a), (b), (c), 0, 0, 0)
__device__ __forceinline__ h8 frag_row(const LAS unsigned char* tile, int stride_b, int row0, int k0, int lane) {
    return *(const LAS h8*)(tile + (row0 + (lane & 15)) * stride_b + (k0 + 8 * (lane >> 4)) * 2);
}
__device__ __forceinline__ h8 frag_tr(const LAS unsigned char* tile, int stride_b, int k0, int n0, int lane) {
    const int g = lane >> 4, q = (lane & 15) >> 2, p = lane & 3;
    const LAS unsigned char* a = tile + (k0 + 8 * g + q) * stride_b + (n0 + 4 * p) * 2;
    const s16x4 lo = __builtin_amdgcn_ds_read_tr16_b64_v4i16((LAS s16x4*)a);
    const s16x4 hi = __builtin_amdgcn_ds_read_tr16_b64_v4i16((LAS s16x4*)(a + 4 * stride_b));
    return __builtin_shufflevector(lo, hi, 0, 1, 2, 3, 4, 5, 6, 7);
}
__device__ __forceinline__ void lds_atomic_add(LAS float* p, float v) { __hip_atomic_fetch_add(p, v, __ATOMIC_RELAXED, __HIP_MEMORY_SCOPE_WORKGROUP); }


__device__ __forceinline__ void p4m_summaries(const Ctx& c) {
    const bf16* Kb = (const bf16*)(c.ws + WS_K); const bf16* Vb = (const bf16*)(c.ws + WS_V);
    const float* IG = (const float*)(c.ws + WS_IG); const float* LF = (const float*)(c.ws + WS_LF);
    float* LT = (float*)(c.ws + WS_L); float* NL = (float*)(c.ws + WS_NL); float* AMAX = (float*)(c.ws + WS_AMAX); float* BTOT = (float*)(c.ws + WS_BTOT);
    LAS unsigned char* L = (LAS unsigned char*)c.lds; LAS unsigned char* Ks = L; LAS unsigned char* Vs = L + TILE_B;
    LAS float* lfs = (LAS float*)(L + 2 * TILE_B); LAS float* as = lfs + 128; LAS float* red = as + 128;
    const int lane = c.lane, rt = c.wave >> 1, cg = c.wave & 1, fr = lane & 15, fg = lane >> 4;
    for (int it = c.bid; it < 2 * NH * NCH; it += c.G) {
        const int d = it / (NH * NCH), h = (it / NCH) % NH, j = it % NCH, r0 = chunk_row0(d, j);
        const float* lf = LF + (size_t)(d * 4 + h) * NT + r0; const float* ig = IG + (size_t)(d * 4 + h) * NT + r0;
        {
            const float lfv = c.tid < 128 ? lf[c.tid] : 0.f, igv = c.tid < 128 ? ig[c.tid] : 0.f;
            const float b = scan128<false>(lfv, d != 0, lfs, c.tid, c.lane, c.wave);
            if (c.tid == (d == 0 ? 127 : 0)) red[0] = b;
            __syncthreads();
            if (c.tid < 128) as[c.tid] = red[0] - b + igv;
        }
        __syncthreads();
        if (c.tid < 64) { float m = fmaxf(as[c.tid], as[c.tid + 64]);
#pragma unroll
            for (int o = 1; o < 64; o <<= 1) m = fmaxf(m, __shfl_xor(m, o));
            if (c.tid == 0) red[1] = m; }
        __syncthreads();
        const float amax = red[1], btot = red[0];
        for (int e = c.tid; e < 128 * 16; e += NTHREADS) {
            const int l = e >> 4, ch = e & 15; const float w = __expf(as[l] - amax);
            float f[8];
            unpack8(*(const v4u*)(Kb + (size_t)(r0 + l) * DM + h * DH + ch * 8), f);
            v4u o; o.x = pk2(f[0] * w, f[1] * w); o.y = pk2(f[2] * w, f[3] * w); o.z = pk2(f[4] * w, f[5] * w); o.w = pk2(f[6] * w, f[7] * w);
            *(LAS v4u*)(Ks + l * TSB + ch * 16) = o;
            *(LAS v4u*)(Vs + l * TSB + ch * 16) = *(const v4u*)(Vb + (size_t)(r0 + l) * DM + h * DH + ch * 8);
        }
        __syncthreads();
        f32x4 acc[2][4];
#pragma unroll
        for (int mt = 0; mt < 2; ++mt)
#pragma unroll
            for (int nt = 0; nt < 4; ++nt) acc[mt][nt] = (f32x4){0.f, 0.f, 0.f, 0.f};
#pragma unroll
        for (int ks = 0; ks < 4; ++ks) {
            h8 a[2], b[4];
#pragma unroll
            for (int mt = 0; mt < 2; ++mt) a[mt] = frag_tr(Vs, TSB, 32 * ks, 32 * rt + 16 * mt, lane);
#pragma unroll
            for (int nt = 0; nt < 4; ++nt) b[nt] = frag_tr(Ks, TSB, 32 * ks, 64 * cg + 16 * nt, lane);
#pragma unroll
            for (int mt = 0; mt < 2; ++mt)
#pragma unroll
                for (int nt = 0; nt < 4; ++nt) acc[mt][nt] = MFMA16(a[mt], b[nt], acc[mt][nt]);
        }
        float* dst = LT + (size_t)((d * 4 + h) * NCH + j) * 16384;
#pragma unroll
        for (int mt = 0; mt < 2; ++mt)
#pragma unroll
            for (int nt = 0; nt < 4; ++nt)
#pragma unroll
                for (int r = 0; r < 4; ++r) dst[(32 * rt + 16 * mt + 4 * fg + r) * 128 + 64 * cg + 16 * nt + fr] = acc[mt][nt][r];
        if (c.tid < 128) {
            float sacc = 0.f;
            for (int l = 0; l < 128; ++l) sacc += bf2f(*(const LAS bf16*)(Ks + l * TSB + c.tid * 2));
            NL[(size_t)((d * 4 + h) * NCH + j) * 128 + c.tid] = sacc;
            if (c.tid == 0) { AMAX[(d * 4 + h) * NCH + j] = amax; BTOT[(d * 4 + h) * NCH + j] = btot; }
        }
        __syncthreads();
    }
}

__device__ __forceinline__ void p8m_mlstm_out(const Ctx& c) {
    const bf16* Q = (const bf16*)(c.ws + WS_Q); const bf16* Kb = (const bf16*)(c.ws + WS_K); const bf16* Vb = (const bf16*)(c.ws + WS_V);
    const bf16* ACT = (const bf16*)(c.ws + WS_ACT); const bf16* Z = (const bf16*)(c.ws + WS_Z);
    const float* IG = (const float*)(c.ws + WS_IG); const float* LF = (const float*)(c.ws + WS_LF);
    const bf16* C0 = (const bf16*)(c.ws + WS_C0); const float* N0 = (const float*)(c.ws + WS_N0); const float* M0 = (const float*)(c.ws + WS_M0);
    const float* norm_w = inp(c, 20); const float* skip = inp(c, 21);
    bf16* A2 = (bf16*)(c.ws + WS_H);
    LAS unsigned char* L = (LAS unsigned char*)c.lds;
    LAS unsigned char* Qs = L; LAS unsigned char* Ks = L + TILE_B; LAS unsigned char* Vs = L + 2 * TILE_B; LAS unsigned char* Ss = L + 3 * TILE_B;
    LAS float* gs = (LAS float*)(L + 4 * TILE_B); LAS float* Ms = gs + 128; LAS float* wis = Ms + 128; LAS float* emt = wis + 128; LAS float* nqs = emt + 128; LAS float* qns = nqs + 128;
    LAS float* rsum = qns + 128; LAS float* rsq = rsum + 128; LAS float* lfs = rsq + 128;
    const int lane = c.lane, rt = c.wave >> 1, cg = c.wave & 1, fr = lane & 15, fg = lane >> 4;
    for (int it = c.bid; it < NH * NCL; it += c.G) {
        const int h = it / NCL, ck = it % NCL, r0 = ck * CH;
        for (int e = c.tid; e < 128 * 16; e += NTHREADS) {
            const int l = e >> 4, ch = e & 15; const size_t go = (size_t)(r0 + l) * DM + h * DH + ch * 8;
            *(LAS v4u*)(Qs + l * TSB + ch * 16) = *(const v4u*)(Q + go);
            *(LAS v4u*)(Ks + l * TSB + ch * 16) = *(const v4u*)(Kb + go);
            *(LAS v4u*)(Vs + l * TSB + ch * 16) = *(const v4u*)(Vb + go);
        }
        if (c.tid < 128) { rsum[c.tid] = 0.f; rsq[c.tid] = 0.f; }
        f32x4 hsum[2][4];
#pragma unroll
        for (int mt = 0; mt < 2; ++mt)
#pragma unroll
            for (int nt = 0; nt < 4; ++nt) hsum[mt][nt] = (f32x4){0.f, 0.f, 0.f, 0.f};
#pragma unroll 1
        for (int d = 0; d < 2; ++d) {
            const int sidx = (d * 4 + h) * NCL + (d == 0 ? ck : NCL - 1 - ck);
            const float m0 = M0[sidx];
            float lfv = 0.f, igv = 0.f;
            if (c.tid < 128) { lfv = LF[(size_t)(d * 4 + h) * NT + r0 + c.tid]; igv = IG[(size_t)(d * 4 + h) * NT + r0 + c.tid]; lfs[c.tid] = N0[(size_t)sidx * 128 + c.tid]; }
            const float bt = scan128<false>(lfv, d != 0, rsq + 128 + 128, c.tid, c.lane, c.wave);
            const float gval = igv - bt;
            const float cm = scan128<true>(c.tid < 128 ? gval : -INFINITY, d != 0, rsq + 128 + 128, c.tid, c.lane, c.wave);
            if (c.tid < 128) {
                gs[c.tid] = gval;
                const float M = fmaxf(m0, cm);
                Ms[c.tid] = M; wis[c.tid] = __expf(m0 - M); emt[c.tid] = __expf(-(bt + M)); nqs[c.tid] = 0.f;
                float qn = 0.f;
#pragma unroll 4
                for (int k8 = 0; k8 < 16; ++k8) {
                    float qf[8]; unpack8(*(const LAS v4u*)(Qs + c.tid * TSB + k8 * 16), qf);
#pragma unroll
                    for (int u = 0; u < 8; ++u) qn += qf[u] * lfs[k8 * 8 + u];
                }
                qns[c.tid] = qn;
            }
            __syncthreads();
            {
                f32x4 acc[2][4];
#pragma unroll
                for (int mt = 0; mt < 2; ++mt)
#pragma unroll
                    for (int nt = 0; nt < 4; ++nt) acc[mt][nt] = (f32x4){0.f, 0.f, 0.f, 0.f};
#pragma unroll 1
                for (int ks = 0; ks < 4; ++ks) {
                    h8 a[2], b[4];
#pragma unroll
                    for (int mt = 0; mt < 2; ++mt) a[mt] = frag_row(Ks, TSB, 32 * rt + 16 * mt, 32 * ks, lane);
#pragma unroll
                    for (int nt = 0; nt < 4; ++nt) b[nt] = frag_row(Qs, TSB, 64 * cg + 16 * nt, 32 * ks, lane);
#pragma unroll
                    for (int mt = 0; mt < 2; ++mt)
#pragma unroll
                        for (int nt = 0; nt < 4; ++nt) acc[mt][nt] = MFMA16(a[mt], b[nt], acc[mt][nt]);
                }
#pragma unroll
                for (int nt = 0; nt < 4; ++nt) {
                    const int t = 64 * cg + 16 * nt + fr; const float Mt = Ms[t]; float csum = 0.f;
#pragma unroll
                    for (int mt = 0; mt < 2; ++mt) {
                        const int s0 = 32 * rt + 16 * mt + 4 * fg; float v[4];
#pragma unroll
                        for (int r = 0; r < 4; ++r) {
                            const int s = s0 + r; const bool ok = d == 0 ? (s <= t) : (s >= t);
                            v[r] = ok ? acc[mt][nt][r] * __expf(gs[s] - Mt) : 0.f; csum += v[r];
                        }
                        v2u w; w.x = pk2(v[0], v[1]); w.y = pk2(v[2], v[3]);
                        *(LAS v2u*)(Ss + t * TSB + s0 * 2) = w;
                    }
                    csum += __shfl_xor(csum, 16); csum += __shfl_xor(csum, 32);
                    if (fg == 0) lds_atomic_add(nqs + t, csum);
                }
            }
            __syncthreads();
            {
                f32x4 a1[2][4], a2[2][4];
#pragma unroll
                for (int mt = 0; mt < 2; ++mt)
#pragma unroll
                    for (int nt = 0; nt < 4; ++nt) { a1[mt][nt] = (f32x4){0.f, 0.f, 0.f, 0.f}; a2[mt][nt] = (f32x4){0.f, 0.f, 0.f, 0.f}; }
                const bf16* c0 = C0 + (size_t)sidx * 16384;
#pragma unroll 1
                for (int ks = 0; ks < 4; ++ks) {
                    h8 as_[2], aq[2], bv[4], bc[4];
#pragma unroll
                    for (int nt = 0; nt < 4; ++nt) bc[nt] = *(const h8*)(c0 + (size_t)(64 * cg + 16 * nt + fr) * 128 + 32 * ks + 8 * fg);
#pragma unroll
                    for (int mt = 0; mt < 2; ++mt) { as_[mt] = frag_row(Ss, TSB, 32 * rt + 16 * mt, 32 * ks, lane); aq[mt] = frag_row(Qs, TSB, 32 * rt + 16 * mt, 32 * ks, lane); }
#pragma unroll
                    for (int nt = 0; nt < 4; ++nt) bv[nt] = frag_tr(Vs, TSB, 32 * ks, 64 * cg + 16 * nt, lane);
#pragma unroll
                    for (int mt = 0; mt < 2; ++mt)
#pragma unroll
                        for (int nt = 0; nt < 4; ++nt) { a1[mt][nt] = MFMA16(as_[mt], bv[nt], a1[mt][nt]); a2[mt][nt] = MFMA16(aq[mt], bc[nt], a2[mt][nt]); }
                }
#pragma unroll
                for (int mt = 0; mt < 2; ++mt)
#pragma unroll
                    for (int r = 0; r < 4; ++r) {
                        const int t = 32 * rt + 16 * mt + 4 * fg + r; const float wi = wis[t];
                        const float rden = 1.f / fmaxf(fabsf(nqs[t] + wi * qns[t]), emt[t]);
#pragma unroll
                        for (int nt = 0; nt < 4; ++nt) hsum[mt][nt][r] += (a1[mt][nt][r] + wi * a2[mt][nt][r]) * rden;
                    }
            }
            __syncthreads();
        }
#pragma unroll
        for (int mt = 0; mt < 2; ++mt)
#pragma unroll
            for (int r = 0; r < 4; ++r) {
                const int t = 32 * rt + 16 * mt + 4 * fg + r; float s1 = 0.f, s2 = 0.f;
#pragma unroll
                for (int nt = 0; nt < 4; ++nt) { const float x = hsum[mt][nt][r]; s1 += x; s2 += x * x; *(LAS bf16*)(Ss + t * TSB + (64 * cg + 16 * nt + fr) * 2) = (bf16)f2bf(x); }
#pragma unroll
                for (int o = 1; o < 16; o <<= 1) { s1 += __shfl_xor(s1, o); s2 += __shfl_xor(s2, o); }
                if (fr == 0) { lds_atomic_add(rsum + t, s1); lds_atomic_add(rsq + t, s2); }
            }
        __syncthreads();
        for (int e = c.tid; e < 128 * 16; e += NTHREADS) {
            const int t = e >> 4, ch = e & 15, col0 = h * DH + ch * 8; const size_t row = (size_t)(r0 + t);
            const float mu = rsum[t] * (1.f / 128.f), var = fmaxf(rsq[t] * (1.f / 128.f) - mu * mu, 0.f), rstd = rsqrtf(var + EPS);
            float hf[8], af[8], zf[8], o[8];
            unpack8(*(const LAS v4u*)(Ss + t * TSB + ch * 16), hf); unpack8(*(const v4u*)(ACT + row * DM + col0), af); unpack8(*(const v4u*)(Z + row * DM + col0), zf);
#pragma unroll
            for (int u = 0; u < 8; ++u) { const float hn = (hf[u] - mu) * rstd * norm_w[col0 + u]; o[u] = (hn + skip[col0 + u] * af[u]) * siluf(zf[u]); }
            v4u w; w.x = pk2(o[0], o[1]); w.y = pk2(o[2], o[3]); w.z = pk2(o[4], o[5]); w.w = pk2(o[6], o[7]);
            *(v4u*)(A2 + row * D + col0) = w;
        }
        __syncthreads();
    }
}


__device__ __forceinline__ void p6m_fourier_a(const Ctx& c) {
    const bf16* U = (const bf16*)(c.ws + WS_U); bf16* FB = (bf16*)c.out;
    LAS unsigned char* L = (LAS unsigned char*)c.lds; LAS unsigned char* Ws = L; LAS unsigned char* Us = L + 256 * TSB;
    constexpr int USB = 544;
    const int lane = c.lane, rt = c.wave >> 1, cg = c.wave & 1, fr = lane & 15, fg = lane >> 4;
    for (int e = c.tid; e < 256 * 128; e += NTHREADS) {
        const int row = e >> 7, t1 = e & 127, k1 = 16 * (row >> 5) + (row & 15), ri = (row >> 4) & 1;
        const float ph = (float)((k1 * t1) & 127) * (1.f / 64.f);
        *(LAS bf16*)(Ws + row * TSB + t1 * 2) = (bf16)f2bf(ri ? -sinpif(ph) : cospif(ph));
    }
    __syncthreads();
    for (int it = c.bid; it < 256; it += c.G) {
        const int t2 = it >> 1, nh = it & 1;
        for (int e = c.tid; e < 128 * 32; e += NTHREADS) {
            const int t1 = e >> 5, ch = e & 31;
            *(LAS v4u*)(Us + t1 * USB + ch * 16) = *(const v4u*)(U + (size_t)(128 * t1 + t2) * DM + 256 * nh + ch * 8);
        }
        __syncthreads();
#pragma unroll 1
        for (int np = 0; np < 2; ++np) {
            f32x4 acc[4][4];
#pragma unroll
            for (int mt = 0; mt < 4; ++mt)
#pragma unroll
                for (int nt = 0; nt < 4; ++nt) acc[mt][nt] = (f32x4){0.f, 0.f, 0.f, 0.f};
            const int n0 = 128 * cg + 64 * np;
#pragma unroll 1
            for (int ks = 0; ks < 4; ++ks) {
                h8 a[4], b[4];
#pragma unroll
                for (int mt = 0; mt < 4; ++mt) a[mt] = frag_row(Ws, TSB, 64 * rt + 16 * mt, 32 * ks, lane);
#pragma unroll
                for (int nt = 0; nt < 4; ++nt) b[nt] = frag_tr(Us, USB, 32 * ks, n0 + 16 * nt, lane);
#pragma unroll
                for (int mt = 0; mt < 4; ++mt)
#pragma unroll
                    for (int nt = 0; nt < 4; ++nt) acc[mt][nt] = MFMA16(a[mt], b[nt], acc[mt][nt]);
            }
#pragma unroll
            for (int pi = 0; pi < 2; ++pi)
#pragma unroll
                for (int r = 0; r < 4; ++r) {
                    const int k1 = 16 * (2 * rt + pi) + 4 * fg + r;
                    const float rev = (float)(k1 * t2) * (1.f / 16384.f); const float tc = __builtin_amdgcn_cosf(rev), ts = __builtin_amdgcn_sinf(rev);
                    bf16* dr = FB + ((size_t)(k1 * 128 + t2) * 2) * 512 + 256 * nh + n0 + fr; bf16* di = dr + 512;
#pragma unroll
                    for (int nt = 0; nt < 4; ++nt) {
                        const float ar = acc[2 * pi][nt][r], ai = acc[2 * pi + 1][nt][r];
                        dr[16 * nt] = (bf16)f2bf(ar * tc + ai * ts); di[16 * nt] = (bf16)f2bf(ai * tc - ar * ts);
                    }
                }
        }
        __syncthreads();
    }
}

__device__ __forceinline__ void p7m_fourier_c(const Ctx& c) {
    const bf16* FB = (const bf16*)c.out; const bf16* Gt = (const bf16*)(c.ws + WS_G); bf16* A2 = (bf16*)(c.ws + WS_H);
    LAS unsigned char* L = (LAS unsigned char*)c.lds; LAS unsigned char* Cs = L; LAS unsigned char* Sn = L + TILE_B; LAS unsigned char* BrS = L + 2 * TILE_B; LAS unsigned char* BiS = L + 3 * TILE_B;
    const int lane = c.lane, rt = c.wave >> 1, cg = c.wave & 1, fr = lane & 15, fg = lane >> 4;
    for (int e = c.tid; e < 128 * 128; e += NTHREADS) {
        const int k2 = e >> 7, t2 = e & 127; const float ph = (float)((k2 * t2) & 127) * (1.f / 64.f);
        *(LAS bf16*)(Cs + k2 * TSB + t2 * 2) = (bf16)f2bf(cospif(ph)); *(LAS bf16*)(Sn + k2 * TSB + t2 * 2) = (bf16)f2bf(sinpif(ph));
    }
    __syncthreads();
    for (int it = c.bid; it < 128 * 4; it += c.G) {
        const int k1 = it >> 2, g = it & 3;
        for (int e = c.tid; e < 128 * 32; e += NTHREADS) {
            const int t2 = e >> 5, ri = (e >> 4) & 1, ch = e & 15;
            *(LAS v4u*)((ri ? BiS : BrS) + t2 * TSB + ch * 16) = *(const v4u*)(FB + ((size_t)(k1 * 128 + t2) * 2 + ri) * 512 + g * 128 + ch * 8);
        }
        __syncthreads();
        {
            f32x4 xr[2][4], xi[2][4];
#pragma unroll
            for (int mt = 0; mt < 2; ++mt)
#pragma unroll
                for (int nt = 0; nt < 4; ++nt) { xr[mt][nt] = (f32x4){0.f, 0.f, 0.f, 0.f}; xi[mt][nt] = (f32x4){0.f, 0.f, 0.f, 0.f}; }
#pragma unroll 1
            for (int ks = 0; ks < 4; ++ks) {
                h8 ar[2], ai[2], an[2], bc[4], bs[4];
#pragma unroll
                for (int mt = 0; mt < 2; ++mt) {
                    ar[mt] = frag_tr(BrS, TSB, 32 * ks, 32 * rt + 16 * mt, lane); ai[mt] = frag_tr(BiS, TSB, 32 * ks, 32 * rt + 16 * mt, lane);
                    an[mt] = ar[mt] ^ (short)0x8000;
                }
#pragma unroll
                for (int nt = 0; nt < 4; ++nt) { bc[nt] = frag_row(Cs, TSB, 64 * cg + 16 * nt, 32 * ks, lane); bs[nt] = frag_row(Sn, TSB, 64 * cg + 16 * nt, 32 * ks, lane); }
#pragma unroll
                for (int mt = 0; mt < 2; ++mt)
#pragma unroll
                    for (int nt = 0; nt < 4; ++nt) {
                        xr[mt][nt] = MFMA16(ar[mt], bc[nt], xr[mt][nt]); xr[mt][nt] = MFMA16(ai[mt], bs[nt], xr[mt][nt]);
                        xi[mt][nt] = MFMA16(ai[mt], bc[nt], xi[mt][nt]); xi[mt][nt] = MFMA16(an[mt], bs[nt], xi[mt][nt]);
                    }
            }
            __syncthreads();
#pragma unroll
            for (int mt = 0; mt < 2; ++mt)
#pragma unroll
                for (int nt = 0; nt < 4; ++nt) {
                    const int k2 = 64 * cg + 16 * nt + fr, c0 = 32 * rt + 16 * mt + 4 * fg;
                    v2u w; w.x = pk2(xr[mt][nt][0], xr[mt][nt][1]); w.y = pk2(xr[mt][nt][2], xr[mt][nt][3]); *(LAS v2u*)(BrS + k2 * TSB + c0 * 2) = w;
                    w.x = pk2(xi[mt][nt][0], xi[mt][nt][1]); w.y = pk2(xi[mt][nt][2], xi[mt][nt][3]); *(LAS v2u*)(BiS + k2 * TSB + c0 * 2) = w;
                }
        }
        __syncthreads();
        {
            f32x4 acc[2][4];
#pragma unroll
            for (int mt = 0; mt < 2; ++mt)
#pragma unroll
                for (int nt = 0; nt < 4; ++nt) acc[mt][nt] = (f32x4){0.f, 0.f, 0.f, 0.f};
            const bf16* gt = Gt + (size_t)g * 128 * 256;
#pragma unroll 1
            for (int ks = 0; ks < 8; ++ks) {
                h8 a[2], b[4];
                const LAS unsigned char* xs = ks < 4 ? BrS : BiS;
#pragma unroll
                for (int nt = 0; nt < 4; ++nt) b[nt] = *(const h8*)(gt + (size_t)(64 * cg + 16 * nt + fr) * 256 + 32 * ks + 8 * fg);
#pragma unroll
                for (int mt = 0; mt < 2; ++mt) a[mt] = frag_row(xs, TSB, 32 * rt + 16 * mt, 32 * (ks & 3), lane);
#pragma unroll
                for (int mt = 0; mt < 2; ++mt)
#pragma unroll
                    for (int nt = 0; nt < 4; ++nt) acc[mt][nt] = MFMA16(a[mt], b[nt], acc[mt][nt]);
            }
#pragma unroll
            for (int mt = 0; mt < 2; ++mt)
#pragma unroll
                for (int r = 0; r < 4; ++r) {
                    const int k2 = 32 * rt + 16 * mt + 4 * fg + r; bf16* dst = A2 + (size_t)(k1 + 128 * k2) * D + 512 + g * 128 + 64 * cg + fr;
#pragma unroll
                    for (int nt = 0; nt < 4; ++nt) dst[16 * nt] = (bf16)f2bf(acc[mt][nt][r]);
                }
        }
        __syncthreads();
    }
}

#define XB_TMO      128
#define XB_XCNT(j)  (256  + 64 * (j))
#define XB_XSUB(j)  (1280 + 64 * (j))
#define XB_XGEN(j)  (2304 + 64 * (j))
#define XB_TOP      3328
#define XB_TOPGEN   3392
#define XCD_BAR_WORDS 3456
#define XB_SPIN_CAP (1u << 18)
__device__ __forceinline__ unsigned xb_ld(unsigned* p)              { return __hip_atomic_load(p, __ATOMIC_RELAXED, __HIP_MEMORY_SCOPE_AGENT); }
__device__ __forceinline__ unsigned xb_add(unsigned* p, unsigned v) { return __hip_atomic_fetch_add(p, v, __ATOMIC_RELAXED, __HIP_MEMORY_SCOPE_AGENT); }
__device__ __forceinline__ unsigned xb_xcc_id() { return (unsigned)__builtin_amdgcn_s_getreg((3 << 11) | 20) & 0xFu; }
#define XB_SPIN(cond, bar) do { unsigned _sp = 0; while (cond) { __builtin_amdgcn_s_sleep(1); \
    if ((++_sp & 255u) == 0u) { if (xb_ld(&(bar)[XB_TMO])) break; if (_sp > XB_SPIN_CAP) { atomicAdd(&(bar)[XB_TMO], 1u); break; } } } } while (0)
struct XcdBarrier { unsigned* bar; unsigned x; volatile LAS unsigned* st; };
__device__ __forceinline__ XcdBarrier xcd_barrier_post(unsigned* bar, volatile LAS unsigned* st) {
    XcdBarrier b; b.bar = bar; b.x = xb_xcc_id(); b.st = st;
    if (threadIdx.x == 0) (void)xb_add(&bar[XB_XCNT(b.x)], 1u);
    return b;
}
__device__ __forceinline__ void xcd_barrier_complete(unsigned* bar, unsigned x, unsigned& nloc, unsigned& nx) {
    const unsigned G = gridDim.x * gridDim.y * gridDim.z;
    unsigned sum, cnt, mine, sp = 0u;
    for (;;) {
        sum = 0u; cnt = 0u; mine = 0u;
#pragma unroll
        for (unsigned j = 0; j < 16; ++j) { const unsigned c = xb_ld(&bar[XB_XCNT(j)]); sum += c; cnt += (c > 0u) ? 1u : 0u; mine = (j == x) ? c : mine; }
        if (sum == G) break;
        __builtin_amdgcn_s_sleep(1);
        if ((++sp & 255u) == 0u) { if (xb_ld(&bar[XB_TMO])) break; if (sp > XB_SPIN_CAP) { atomicAdd(&bar[XB_TMO], 1u); break; } }
    }
    nloc = mine > 0u ? mine : 1u; nx = cnt > 0u ? cnt : 1u;
}
__device__ __forceinline__ void xcd_barrier(const XcdBarrier& b) {
    asm volatile("s_waitcnt vmcnt(0)" ::: "memory");
    __syncthreads();
    if (threadIdx.x == 0) {
        unsigned* bar = b.bar;
        __builtin_amdgcn_s_waitcnt(0);
        unsigned nloc = b.st[0], nx = b.st[1];
        if (nloc == 0u) { xcd_barrier_complete(bar, b.x, nloc, nx); b.st[0] = nloc; b.st[1] = nx; }
        const unsigned old = xb_add(&bar[XB_XSUB(b.x)], 1u);
        const unsigned gen = old / nloc;
        if (old + 1u == (gen + 1u) * nloc) {
            __builtin_amdgcn_fence(__ATOMIC_RELEASE, "agent");
            asm volatile("s_waitcnt vmcnt(0)" ::: "memory");
            const unsigned og = xb_add(&bar[XB_TOP], 1u);
            const unsigned tg = og / nx;
            if (og + 1u == (tg + 1u) * nx) xb_add(&bar[XB_TOPGEN], 1u);
            else XB_SPIN(xb_ld(&bar[XB_TOPGEN]) == tg, bar);
            __builtin_amdgcn_fence(__ATOMIC_ACQUIRE, "agent");
            xb_add(&bar[XB_XGEN(b.x)], 1u);
            asm volatile("s_waitcnt vmcnt(0)" ::: "memory");
        } else {
            XB_SPIN(xb_ld(&bar[XB_XGEN(b.x)]) == gen, bar);
            __builtin_amdgcn_fence(__ATOMIC_ACQUIRE, "agent");
            asm volatile("s_waitcnt vmcnt(0)" ::: "memory");
        }
    }
    __syncthreads();
}

#ifndef MK_CG_SYNC
#define MK_CG_SYNC 0
#endif
constexpr int MISC_OFF = LDS_BYTES - 256;
constexpr int TAB_OFF = LDS_BYTES - 1024;
__global__ void __launch_bounds__(NTHREADS, 2) fwd_kernel(Args a) {
    extern __shared__ __attribute__((aligned(16))) unsigned char lds_raw[];
    Ctx c;
    c.tid = threadIdx.x; c.lane = c.tid & 63; c.wave = __builtin_amdgcn_readfirstlane(c.tid >> 6);
    c.G = gridDim.x; c.bid = blockIdx.x; c.gw = c.bid * NWAVES + c.wave; c.NGW = c.G * NWAVES; c.gtid = c.bid * NTHREADS + c.tid; c.NTHR = c.G * NTHREADS;
    c.lds = (float*)lds_raw;
    {
        volatile LAS unsigned* tabw = (volatile LAS unsigned*)((LAS unsigned char*)lds_raw + TAB_OFF);
        if (c.tid == 0) {
#define PUT(i, p) do { tabw[2 * (i)] = (unsigned)(size_t)(p); tabw[2 * (i) + 1] = (unsigned)((size_t)(p) >> 32); } while (0)
            PUT(0, a.in[0]); PUT(1, a.in[1]); PUT(2, a.in[2]); PUT(3, a.in[3]); PUT(4, a.in[4]); PUT(5, a.in[5]); PUT(6, a.in[6]); PUT(7, a.in[7]);
            PUT(8, a.in[8]); PUT(9, a.in[9]); PUT(10, a.in[10]); PUT(11, a.in[11]); PUT(12, a.in[12]); PUT(13, a.in[13]); PUT(14, a.in[14]); PUT(15, a.in[15]);
            PUT(16, a.in[16]); PUT(17, a.in[17]); PUT(18, a.in[18]); PUT(19, a.in[19]); PUT(20, a.in[20]); PUT(21, a.in[21]); PUT(22, a.in[22]); PUT(23, a.in[23]);
            PUT(24, a.in[24]); PUT(25, a.in[25]); PUT(26, a.in[26]); PUT(27, a.in[27]); PUT(28, a.in[28]); PUT(29, a.in[29]); PUT(30, a.in[30]); PUT(31, a.ws); PUT(32, a.out);
#undef PUT
        }
        c.tab = tabw; c.ws = a.ws; c.out = a.out;
    }
    __syncthreads();
#if MK_CG_SYNC
    cooperative_groups::grid_group grid = cooperative_groups::this_grid();
#define GRID_BAR() do { grid.sync(); } while (0)
#else
    volatile LAS unsigned* misc = (volatile LAS unsigned*)((LAS unsigned char*)lds_raw + MISC_OFF);
    if (c.tid < 64) misc[c.tid] = 0u;
    __syncthreads();
    const XcdBarrier bar = xcd_barrier_post((unsigned*)(a.ws + WS_CTL) + 4096, misc + 8);
#define GRID_BAR() do { xcd_barrier(bar); } while (0)
#endif
    volatile LAS int* ts = (volatile LAS int*)((LAS unsigned char*)lds_raw + MISC_OFF) + 16;
#ifndef DUP_MASK
#define DUP_MASK 0
#endif
#define DUP(bit, stmt) do { if (DUP_MASK & (1 << (bit))) { GRID_BAR(); stmt; } } while (0)
    p0_prologue(fresh(c)); conv_small_weights(fresh(c));   GRID_BAR();
    p1_hrows(fresh(c));               GRID_BAR();
    DUP(1, p0_prologue(fresh(c)); conv_small_weights(fresh(c)); GRID_BAR(); p1_hrows(fresh(c)); GRID_BAR());
    g1_gemm1(fresh(c));               GRID_BAR();
    DUP(0, g1_gemm1(fresh(c)); GRID_BAR());
    p3_features(fresh(c)); p6m_fourier_a(fresh(c));  GRID_BAR();
    DUP(1, p3_features(fresh(c)); GRID_BAR());
    DUP(4, p6m_fourier_a(fresh(c)); GRID_BAR());
    p4m_summaries(fresh(c));          GRID_BAR();
    DUP(3, p4m_summaries(fresh(c)); GRID_BAR());
    p5_scan(fresh(c)); p7m_fourier_c(fresh(c));      GRID_BAR();
    DUP(2, p5_scan(fresh(c)); GRID_BAR());
    DUP(4, p7m_fourier_c(fresh(c)); GRID_BAR());
    p8m_mlstm_out(fresh(c)); conv_moe_weights(fresh(c));   GRID_BAR();
    DUP(3, p8m_mlstm_out(fresh(c)); GRID_BAR());
    DUP(5, conv_moe_weights(fresh(c)); GRID_BAR());
    g2_outproj(fresh(c));             GRID_BAR();
    DUP(0, g2_outproj(fresh(c)); GRID_BAR());
    p10b_token(fresh(c));             GRID_BAR();
    p10c_scatter(fresh(c));           GRID_BAR();
    g3_moe_up(fresh(c), ts);          GRID_BAR();
    DUP(0, g3_moe_up(fresh(c), ts); GRID_BAR());
    g4_moe_down(fresh(c), ts);        GRID_BAR();
    DUP(0, g4_moe_down(fresh(c), ts); GRID_BAR());
    p12b_final(fresh(c));
}

extern "C" void kernel_launch(void* const* d_in, const int* in_sizes, int n_in, void* d_out, int out_size, void* d_ws, size_t ws_size, hipStream_t stream) {
    static int grid = 0;
    if (grid == 0) {
        if (n_in != 31 || out_size != T * D || ws_size < 256 * MiB) { fprintf(stderr, "kernel_launch: unexpected shapes n_in %d out %d ws %zu\n", n_in, out_size, ws_size); grid = -1; return; }
        int dev = 0, cus = 0, per_cu = 0;
        (void)hipGetDevice(&dev); (void)hipDeviceGetAttribute(&cus, hipDeviceAttributeMultiprocessorCount, dev);
        if (hipFuncSetAttribute((const void*)fwd_kernel, hipFuncAttributeMaxDynamicSharedMemorySize, LDS_BYTES) != hipSuccess) { fprintf(stderr, "kernel_launch: hipFuncSetAttribute failed\n"); grid = -1; return; }
        if (hipOccupancyMaxActiveBlocksPerMultiprocessor(&per_cu, (const void*)fwd_kernel, NTHREADS, LDS_BYTES) != hipSuccess || per_cu < 1) { fprintf(stderr, "kernel_launch: occupancy query says %d blocks per CU\n", per_cu); (void)hipGetLastError(); per_cu = 1; }
        grid = (cus > 0 ? cus : 256);
        fprintf(stderr, "kernel_launch: cus %d occupancy %d grid %d\n", cus, per_cu, grid);
    }
    if (grid < 0) return;
    (void)hipMemsetAsync((char*)d_ws + WS_CTL, 0, 65536, stream);
    Args a{};
    for (int i = 0; i < 31; ++i) a.in[i] = (const float*)d_in[i];
    a.out = (float*)d_out; a.ws = (unsigned char*)d_ws; a.ph_lo = 0; a.ph_hi = 0;
    void* kargs[] = {&a};
    hipError_t e = hipLaunchCooperativeKernel((const void*)fwd_kernel, dim3(grid), dim3(NTHREADS), kargs, LDS_BYTES, stream);
    if (e != hipSuccess) fprintf(stderr, "kernel_launch: cooperative launch failed: %s (grid %d)\n", hipGetErrorString(e), grid);
}
```

```cpp
#include <hip/hip_runtime.h>
#include <hip/hip_cooperative_groups.h>
#include <cstdio>

typedef unsigned short bf16;
typedef unsigned v4u __attribute__((ext_vector_type(4)));
typedef float f32x4 __attribute__((ext_vector_type(4)));

constexpr int D = 1024, T = 16384, TC = 256, NT = T + TC;
constexpr int DM = 512, NH = 4, DH = 128, CH = 128, NCL = T / CH, NCC = TC / CH, NCH = NCL + NCC;
constexpr int DIN = 1536, NE = 16, DE = 512;
constexpr float EPS = 1e-6f;
constexpr int NTHREADS = 512, NWAVES = 8;
constexpr int LDS_BYTES = 163840;

constexpr size_t MiB = 1u << 20;
constexpr size_t WS_CTL = 0;
constexpr size_t WS_MOD = 1 * MiB;
constexpr size_t WS_MODC = 1 * MiB + 32768;
constexpr size_t WS_POSR = 1 * MiB + 65536;
constexpr size_t WS_POSC = WS_POSR + 256 * 512 * 4;
constexpr size_t WS_G = 2 * MiB;
constexpr size_t WS_IG = 3 * MiB;
constexpr size_t WS_LF = 4 * MiB;
constexpr size_t WS_AMAX = 5 * MiB;
constexpr size_t WS_BTOT = 5 * MiB + 8192;
constexpr size_t WS_M0 = 5 * MiB + 16384;
constexpr size_t WS_NL = 5 * MiB + 65536;
constexpr size_t WS_N0 = 6 * MiB;
constexpr size_t WS_RE = 7 * MiB;
constexpr size_t WS_RW = 7 * MiB + 256 * 1024;
constexpr size_t WS_H = 13 * MiB;
constexpr size_t WS_XM = 46 * MiB;
constexpr size_t WS_U = WS_XM + (size_t)NT * 1024;
constexpr size_t WS_Z = 79 * MiB;
constexpr size_t WS_C0 = 46 * MiB;
constexpr size_t WS_Q = 96 * MiB, WS_K = WS_Q + (size_t)NT * 1024, WS_V = WS_K + (size_t)NT * 1024, WS_ACT = WS_V + (size_t)NT * 1024;
constexpr size_t WS_L = 163 * MiB;
constexpr size_t WS_Y = 96 * MiB;
static_assert(WS_U + (size_t)NT * 1024 <= WS_Z && WS_Z + (size_t)NT * 1024 <= WS_Q && WS_ACT + (size_t)NT * 1024 <= WS_L && WS_L + 65 * MiB <= 256 * MiB, "ws map");
static_assert(WS_C0 + 32 * MiB <= WS_Z && WS_Y + 64 * MiB <= WS_L && WS_H + (size_t)NT * 2048 <= WS_XM, "ws map 2");
constexpr size_t WS_WIN_T = 8 * MiB;
constexpr size_t WS_WOUT_T = 11 * MiB;
constexpr size_t WS_WGU_T = 168 * MiB;
constexpr size_t WS_WD_T = 200 * MiB;
constexpr size_t WS_ASORT = 96 * MiB;
constexpr size_t WS_YROW = 96 * MiB;
constexpr size_t WS_ACTS = 46 * MiB;
constexpr size_t WS_RS = 7 * MiB + 512 * 1024;
constexpr size_t WS_ROWW = 216 * MiB;
constexpr size_t WS_ROWTOK = 217 * MiB;
constexpr int CW_CNT = 8192;
static_assert(WS_ASORT + 72 * MiB <= WS_WGU_T && WS_WD_T + 16 * MiB <= WS_ROWW && WS_ACTS + 36 * MiB <= WS_ASORT, "ws map 3");

#define LAS __attribute__((address_space(3)))
struct Args { const float* in[31]; float* out; unsigned char* ws; int ph_lo, ph_hi; };

__device__ __forceinline__ float bf2f(unsigned b) { return __uint_as_float(b << 16); }
__device__ __forceinline__ unsigned f2bf(float f) { unsigned u = __float_as_uint(f); return (u + 0x7fffu + ((u >> 16) & 1u)) >> 16; }
__device__ __forceinline__ unsigned pk2(float lo, float hi) { return f2bf(lo) | (f2bf(hi) << 16); }
__device__ __forceinline__ float lo16(unsigned w) { return __uint_as_float(w << 16); }
__device__ __forceinline__ float hi16(unsigned w) { return __uint_as_float(w & 0xffff0000u); }
__device__ __forceinline__ float wave_sum(float v) {
#pragma unroll
    for (int o = 1; o < 64; o <<= 1) v += __shfl_xor(v, o);
    return v;
}
__device__ __forceinline__ float siluf(float x) { return x / (1.f + __expf(-x)); }
__device__ __forceinline__ float logsigf(float x) { return fminf(x, 0.f) - log1pf(__expf(-fabsf(x))); }
__device__ __forceinline__ void unpack8(const v4u w, float (&f)[8]) {
    f[0] = lo16(w.x); f[1] = hi16(w.x); f[2] = lo16(w.y); f[3] = hi16(w.y); f[4] = lo16(w.z); f[5] = hi16(w.z); f[6] = lo16(w.w); f[7] = hi16(w.w);
}
template <bool MAXOP>
__device__ __forceinline__ float scan128(float v, bool rev, LAS float* tmp, int tid, int lane, int wave) {
    float x = v;
#pragma unroll
    for (int o = 1; o < 64; o <<= 1) {
        const float y = rev ? __shfl_down(x, o) : __shfl_up(x, o);
        const bool ok = rev ? (lane + o < 64) : (lane >= o);
        if (ok) x = MAXOP ? fmaxf(x, y) : x + y;
    }
    if (wave < 2 && lane == (rev ? 0 : 63)) tmp[wave] = x;
    __syncthreads();
    if (tid < 128) {
        if (!rev && wave == 1) x = MAXOP ? fmaxf(x, tmp[0]) : x + tmp[0];
        if (rev && wave == 0) x = MAXOP ? fmaxf(x, tmp[1]) : x + tmp[1];
    }
    __syncthreads();
    return x;
}
__device__ __forceinline__ int chunk_row0(int d, int j) {
    if (d == 0) return j < NCC ? T + j * CH : (j - NCC) * CH;
    return j < NCC ? T + (NCC - 1 - j) * CH : (NCL - 1 - (j - NCC)) * CH;
}

struct Ctx {
    int tid, lane, wave, gw, NGW, gtid, NTHR, G, bid;
    unsigned char* ws; float* out; const volatile LAS unsigned* tab;
    float* lds;
};

__device__ __forceinline__ const void* tab_ptr(const volatile LAS unsigned* tab, int i) {
    unsigned lo = tab[2 * i], hi = tab[2 * i + 1];
    lo = __builtin_amdgcn_readfirstlane(lo); hi = __builtin_amdgcn_readfirstlane(hi);
    return (const void*)(((size_t)hi << 32) | lo);
}
__device__ __forceinline__ const float* inp(const Ctx& c, int i) { return (const float*)tab_ptr(c.tab, i); }
__device__ __forceinline__ Ctx fresh(const Ctx& c0) {
    Ctx c = c0;
    int t = threadIdx.x; asm volatile("" : "+v"(t));
    c.tid = t; c.lane = t & 63; c.wave = __builtin_amdgcn_readfirstlane(t >> 6);
    c.gw = c.bid * NWAVES + c.wave; c.gtid = c.bid * NTHREADS + t;
    c.ws = (unsigned char*)tab_ptr(c0.tab, 31); c.out = (float*)tab_ptr(c0.tab, 32);
    return c;
}
template <int K>
__device__ __forceinline__ void gemm_8x64(const bf16* a0, const bf16* a1, const bf16* a2, const bf16* a3, const bf16* a4, const bf16* a5, const bf16* a6, const bf16* a7,
                                          const float* B, int ldb, int col, float (&acc)[8]) {
    for (int k0 = 0; k0 < K; k0 += 8) {
        float a[8][8];
        unpack8(*(const v4u*)(a0 + k0), a[0]); unpack8(*(const v4u*)(a1 + k0), a[1]); unpack8(*(const v4u*)(a2 + k0), a[2]); unpack8(*(const v4u*)(a3 + k0), a[3]);
        unpack8(*(const v4u*)(a4 + k0), a[4]); unpack8(*(const v4u*)(a5 + k0), a[5]); unpack8(*(const v4u*)(a6 + k0), a[6]); unpack8(*(const v4u*)(a7 + k0), a[7]);
#pragma unroll
        for (int kk = 0; kk < 8; ++kk) {
            const float b = B[(size_t)(k0 + kk) * ldb + col];
#pragma unroll
            for (int r = 0; r < 8; ++r) acc[r] += a[r][kk] * b;
        }
    }
}

__device__ __forceinline__ void p0_prologue(const Ctx& c) {
    const float* cvec = inp(c, 1); const float* ccvec = inp(c, 3); const float* w_ada = inp(c, 4); const float* b_ada = inp(c, 5);
    float* mod = (float*)(c.ws + WS_MOD); float* modc = (float*)(c.ws + WS_MODC);
    for (int it = c.bid; it < 96; it += c.G) {
        const int col = it * 64 + c.lane; float al = 0.f, ac = 0.f;
#pragma unroll 16
        for (int k = c.wave * 128; k < c.wave * 128 + 128; ++k) {
            const float w = w_ada[(size_t)k * 6144 + col];
            al += siluf(cvec[k]) * w; ac += siluf(ccvec[k]) * w;
        }
        c.lds[(c.wave * 64 + c.lane) * 2] = al; c.lds[(c.wave * 64 + c.lane) * 2 + 1] = ac;
        __syncthreads();
        if (c.wave == 0) {
            float sl = 0.f, sc = 0.f;
            for (int w = 0; w < 8; ++w) { sl += c.lds[(w * 64 + c.lane) * 2]; sc += c.lds[(w * 64 + c.lane) * 2 + 1]; }
            mod[col] = sl + b_ada[col];
            if (col < 2048) modc[col] = sc + b_ada[col];
        }
        __syncthreads();
    }
    float* posR = (float*)(c.ws + WS_POSR);
    for (int i = c.gtid; i < 320 * 512; i += c.NTHR) {
        const int r = i >> 9, j = i & 511, p = r < 256 ? r : r - 256, fi = j & 255;
        const float freq = 1.0f / powf(10000.0f, (float)fi / 256.0f);
        const float ang = (float)p * freq;
        posR[i] = j < 256 ? sinf(ang) : cosf(ang);
    }
    const float* wf = inp(c, 22); bf16* Gt = (bf16*)(c.ws + WS_G);
    const float scale = 1.0f / sqrtf(16384.0f * 128.0f);
    LAS float* tab = (LAS float*)c.lds + 2048;
    if (c.tid < 128) { tab[c.tid] = cospif((float)c.tid * (1.f / 64.f)); tab[128 + c.tid] = sinpif((float)c.tid * (1.f / 64.f)); }
    __syncthreads();
    for (int i = c.gtid; i < 4 * 128 * 256; i += c.NTHR) {
        const int g = i >> 15, d = (i >> 8) & 127, row = i & 255, cc = row & 127; float s = 0.f;
        const LAS float* tb = tab + (row < 128 ? 0 : 128); const float* wp = wf + (size_t)g * 128 * 128 + d;
#pragma unroll 8
        for (int c2 = 0; c2 < 128; ++c2) s += tb[(cc * c2) & 127] * wp[c2 * 128];
        Gt[i] = (bf16)f2bf(s * scale);
    }
}

__device__ __forceinline__ void p1_hrows(const Ctx& c) {
    const float* x = inp(c, 0); const float* ctx = inp(c, 2); const float* g = inp(c, 6);
    const float* mod = (const float*)(c.ws + WS_MOD); const float* modc = (const float*)(c.ws + WS_MODC);
    const float* posR = (const float*)(c.ws + WS_POSR); const float* posC = (const float*)(c.ws + WS_POSC);
    bf16* H = (bf16*)(c.ws + WS_H);
    for (int r = c.gw; r < NT; r += c.NGW) {
        asm volatile("" ::: "memory");
        const bool lat = r < T;
        const float* src = lat ? x + (size_t)r * D : ctx + (size_t)(r - T) * D;
        const float* md = lat ? mod : modc;
        f32x4 v[4]; float ss = 0.f;
#pragma unroll
        for (int j = 0; j < 4; ++j) {
            const int col = 256 * j + 4 * c.lane;
            v[j] = *(const f32x4*)(src + col);
            if (lat) { const float* pp = col < 512 ? posR + (r >> 6) * 512 + col : posC + (r & 63) * 512 + (col - 512); v[j] += *(const f32x4*)pp; }
            ss += v[j].x * v[j].x + v[j].y * v[j].y + v[j].z * v[j].z + v[j].w * v[j].w;
        }
        const float rinv = rsqrtf(wave_sum(ss) * (1.f / D) + EPS);
#pragma unroll
        for (int j = 0; j < 4; ++j) {
            const int col = 256 * j + 4 * c.lane;
            const f32x4 gg = *(const f32x4*)(g + col), sh = *(const f32x4*)(md + col), sc = *(const f32x4*)(md + 1024 + col);
            const f32x4 o = v[j] * rinv * gg * (sc + 1.f) + sh;
            uint2 w; w.x = pk2(o.x, o.y); w.y = pk2(o.z, o.w);
            *(uint2*)(H + (size_t)r * D + col) = w;
        }
    }
}

__device__ __forceinline__ void p3_features(const Ctx& c) {
    const bf16* XM = (const bf16*)(c.ws + WS_XM);
    bf16* Q = (bf16*)(c.ws + WS_Q); bf16* Kb = (bf16*)(c.ws + WS_K); bf16* Vb = (bf16*)(c.ws + WS_V); bf16* ACT = (bf16*)(c.ws + WS_ACT);
    float* IG = (float*)(c.ws + WS_IG); float* LF = (float*)(c.ws + WS_LF);
    LAS float* WL = (LAS float*)c.lds; LAS float* PW = WL + 24 * 64 * 20;
    {
        const float* wf_ = inp(c, 16); const float* wb_ = inp(c, 18);
        for (int idx = c.tid; idx < 24 * 64 * 16; idx += NTHREADS) {
            const int pi = idx >> 10, ln = (idx >> 4) & 63, dj = idx & 15, part = pi >> 3, i = pi & 7, d = dj >> 3, j = dj & 7;
            WL[(pi * 64 + ln) * 20 + dj] = (d ? wb_ : wf_)[(size_t)(part * 512 + 8 * ln + i) * 8 + j];
        }
        const float* conv_w = inp(c, 11); const float* conv_b = inp(c, 12); const float* wq = inp(c, 13); const float* wk = inp(c, 14); const float* wv = inp(c, 15);
        for (int idx = c.tid; idx < 64 * 128; idx += NTHREADS) {
            const int ln = idx >> 7, k = idx & 127; float v;
            if (k < 32) v = wq[ln * 32 + k]; else if (k < 64) v = wk[ln * 32 + k - 32]; else if (k < 96) v = wv[ln * 32 + k - 64];
            else if (k < 120) v = conv_w[((k - 96) >> 3) * DM + 8 * ln + ((k - 96) & 7)]; else v = conv_b[8 * ln + k - 120];
            PW[((k >> 2) * 64 + ln) * 4 + (k & 3)] = v;
        }
    }
    __syncthreads();
    const float bias_ = 0.f; (void)bias_;
    const float* bif_f = inp(c, 17); const float* bif_b = inp(c, 19);
    const int ch0 = 8 * c.lane;
#define PWV(k4) (*(const LAS f32x4*)(PW + ((k4) * 64 + c.lane) * 4))
    for (int r = c.gw; r < NT; r += c.NGW) {
        const bool lat = r < T;
        const bool hasp = lat ? (r > 0) : (r > T), hasn = lat ? (r < T - 1) : (r < NT - 1);
        float xc[8], xp[8], xn[8];
        unpack8(*(const v4u*)(XM + (size_t)r * DM + ch0), xc);
        if (hasp) unpack8(*(const v4u*)(XM + (size_t)(r - 1) * DM + ch0), xp); else { for (int i = 0; i < 8; ++i) xp[i] = 0.f; }
        if (hasn) unpack8(*(const v4u*)(XM + (size_t)(r + 1) * DM + ch0), xn); else { for (int i = 0; i < 8; ++i) xn[i] = 0.f; }
        float act[8], q[8], k[8], v[8];
        {
            const f32x4 w0a = PWV(24), w0b = PWV(25), w1a = PWV(26), w1b = PWV(27), w2a = PWV(28), w2b = PWV(29), cba = PWV(30), cbb = PWV(31);
#pragma unroll
            for (int i = 0; i < 4; ++i) {
                act[i] = siluf(w0a[i] * xp[i] + w1a[i] * xc[i] + w2a[i] * xn[i] + cba[i]);
                act[4 + i] = siluf(w0b[i] * xp[4 + i] + w1b[i] * xc[4 + i] + w2b[i] * xn[4 + i] + cbb[i]);
            }
        }
#pragma unroll
        for (int b = 0; b < 2; ++b) {
#pragma unroll
            for (int o = 0; o < 4; ++o) { q[4 * b + o] = 0.f; k[4 * b + o] = 0.f; v[4 * b + o] = 0.f; }
#pragma unroll
            for (int i = 0; i < 4; ++i) {
                const f32x4 wq4 = PWV(b * 4 + i), wk4 = PWV(8 + b * 4 + i), wv4 = PWV(16 + b * 4 + i);
#pragma unroll
                for (int o = 0; o < 4; ++o) { q[4 * b + o] += act[4 * b + i] * wq4[o]; k[4 * b + o] += act[4 * b + i] * wk4[o]; v[4 * b + o] += xc[4 * b + i] * wv4[o]; }
            }
        }
        float sg[16];
#pragma unroll
        for (int u = 0; u < 16; ++u) sg[u] = 0.f;
#pragma unroll
        for (int part = 0; part < 3; ++part)
#pragma unroll
            for (int i = 0; i < 8; ++i) {
                const float xv = part == 0 ? q[i] : (part == 1 ? k[i] : v[i]);
                const LAS float* wp = WL + ((part * 8 + i) * 64 + c.lane) * 20;
#pragma unroll
                for (int u4 = 0; u4 < 4; ++u4) { const f32x4 w4 = *(const LAS f32x4*)(wp + 4 * u4);
#pragma unroll
                    for (int e = 0; e < 4; ++e) sg[4 * u4 + e] += xv * w4[e]; }
            }
        float t8[8], t4[4], t2[2];
        { const bool hi = (c.lane & 32) != 0;
#pragma unroll
          for (int u = 0; u < 8; ++u) { const float send = hi ? sg[u] : sg[u + 8], keep = hi ? sg[u + 8] : sg[u]; t8[u] = keep + __shfl_xor(send, 32); } }
        { const bool hi = (c.lane & 16) != 0;
#pragma unroll
          for (int u = 0; u < 4; ++u) { const float send = hi ? t8[u] : t8[u + 4], keep = hi ? t8[u + 4] : t8[u]; t4[u] = keep + __shfl_xor(send, 16); } }
        { const bool hi = (c.lane & 8) != 0;
#pragma unroll
          for (int u = 0; u < 2; ++u) { const float send = hi ? t4[u] : t4[u + 2], keep = hi ? t4[u + 2] : t4[u]; t2[u] = keep + __shfl_xor(send, 8); } }
        float gsum;
        { const bool hi = (c.lane & 4) != 0; const float send = hi ? t2[0] : t2[1], keep = hi ? t2[1] : t2[0]; gsum = keep + __shfl_xor(send, 4); }
        gsum += __shfl_xor(gsum, 2); gsum += __shfl_xor(gsum, 1);
        if ((c.lane & 3) == 0) {
            const int gi = (c.lane >> 2) & 15, d = gi >> 3, j = gi & 7;
            const float val = gsum + (d ? bif_b : bif_f)[j];
            if (j < 4) IG[(size_t)(d * 4 + j) * NT + r] = val; else LF[(size_t)(d * 4 + (j - 4)) * NT + r] = logsigf(val);
        }
        const float qs = 0.08838834764831845f;
        v4u w;
        w.x = pk2(q[0] * qs, q[1] * qs); w.y = pk2(q[2] * qs, q[3] * qs); w.z = pk2(q[4] * qs, q[5] * qs); w.w = pk2(q[6] * qs, q[7] * qs); *(v4u*)(Q + (size_t)r * DM + ch0) = w;
        w.x = pk2(k[0], k[1]); w.y = pk2(k[2], k[3]); w.z = pk2(k[4], k[5]); w.w = pk2(k[6], k[7]); *(v4u*)(Kb + (size_t)r * DM + ch0) = w;
        w.x = pk2(v[0], v[1]); w.y = pk2(v[2], v[3]); w.z = pk2(v[4], v[5]); w.w = pk2(v[6], v[7]); *(v4u*)(Vb + (size_t)r * DM + ch0) = w;
        w.x = pk2(act[0], act[1]); w.y = pk2(act[2], act[3]); w.z = pk2(act[4], act[5]); w.w = pk2(act[6], act[7]); *(v4u*)(ACT + (size_t)r * DM + ch0) = w;
    }
#undef PWV
    __syncthreads();
}

__device__ __forceinline__ void p5_scan(const Ctx& c) {
    const float* LT = (const float*)(c.ws + WS_L); const float* NL = (const float*)(c.ws + WS_NL);
    const float* AMAX = (const float*)(c.ws + WS_AMAX); const float* BTOT = (const float*)(c.ws + WS_BTOT);
    bf16* C0 = (bf16*)(c.ws + WS_C0); float* N0 = (float*)(c.ws + WS_N0); float* M0 = (float*)(c.ws + WS_M0);
    constexpr int PER = 16384 + 128, JB = 13;
    for (int e = c.gtid; e < 8 * PER; e += c.NTHR) {
        const int dh = e / PER, rem = e % PER; const bool isC = rem < 16384; const int idx = isC ? rem : rem - 16384;
        const float* src = isC ? LT + (size_t)dh * NCH * 16384 + idx : NL + (size_t)dh * NCH * 128 + idx; const size_t sstep = isC ? 16384 : 128;
        float m = 0.f, val = 0.f;
#pragma unroll 1
        for (int jb = 0; jb < NCH; jb += JB) {
            float lv[JB], bt[JB], am[JB];
#pragma unroll
            for (int u = 0; u < JB; ++u) { lv[u] = src[(size_t)(jb + u) * sstep]; bt[u] = BTOT[dh * NCH + jb + u]; am[u] = AMAX[dh * NCH + jb + u]; }
#pragma unroll
            for (int u = 0; u < JB; ++u) {
                const int j = jb + u;
                if (j >= NCC) {
                    if (isC) C0[((size_t)(dh * NCL + (j - NCC))) * 16384 + idx] = (bf16)f2bf(val);
                    else N0[(size_t)(dh * NCL + (j - NCC)) * 128 + idx] = val;
                    if (rem == 0) M0[dh * NCL + (j - NCC)] = m;
                }
                const float mn = fmaxf(bt[u] + m, am[u]), dec = __expf(bt[u] + m - mn), sc = __expf(am[u] - mn);
                val = dec * val + sc * lv[u]; m = mn;
            }
        }
    }
}

namespace pg8 {
#define PG8_LAS __attribute__((address_space(3)))
typedef unsigned short bf16_t;
typedef short bf16x8 __attribute__((ext_vector_type(8)));
typedef float f32x4 __attribute__((ext_vector_type(4)));
typedef unsigned u32x4 __attribute__((ext_vector_type(4)));
constexpr int BM = 256, BK = 64, HALF = 128, HTB = HALF * BK * 2  , STAGE_BYTES = 8 * HTB, NXCD = 8, WGM = 8;

__host__ __device__ __forceinline__ int lds_byte(int r, int c) { const int st = (r >> 4) * 2 + (c >> 5), rr = r & 15, cc = c & 31, ob = rr * 64 + cc * 2; return st * 1024 + (ob ^ (((ob >> 9) & 1) << 5)); }
__host__ __device__ __forceinline__ void stage_rc(int b, int& R, int& C) { const int st = b / 1024, sb = b % 1024, swz = sb ^ (((sb >> 9) & 1) << 5); R = (st >> 1) * 16 + swz / 64; C = (st & 1) * 32 + (swz % 64) / 2; }
__host__ __device__ __forceinline__ int perm32(int rho) { const int n = rho >> 4, i = rho & 15; return 8 * (i >> 2) + 4 * n + (i & 3); }

struct Unit { int pm, pn; };
struct Gemm { const bf16_t* A; const bf16_t* Bt; int M, N, K; };

struct StaticOrder {
    int nM, nN, nwg, G, c;
    __host__ __device__ void init(int M, int N, int G_, int c_) { nM = M / BM; nN = N / BM; nwg = nM * nN; G = G_; c = c_; }
    __host__ __device__ bool next(int i, Unit& u) const {
        const long L = (long)i * G + c; if (L >= nwg) return false;
        int wgid = (int)L; { const int q = nwg / NXCD, r = nwg % NXCD, xcd = wgid % NXCD, off = wgid / NXCD; wgid = (xcd < r ? xcd * (q + 1) : r * (q + 1) + (xcd - r) * q) + off; }
        const int nig = WGM * nN, gid = wgid / nig, fm = gid * WGM, gsz = (nM - fm) < WGM ? (nM - fm) : WGM;
        u.pm = fm + ((wgid % nig) % gsz); u.pn = (wgid % nig) / gsz; return true;
    }
    __device__ __forceinline__ void a_ready(const Unit&) const {}
    __device__ __forceinline__ void done(const Unit&) const {}
};
__device__ __forceinline__ unsigned cvt_pk_bf16(float lo, float hi) { unsigned r; asm volatile("v_cvt_pk_bf16_f32 %0, %1, %2" : "=v"(r) : "v"(lo), "v"(hi)); return r; }
template <class Epi, class Sched, bool ALIGN_EPI = false, bool SP2 = false>
__device__ __forceinline__ void gemm_phase(PG8_LAS unsigned char* lds, const Gemm g, const Sched& S, const Epi& E) {
    int tid_ = threadIdx.x; asm volatile("" : "+v"(tid_));
    const int tid = tid_, wid = __builtin_amdgcn_readfirstlane(tid >> 6), lane = tid & 63, wr = wid >> 2, wc = wid & 3, fr = lane & 15, fq = lane >> 4;
    const int K = g.K, nt = K / BK;
    unsigned voffA[2], voffB[2];
#pragma unroll
    for (int i = 0; i < 2; ++i) { int R, C; stage_rc(tid * 16 + i * 8192, R, C); const int Rb = Epi::PERM ? ((R & ~31) + perm32(R & 31)) : R;
        voffA[i] = (unsigned)(R * K + C) * 2u; voffB[i] = (unsigned)(Rb * K + C) * 2u; }
    const size_t kstep = (size_t)(BK * 2);
    const size_t hstep = (size_t)HALF * K * 2;
    const size_t tstep = 2 * hstep;
    const unsigned ldsw = (unsigned)wid * 1024u;
    const int aoff = lds_byte(wr * 64 + fr, fq * 8), boff = lds_byte(wc * 32 + fr, fq * 8);
#define PG8_SA(b, h) (((b) * 2 + (h)) * HTB)
#define PG8_SB(b, h) ((4 + (b) * 2 + (h)) * HTB)
#define PG8_STAGE(bufoff, gbase, voff) do { _Pragma("unroll") for (int _i = 0; _i < 2; ++_i) \
        __builtin_amdgcn_global_load_lds((const unsigned*)((const char*)(gbase) + (voff)[_i]), (PG8_LAS unsigned*)(lds + (bufoff) + ldsw + _i * 8192), 16, 0, 0); } while (0)
#define PG8_LDA(dst, b, h) do { _Pragma("unroll") for (int m = 0; m < 4; ++m) _Pragma("unroll") for (int k = 0; k < 2; ++k) dst[m][k] = *(const PG8_LAS bf16x8*)(lds + PG8_SA(b, h) + aoff + m * 2048 + k * 1024); } while (0)
#define PG8_LDB(dst, b, h) do { _Pragma("unroll") for (int n = 0; n < 2; ++n) _Pragma("unroll") for (int k = 0; k < 2; ++k) dst[n][k] = *(const PG8_LAS bf16x8*)(lds + PG8_SB(b, h) + boff + n * 2048 + k * 1024); } while (0)
#define PG8_MMA(ai, bj, At, Bt) do { __builtin_amdgcn_s_setprio(1); _Pragma("unroll") for (int m = 0; m < 4; ++m) _Pragma("unroll") for (int n = 0; n < 2; ++n) _Pragma("unroll") for (int k = 0; k < 2; ++k) \
        acc[ai][bj][m][n] = __builtin_amdgcn_mfma_f32_16x16x32_bf16(Bt[n][k], At[m][k], acc[ai][bj][m][n], 0, 0, 0); __builtin_amdgcn_s_setprio(0); } while (0)
#define PG8_WAIT_V(n) asm volatile("s_waitcnt vmcnt(" #n ")" ::: "memory")
#define PG8_WAIT_L(n) asm volatile("s_waitcnt lgkmcnt(" #n ")" ::: "memory")
#define PG8_BAR __builtin_amdgcn_s_barrier()
#define PG8_SCHED __builtin_amdgcn_sched_barrier(0)
    Unit cur, nxt; int ui = 0;
    if (!S.next(0, cur)) return;
    f32x4 acc[2][2][4][2];
#pragma unroll
    for (int a = 0; a < 2; ++a)
#pragma unroll
        for (int b = 0; b < 2; ++b)
#pragma unroll
            for (int m = 0; m < 4; ++m)
#pragma unroll
                for (int n = 0; n < 2; ++n) acc[a][b][m][n] = (f32x4){0.f, 0.f, 0.f, 0.f};
    bf16x8 At[4][2], B0[2][2], B1[2][2];
    const char* cA = (const char*)g.A + (size_t)cur.pm * tstep; const char* cB = (const char*)g.Bt + (size_t)cur.pn * tstep;
    S.a_ready(cur);
    if constexpr (SP2) {
        PG8_STAGE(PG8_SB(0, 0), cB, voffB); PG8_STAGE(PG8_SB(0, 1), cB + hstep, voffB); PG8_STAGE(PG8_SA(0, 0), cA, voffA); PG8_STAGE(PG8_SA(0, 1), cA + hstep, voffA);
        if (wr == 1) PG8_BAR;
        PG8_WAIT_V(2); PG8_BAR;
        PG8_STAGE(PG8_SB(1, 0), cB + kstep, voffB); PG8_STAGE(PG8_SA(1, 0), cA + kstep, voffA); PG8_STAGE(PG8_SB(1, 1), cB + hstep + kstep, voffB);
        PG8_WAIT_V(6); PG8_BAR;
    } else {
        PG8_STAGE(PG8_SB(0, 0), cB, voffB); PG8_STAGE(PG8_SA(0, 0), cA, voffA); PG8_STAGE(PG8_SB(0, 1), cB + hstep, voffB); PG8_STAGE(PG8_SA(0, 1), cA + hstep, voffA);
        if (wr == 1) PG8_BAR;
        PG8_WAIT_V(4); PG8_BAR;
        PG8_STAGE(PG8_SB(1, 0), cB + kstep, voffB); PG8_STAGE(PG8_SA(1, 0), cA + kstep, voffA); PG8_STAGE(PG8_SB(1, 1), cB + hstep + kstep, voffB);
        PG8_WAIT_V(6); PG8_BAR;
    }
    for (;;) {
        const bool has_next = S.next(ui + 1, nxt);
        const char* nA = has_next ? (const char*)g.A + (size_t)nxt.pm * tstep : cA; const char* nB = has_next ? (const char*)g.Bt + (size_t)nxt.pn * tstep : cB;
        for (int t = 0; t < nt; t += 2) {
            const bool last = (t == nt - 2);
            const char* a1 = cA + (size_t)(t + 1) * kstep;
            const char* a2 = last ? nA : cA + (size_t)(t + 2) * kstep; const char* b2 = last ? nB : cB + (size_t)(t + 2) * kstep;
            const char* a3 = a2 + kstep; const char* b3 = b2 + kstep;
            if (last && has_next) S.a_ready(nxt);
            if constexpr (SP2) {
            PG8_LDB(B0, 0, 0); PG8_LDB(B1, 0, 1); PG8_SCHED; PG8_LDA(At, 0, 0); PG8_STAGE(PG8_SA(1, 1), a1 + hstep, voffA);
            PG8_WAIT_V(8); PG8_WAIT_L(0); PG8_BAR; PG8_MMA(0, 0, At, B0); PG8_MMA(0, 1, At, B1); PG8_BAR; PG8_SCHED;
            PG8_LDA(At, 0, 1); PG8_STAGE(PG8_SB(0, 0), b2, voffB); PG8_STAGE(PG8_SB(0, 1), b2 + hstep, voffB); PG8_STAGE(PG8_SA(0, 0), a2, voffA);
            PG8_WAIT_V(8); PG8_WAIT_L(0); PG8_BAR; PG8_MMA(1, 0, At, B0); PG8_MMA(1, 1, At, B1); PG8_BAR; PG8_SCHED;
            PG8_LDB(B0, 1, 0); PG8_LDB(B1, 1, 1); PG8_SCHED; PG8_LDA(At, 1, 0); PG8_STAGE(PG8_SA(0, 1), a2 + hstep, voffA);
            PG8_WAIT_V(8); PG8_WAIT_L(0); PG8_BAR; PG8_MMA(0, 0, At, B0); PG8_MMA(0, 1, At, B1); PG8_BAR; PG8_SCHED;
            PG8_LDA(At, 1, 1); PG8_STAGE(PG8_SB(1, 0), b3, voffB); PG8_STAGE(PG8_SB(1, 1), b3 + hstep, voffB); PG8_STAGE(PG8_SA(1, 0), a3, voffA);
            PG8_WAIT_V(8); PG8_WAIT_L(0); PG8_BAR; PG8_MMA(1, 0, At, B0); PG8_MMA(1, 1, At, B1); PG8_BAR; PG8_SCHED;
            } else {
            PG8_LDB(B0, 0, 0); PG8_SCHED; PG8_LDA(At, 0, 0); PG8_STAGE(PG8_SA(1, 1), a1 + hstep, voffA);
            PG8_WAIT_L(8); PG8_BAR; PG8_WAIT_L(0); PG8_MMA(0, 0, At, B0); PG8_BAR; PG8_SCHED;
            PG8_LDB(B1, 0, 1); PG8_STAGE(PG8_SB(0, 0), b2, voffB);
            PG8_BAR; PG8_WAIT_L(0); PG8_MMA(0, 1, At, B1); PG8_BAR;
            PG8_LDA(At, 0, 1); PG8_STAGE(PG8_SA(0, 0), a2, voffA);
            PG8_BAR; PG8_WAIT_L(0); PG8_MMA(1, 0, At, B0); PG8_BAR; PG8_SCHED;
            PG8_STAGE(PG8_SB(0, 1), b2 + hstep, voffB);
            PG8_WAIT_V(6); PG8_BAR; PG8_MMA(1, 1, At, B1); PG8_BAR;
            PG8_LDB(B0, 1, 0); PG8_SCHED; PG8_LDA(At, 1, 0); PG8_STAGE(PG8_SA(0, 1), a2 + hstep, voffA);
            PG8_WAIT_L(8); PG8_BAR; PG8_WAIT_L(0); PG8_MMA(0, 0, At, B0); PG8_BAR; PG8_SCHED;
            PG8_LDB(B1, 1, 1); PG8_STAGE(PG8_SB(1, 0), b3, voffB);
            PG8_BAR; PG8_WAIT_L(0); PG8_MMA(0, 1, At, B1); PG8_BAR;
            PG8_LDA(At, 1, 1); PG8_STAGE(PG8_SA(1, 0), a3, voffA);
            PG8_BAR; PG8_WAIT_L(0); PG8_MMA(1, 0, At, B0); PG8_BAR; PG8_SCHED;
            PG8_STAGE(PG8_SB(1, 1), b3 + hstep, voffB);
            PG8_WAIT_V(6); PG8_BAR; PG8_MMA(1, 1, At, B1); PG8_BAR;
            }
        }
        if constexpr (ALIGN_EPI) { if (wr == 0) PG8_BAR; }
        if constexpr (!Epi::AFTER_DRAIN) { E(acc, cur, wr, wc, fr, fq); S.done(cur); }
        if (!has_next) break;
#pragma unroll
        for (int a = 0; a < 2; ++a)
#pragma unroll
            for (int b = 0; b < 2; ++b)
#pragma unroll
                for (int m = 0; m < 4; ++m)
#pragma unroll
                    for (int n = 0; n < 2; ++n) acc[a][b][m][n] = (f32x4){0.f, 0.f, 0.f, 0.f};
        cur = nxt; cA = nA; cB = nB; ++ui;
        if constexpr (ALIGN_EPI) { if (wr == 1) PG8_BAR; }
    }
    PG8_WAIT_V(0);
    if constexpr (!ALIGN_EPI) { if (wr == 0) PG8_BAR; }
    PG8_BAR;
    if constexpr (Epi::AFTER_DRAIN) { E.fused(acc, cur, wr, wc, fr, fq, lds, wid, lane); S.done(cur); }
#undef PG8_SA
#undef PG8_SB
#undef PG8_STAGE
#undef PG8_LDA
#undef PG8_LDB
#undef PG8_MMA
#undef PG8_WAIT_V
#undef PG8_WAIT_L
#undef PG8_BAR
#undef PG8_SCHED
}
template <class Epi, class Sched>
__device__ __forceinline__ void gemm_phase_g(PG8_LAS unsigned char* lds, const Gemm g, const Sched& S, const Epi& E) {
    int tid_ = threadIdx.x; asm volatile("" : "+v"(tid_));
    const int tid = tid_, wid = __builtin_amdgcn_readfirstlane(tid >> 6), lane = tid & 63, wr = wid >> 2, wc = wid & 3, fr = lane & 15, fq = lane >> 4;
    const int K = g.K, nt = K / BK;
    unsigned voffA[2], voffB[2];
#pragma unroll
    for (int i = 0; i < 2; ++i) { int R, C; stage_rc(tid * 16 + i * 8192, R, C); const int Rb = Epi::PERM ? ((R & ~31) + perm32(R & 31)) : R;
        voffA[i] = (unsigned)(R * K + C) * 2u; voffB[i] = (unsigned)(Rb * K + C) * 2u; }
    const size_t kstep = (size_t)(BK * 2);
    const size_t hstep = (size_t)HALF * K * 2;
    const size_t tstep = 2 * hstep;
    const unsigned ldsw = (unsigned)wid * 1024u;
    const int aoff = lds_byte(wr * 64 + fr, fq * 8), boff = lds_byte(wc * 32 + fr, fq * 8);
#define PG8_SA(b, h) (((b) * 2 + (h)) * HTB)
#define PG8_SB(b, h) ((4 + (b) * 2 + (h)) * HTB)
#define PG8_STAGE(bufoff, gbase, voff) do { _Pragma("unroll") for (int _i = 0; _i < 2; ++_i) \
        __builtin_amdgcn_global_load_lds((const unsigned*)((const char*)(gbase) + (voff)[_i]), (PG8_LAS unsigned*)(lds + (bufoff) + ldsw + _i * 8192), 16, 0, 0); } while (0)
#define PG8_STAGE_A(bufoff, kt, o) do { _Pragma("unroll") for (int _i = 0; _i < 2; ++_i) \
        __builtin_amdgcn_global_load_lds((const unsigned*)((const char*)g.A + (size_t)(kt) * kstep + (o)[_i]), (PG8_LAS unsigned*)(lds + (bufoff) + ldsw + _i * 8192), 16, 0, 0); } while (0)
#define PG8_LDA(dst, b, h) do { _Pragma("unroll") for (int m = 0; m < 4; ++m) _Pragma("unroll") for (int k = 0; k < 2; ++k) dst[m][k] = *(const PG8_LAS bf16x8*)(lds + PG8_SA(b, h) + aoff + m * 2048 + k * 1024); } while (0)
#define PG8_LDB(dst, b, h) do { _Pragma("unroll") for (int n = 0; n < 2; ++n) _Pragma("unroll") for (int k = 0; k < 2; ++k) dst[n][k] = *(const PG8_LAS bf16x8*)(lds + PG8_SB(b, h) + boff + n * 2048 + k * 1024); } while (0)
#define PG8_MMA(ai, bj, At, Bt) do { __builtin_amdgcn_s_setprio(1); _Pragma("unroll") for (int m = 0; m < 4; ++m) _Pragma("unroll") for (int n = 0; n < 2; ++n) _Pragma("unroll") for (int k = 0; k < 2; ++k) \
        acc[ai][bj][m][n] = __builtin_amdgcn_mfma_f32_16x16x32_bf16(Bt[n][k], At[m][k], acc[ai][bj][m][n], 0, 0, 0); __builtin_amdgcn_s_setprio(0); } while (0)
#define PG8_WAIT_V(n) asm volatile("s_waitcnt vmcnt(" #n ")" ::: "memory")
#define PG8_WAIT_L(n) asm volatile("s_waitcnt lgkmcnt(" #n ")" ::: "memory")
#define PG8_BAR __builtin_amdgcn_s_barrier()
#define PG8_SCHED __builtin_amdgcn_sched_barrier(0)
    Unit cur, nxt; int ui = 0;
    if (!S.next(0, cur)) return;
    f32x4 acc[2][2][4][2];
#pragma unroll
    for (int a = 0; a < 2; ++a)
#pragma unroll
        for (int b = 0; b < 2; ++b)
#pragma unroll
            for (int m = 0; m < 4; ++m)
#pragma unroll
                for (int n = 0; n < 2; ++n) acc[a][b][m][n] = (f32x4){0.f, 0.f, 0.f, 0.f};
    bf16x8 At[4][2], B0[2][2], B1[2][2];
    const char* cB = (const char*)g.Bt + (size_t)cur.pn * tstep;
    S.a_ready(cur);
    int R0_, C0_; stage_rc(tid * 16, R0_, C0_);
    unsigned oc[2][2], on[2][2];
    S.a_offsets(cur, R0_, C0_ * 2, K, oc);
    if constexpr (true) {
        PG8_STAGE(PG8_SB(0, 0), cB, voffB); PG8_STAGE(PG8_SB(0, 1), cB + hstep, voffB); PG8_STAGE_A(PG8_SA(0, 0), 0, oc[0]); PG8_STAGE_A(PG8_SA(0, 1), 0, oc[1]);
        if (wr == 1) PG8_BAR;
        PG8_WAIT_V(2); PG8_BAR;
        PG8_STAGE(PG8_SB(1, 0), cB + kstep, voffB); PG8_STAGE_A(PG8_SA(1, 0), 1, oc[0]); PG8_STAGE(PG8_SB(1, 1), cB + hstep + kstep, voffB);
        PG8_WAIT_V(6); PG8_BAR;
    }
    for (;;) {
        const bool has_next = S.next(ui + 1, nxt);
        const char* nB = has_next ? (const char*)g.Bt + (size_t)nxt.pn * tstep : cB;
        if (has_next) S.a_offsets(nxt, R0_, C0_ * 2, K, on); else { on[0][0] = oc[0][0]; on[0][1] = oc[0][1]; on[1][0] = oc[1][0]; on[1][1] = oc[1][1]; }
        for (int t = 0; t < nt; t += 2) {
            const bool last = (t == nt - 2);
            const char* b2 = last ? nB : cB + (size_t)(t + 2) * kstep;
            const char* b3 = b2 + kstep;
            const int kt2 = last ? 0 : t + 2;
            unsigned o2[2][2];
            o2[0][0] = last ? on[0][0] : oc[0][0]; o2[0][1] = last ? on[0][1] : oc[0][1]; o2[1][0] = last ? on[1][0] : oc[1][0]; o2[1][1] = last ? on[1][1] : oc[1][1];
            if (last && has_next) S.a_ready(nxt);
            if constexpr (true) {
            PG8_LDB(B0, 0, 0); PG8_LDB(B1, 0, 1); PG8_SCHED; PG8_LDA(At, 0, 0); PG8_STAGE_A(PG8_SA(1, 1), t + 1, oc[1]);
            PG8_WAIT_V(8); PG8_WAIT_L(0); PG8_BAR; PG8_MMA(0, 0, At, B0); PG8_MMA(0, 1, At, B1); PG8_BAR; PG8_SCHED;
            PG8_LDA(At, 0, 1); PG8_STAGE(PG8_SB(0, 0), b2, voffB); PG8_STAGE(PG8_SB(0, 1), b2 + hstep, voffB); PG8_STAGE_A(PG8_SA(0, 0), kt2, o2[0]);
            PG8_WAIT_V(8); PG8_WAIT_L(0); PG8_BAR; PG8_MMA(1, 0, At, B0); PG8_MMA(1, 1, At, B1); PG8_BAR; PG8_SCHED;
            PG8_LDB(B0, 1, 0); PG8_LDB(B1, 1, 1); PG8_SCHED; PG8_LDA(At, 1, 0); PG8_STAGE_A(PG8_SA(0, 1), kt2, o2[1]);
            PG8_WAIT_V(8); PG8_WAIT_L(0); PG8_BAR; PG8_MMA(0, 0, At, B0); PG8_MMA(0, 1, At, B1); PG8_BAR; PG8_SCHED;
            PG8_LDA(At, 1, 1); PG8_STAGE(PG8_SB(1, 0), b3, voffB); PG8_STAGE(PG8_SB(1, 1), b3 + hstep, voffB); PG8_STAGE_A(PG8_SA(1, 0), kt2 + 1, o2[0]);
            PG8_WAIT_V(8); PG8_WAIT_L(0); PG8_BAR; PG8_MMA(1, 0, At, B0); PG8_MMA(1, 1, At, B1); PG8_BAR; PG8_SCHED;
            }
        }
        if constexpr (true) { if (wr == 0) PG8_BAR; }
        if constexpr (!Epi::AFTER_DRAIN) { E(acc, cur, wr, wc, fr, fq); S.done(cur); }
        if (!has_next) break;
#pragma unroll
        for (int a = 0; a < 2; ++a)
#pragma unroll
            for (int b = 0; b < 2; ++b)
#pragma unroll
                for (int m = 0; m < 4; ++m)
#pragma unroll
                    for (int n = 0; n < 2; ++n) acc[a][b][m][n] = (f32x4){0.f, 0.f, 0.f, 0.f};
        cur = nxt; cB = nB; ++ui; oc[0][0] = on[0][0]; oc[0][1] = on[0][1]; oc[1][0] = on[1][0]; oc[1][1] = on[1][1];
        if constexpr (true) { if (wr == 1) PG8_BAR; }
    }
    PG8_WAIT_V(0);
    if constexpr (false) { if (wr == 0) PG8_BAR; }
    PG8_BAR;
    if constexpr (Epi::AFTER_DRAIN) { E.fused(acc, cur, wr, wc, fr, fq, lds, wid, lane); S.done(cur); }
#undef PG8_SA
#undef PG8_SB
#undef PG8_STAGE
#undef PG8_STAGE_A
#undef PG8_LDA
#undef PG8_LDB
#undef PG8_MMA
#undef PG8_WAIT_V
#undef PG8_WAIT_L
#undef PG8_BAR
#undef PG8_SCHED
}
}

#define PG8_SP2 true
#define PG8_ALIGN true
template <class RowMap>
__device__ __forceinline__ void transpose_item(const float* W, int K, int N, bf16* WT, const RowMap& rm, LAS float* scr, int item, int lane) {
    const int nblk = N / 32, kb = item / nblk, nb = item % nblk, k0 = 64 * kb, n0 = 32 * nb;
    {
        f32x4 v[8];
#pragma unroll
        for (int i = 0; i < 8; ++i) v[i] = *(const f32x4*)(W + (size_t)(k0 + 8 * i + (lane >> 3)) * N + n0 + 4 * (lane & 7));
#pragma unroll
        for (int i = 0; i < 8; ++i) { LAS float* d = scr + (8 * i + (lane >> 3)) * 33 + 4 * (lane & 7); d[0] = v[i][0]; d[1] = v[i][1]; d[2] = v[i][2]; d[3] = v[i][3]; }
    }
    asm volatile("s_waitcnt lgkmcnt(0)" ::: "memory");
    const int c = lane & 7;
#pragma unroll
    for (int j = 0; j < 4; ++j) { const int n = (lane >> 3) + 8 * j; const LAS float* sp = scr + (8 * c) * 33 + n;
        v4u o; o.x = pk2(sp[0 * 33], sp[1 * 33]); o.y = pk2(sp[2 * 33], sp[3 * 33]); o.z = pk2(sp[4 * 33], sp[5 * 33]); o.w = pk2(sp[6 * 33], sp[7 * 33]);
        *(v4u*)(WT + (size_t)rm(n0 + n) * K + k0 + 8 * c) = o; }
    asm volatile("s_waitcnt lgkmcnt(0)" ::: "memory");
}
struct RowId { __device__ __forceinline__ int operator()(int n) const { return n; } };
struct RowGU { int off; __device__ __forceinline__ int operator()(int n) const { return 256 * (n >> 7) + (n & 127) + off; } };
__device__ __forceinline__ void conv_small_weights(const Ctx& c) {
    LAS float* scr = (LAS float*)c.lds + c.wave * 4096;
    constexpr int I_IN = (D / 64) * (DIN / 32), I_OUT = (D / 64) * (D / 32);
    for (int it = c.gw; it < I_IN + I_OUT; it += c.NGW) {
        if (it < I_IN) transpose_item(inp(c, 10), D, DIN, (bf16*)(c.ws + WS_WIN_T), RowId{}, scr, it, c.lane);
        else transpose_item(inp(c, 23), D, D, (bf16*)(c.ws + WS_WOUT_T), RowId{}, scr, it - I_IN, c.lane);
    }
}
__device__ __forceinline__ void conv_moe_weights(const Ctx& c) {
    LAS float* scr = (LAS float*)c.lds + c.wave * 4096;
    constexpr int I_G = (D / 64) * (DE / 32), I_D = (DE / 64) * (D / 32), PER_E = 2 * I_G + I_D;
    for (int it = c.gw; it < NE * PER_E; it += c.NGW) {
        const int e = it / PER_E; int r = it % PER_E;
        bf16* gu = (bf16*)(c.ws + WS_WGU_T) + (size_t)e * 1024 * 1024; bf16* dn = (bf16*)(c.ws + WS_WD_T) + (size_t)e * 1024 * 512;
        if (r < I_G) { transpose_item(inp(c, 28) + (size_t)e * D * DE, D, DE, gu, RowGU{0}, scr, r, c.lane); continue; } r -= I_G;
        if (r < I_G) { transpose_item(inp(c, 29) + (size_t)e * D * DE, D, DE, gu, RowGU{128}, scr, r, c.lane); continue; } r -= I_G;
        transpose_item(inp(c, 30) + (size_t)e * DE * D, DE, D, dn, RowId{}, scr, r, c.lane);
    }
}
__device__ __forceinline__ v4u pack8(const f32x4 a, const f32x4 b) { v4u w; w.x = pg8::cvt_pk_bf16(a[0], a[1]); w.y = pg8::cvt_pk_bf16(a[2], a[3]); w.z = pg8::cvt_pk_bf16(b[0], b[1]); w.w = pg8::cvt_pk_bf16(b[2], b[3]); return w; }
struct EpiProj {
    static constexpr bool PERM = true, AFTER_DRAIN = false;
    unsigned char* ws;
    __device__ __forceinline__ void operator()(const f32x4 (&acc)[2][2][4][2], const pg8::Unit& un, int wr, int wc, int fr, int fq) const {
        const int colt = un.pn * 256, reg = colt >> 9;
        const size_t off = WS_XM + (size_t)(reg & 1) * (WS_Z - WS_XM) + (size_t)(reg >> 1) * (WS_U - WS_XM);
        bf16* base = (bf16*)(ws + off);
        const int lc0 = (colt & 511) + wc * 32 + 8 * fq, row0 = un.pm * 256 + wr * 64 + fr;
#pragma unroll
        for (int ai = 0; ai < 2; ++ai)
#pragma unroll
            for (int m = 0; m < 4; ++m) { bf16* rowp = base + (size_t)(row0 + ai * 128 + m * 16) * DM + lc0;
#pragma unroll
                for (int bj = 0; bj < 2; ++bj) *(v4u*)(rowp + bj * 128) = pack8(acc[ai][bj][m][0], acc[ai][bj][m][1]); }
    }
};
struct EpiY {
    static constexpr bool PERM = false, AFTER_DRAIN = false;
    float* Y;
    __device__ __forceinline__ void operator()(const f32x4 (&acc)[2][2][4][2], const pg8::Unit& un, int wr, int wc, int fr, int fq) const {
        const int row0 = un.pm * 256 + wr * 64 + fr, col0 = un.pn * 256 + wc * 32 + 4 * fq;
#pragma unroll
        for (int ai = 0; ai < 2; ++ai)
#pragma unroll
            for (int m = 0; m < 4; ++m) { float* rowp = Y + (size_t)(row0 + ai * 128 + m * 16) * D + col0;
#pragma unroll
                for (int bj = 0; bj < 2; ++bj)
#pragma unroll
                    for (int n = 0; n < 2; ++n) *(f32x4*)(rowp + bj * 128 + n * 16) = acc[ai][bj][m][n]; }
    }
};
struct EpiSwiGLU {
    static constexpr bool PERM = true, AFTER_DRAIN = false;
    bf16* act; const float* roww; const volatile LAS int* ts;
    __device__ __forceinline__ void operator()(const f32x4 (&acc)[2][2][4][2], const pg8::Unit& un, int wr, int wc, int fr, int fq) const {
        const int e = un.pn >> 2, row0 = un.pm * 256 + wr * 64 + fr, col0 = (un.pn & 3) * 128 + wc * 32 + 8 * fq, slot0 = (un.pm - ts[e]) * 256 + wr * 64 + fr, cnt = ts[17 + e];
#pragma unroll
        for (int ai = 0; ai < 2; ++ai)
#pragma unroll
            for (int m = 0; m < 4; ++m) { const int row = row0 + ai * 128 + m * 16, slot = slot0 + ai * 128 + m * 16; const float w = slot < cnt ? roww[(size_t)e * T + slot] : 0.f;
                f32x4 o[2];
#pragma unroll
                for (int n = 0; n < 2; ++n)
#pragma unroll
                    for (int i = 0; i < 4; ++i) { const float g = acc[ai][0][m][n][i], uu = acc[ai][1][m][n][i]; o[n][i] = siluf(g) * uu * w; }
                *(v4u*)(act + (size_t)row * DE + col0) = pack8(o[0], o[1]); }
    }
};
struct EpiDown {
    static constexpr bool PERM = true, AFTER_DRAIN = false;
    bf16* yrow;
    __device__ __forceinline__ void operator()(const f32x4 (&acc)[2][2][4][2], const pg8::Unit& un, int wr, int wc, int fr, int fq) const {
        const int row0 = un.pm * 256 + wr * 64 + fr, col0 = (un.pn & 3) * 256 + wc * 32 + 8 * fq;
#pragma unroll
        for (int ai = 0; ai < 2; ++ai)
#pragma unroll
            for (int m = 0; m < 4; ++m) { bf16* rowp = yrow + (size_t)(row0 + ai * 128 + m * 16) * D + col0;
#pragma unroll
                for (int bj = 0; bj < 2; ++bj) *(v4u*)(rowp + bj * 128) = pack8(acc[ai][bj][m][0], acc[ai][bj][m][1]); }
    }
};
struct MoeOrder {
    int G, c; const volatile LAS int* ts; const int* rowtok;
    __device__ __forceinline__ bool next(int i, pg8::Unit& u) const {
        const int L = i * G + c; if (L >= ts[16] * 4) return false;
        const int mt = L >> 2; int e = 0;
#pragma unroll
        for (int j = 1; j < 16; ++j) e += (mt >= ts[j]) ? 1 : 0;
        u.pm = mt; u.pn = e * 4 + (L & 3); return true;
    }
    __device__ __forceinline__ void a_offsets(const pg8::Unit& u, int R0, int Cb, int K, unsigned (&o)[2][2]) const {
        const int e = u.pn >> 2, base = (u.pm - ts[e]) * 256 + R0, cnt = ts[17 + e];
#pragma unroll
        for (int h = 0; h < 2; ++h)
#pragma unroll
            for (int i = 0; i < 2; ++i) { const int slot = base + 128 * h + 64 * i; const int tok = slot < cnt ? rowtok[(size_t)e * T + slot] : 0; o[h][i] = (unsigned)tok * (unsigned)(K * 2) + (unsigned)Cb; }
    }
    __device__ __forceinline__ void a_ready(const pg8::Unit&) const {}
    __device__ __forceinline__ void done(const pg8::Unit&) const {}
};
__device__ __forceinline__ int vcu_of(const Ctx& c) { return (c.G % 8 == 0) ? (c.bid % 8) * (c.G / 8) + c.bid / 8 : c.bid; }
__device__ __forceinline__ void moe_tile_table(const Ctx& c, volatile LAS int* ts) {
    if (c.tid == 0) {
        const unsigned* cnt = (const unsigned*)(c.ws + WS_CTL) + CW_CNT; int acc = 0;
        for (int e = 0; e < 16; ++e) { const unsigned n = __hip_atomic_load(cnt + e, __ATOMIC_RELAXED, __HIP_MEMORY_SCOPE_AGENT); ts[e] = acc; ts[17 + e] = (int)n; acc += (int)((n + 255u) >> 8); }
        ts[16] = acc;
    }
    __syncthreads();
}

__device__ __forceinline__ void g1_gemm1(const Ctx& c) {
    pg8::Gemm g{(const bf16*)(c.ws + WS_H), (const bf16*)(c.ws + WS_WIN_T), NT, DIN, D};
    pg8::StaticOrder S; S.init(NT, DIN, c.G, c.bid);
    EpiProj E{c.ws};
    pg8::gemm_phase<EpiProj, pg8::StaticOrder, PG8_ALIGN, PG8_SP2>((LAS unsigned char*)c.lds, g, S, E);
}
__device__ __forceinline__ void g2_outproj(const Ctx& c) {
    pg8::Gemm g{(const bf16*)(c.ws + WS_H), (const bf16*)(c.ws + WS_WOUT_T), T, D, D};
    pg8::StaticOrder S; S.init(T, D, c.G, c.bid);
    EpiY E{(float*)(c.ws + WS_Y)};
    pg8::gemm_phase<EpiY, pg8::StaticOrder, PG8_ALIGN, PG8_SP2>((LAS unsigned char*)c.lds, g, S, E);
}
__device__ __forceinline__ void g3_moe_up(const Ctx& c, volatile LAS int* ts) {
    moe_tile_table(c, ts);
    pg8::Gemm g{(const bf16*)(c.ws + WS_H), (const bf16*)(c.ws + WS_WGU_T), 0, 0, D};
    MoeOrder S{c.G, vcu_of(c), ts, (const int*)(c.ws + WS_ROWTOK)};
    EpiSwiGLU E{(bf16*)(c.ws + WS_ACTS), (const float*)(c.ws + WS_ROWW), ts};
    pg8::gemm_phase_g<EpiSwiGLU, MoeOrder>((LAS unsigned char*)c.lds, g, S, E);
}
__device__ __forceinline__ void g4_moe_down(const Ctx& c, volatile LAS int* ts) {
    moe_tile_table(c, ts);
    pg8::Gemm g{(const bf16*)(c.ws + WS_ACTS), (const bf16*)(c.ws + WS_WD_T), 0, 0, DE};
    MoeOrder S{c.G, vcu_of(c), ts, (const int*)(c.ws + WS_ROWTOK)};
    EpiDown E{(bf16*)(c.ws + WS_YROW)};
    pg8::gemm_phase<EpiDown, MoeOrder, PG8_ALIGN, PG8_SP2>((LAS unsigned char*)c.lds, g, S, E);
}

__device__ __forceinline__ void p10b_token(const Ctx& c) {
    const float* x = inp(c, 0); const float* g_post = inp(c, 7); const float* g_ffn = inp(c, 8);
    const float* wrg = inp(c, 24); const float* brg = inp(c, 25); const float* wre = inp(c, 26); const float* bre = inp(c, 27);
    const float* mod = (const float*)(c.ws + WS_MOD);
    const float* posR = (const float*)(c.ws + WS_POSR); const float* posC = (const float*)(c.ws + WS_POSC);
    const float* Y = (const float*)(c.ws + WS_Y); bf16* H2 = (bf16*)(c.ws + WS_H); int* RE = (int*)(c.ws + WS_RE); int* RS = (int*)(c.ws + WS_RS);
    unsigned* CNT = (unsigned*)(c.ws + WS_CTL) + CW_CNT;
    constexpr int WRS = 1028;
    LAS float* WRt = (LAS float*)c.lds;
    int* hist = (int*)(c.lds + 20 * WRS); int* gbase = hist + 16; int* tinfo = hist + 32;
    for (int idx = c.tid; idx < 1024 * 20; idx += NTHREADS) {
        const int col = idx / 20, o = idx % 20;
        WRt[o * WRS + col] = o < 4 ? wrg[col * 4 + o] : wre[col * 16 + (o - 4)];
    }
    if (c.tid < 32) hist[c.tid] = 0;
    __syncthreads();
    int li = 0;
    for (int r = c.gw; r < T; r += c.NGW, ++li) {
        asm volatile("" ::: "memory");
        f32x4 xv[4], yv[4]; float ss = 0.f;
#pragma unroll
        for (int j = 0; j < 4; ++j) {
            const int col = 256 * j + 4 * c.lane;
            const float* pp = col < 512 ? posR + (r >> 6) * 512 + col : posC + (r & 63) * 512 + (col - 512);
            xv[j] = *(const f32x4*)(x + (size_t)r * D + col) + *(const f32x4*)pp;
            yv[j] = *(const f32x4*)(Y + (size_t)r * D + col);
            ss += yv[j].x * yv[j].x + yv[j].y * yv[j].y + yv[j].z * yv[j].z + yv[j].w * yv[j].w;
        }
        const float rinv = rsqrtf(wave_sum(ss) * (1.f / D) + EPS);
        float s2 = 0.f;
#pragma unroll
        for (int j = 0; j < 4; ++j) {
            const int col = 256 * j + 4 * c.lane;
            const f32x4 gg = *(const f32x4*)(g_post + col), g1 = *(const f32x4*)(mod + 2048 + col);
            xv[j] = xv[j] + g1 * (yv[j] * rinv * gg);
            *(f32x4*)(c.out + (size_t)r * D + col) = xv[j];
            s2 += xv[j].x * xv[j].x + xv[j].y * xv[j].y + xv[j].z * xv[j].z + xv[j].w * xv[j].w;
        }
        const float rinv2 = rsqrtf(wave_sum(s2) * (1.f / D) + EPS);
        float lg[20];
#pragma unroll
        for (int i = 0; i < 20; ++i) lg[i] = 0.f;
#pragma unroll
        for (int j = 0; j < 4; ++j) {
            const int col = 256 * j + 4 * c.lane;
            const f32x4 gg = *(const f32x4*)(g_ffn + col), sh = *(const f32x4*)(mod + 3072 + col), sc = *(const f32x4*)(mod + 4096 + col);
            const f32x4 hv = xv[j] * rinv2 * gg * (sc + 1.f) + sh;
            uint2 w; w.x = pk2(hv.x, hv.y); w.y = pk2(hv.z, hv.w);
            *(uint2*)(H2 + (size_t)r * D + col) = w;
#pragma unroll
            for (int o = 0; o < 20; ++o) { const f32x4 w4 = *(const LAS f32x4*)(WRt + o * WRS + col); lg[o] += hv.x * w4.x + hv.y * w4.y + hv.z * w4.z + hv.w * w4.w; }
        }
#pragma unroll
        for (int i = 0; i < 20; ++i) lg[i] = wave_sum(lg[i]);
        if (c.lane == 0) {
            float gl[4];
#pragma unroll
            for (int i = 0; i < 4; ++i) gl[i] = lg[i] + brg[i];
            int gs = 0; float gm = gl[0];
#pragma unroll
            for (int i = 1; i < 4; ++i) if (gl[i] > gm) { gm = gl[i]; gs = i; }
            float den = 0.f;
#pragma unroll
            for (int i = 0; i < 4; ++i) den += __expf(gl[i] - gm);
            const float psel = 1.f / den;
            float el[4];
#pragma unroll
            for (int i = 0; i < 4; ++i) {
                float v = 0.f;
#pragma unroll
                for (int g2 = 0; g2 < 4; ++g2) v = (g2 == gs) ? lg[4 + g2 * 4 + i] + bre[g2 * 4 + i] : v;
                el[i] = v;
            }
            int i1 = 0; float em1 = el[0];
#pragma unroll
            for (int i = 1; i < 4; ++i) if (el[i] > em1) { em1 = el[i]; i1 = i; }
            int i2 = -1; float em2 = -INFINITY;
#pragma unroll
            for (int i = 0; i < 4; ++i) if (i != i1 && el[i] > em2) { em2 = el[i]; i2 = i; }
            const float e2 = __expf(em2 - em1), w1 = psel / (1.f + e2), w2 = psel * e2 / (1.f + e2);
            const int ea = gs * 4 + i1, eb = gs * 4 + i2;
            RE[2 * r] = ea; RE[2 * r + 1] = eb;
            int* ti = tinfo + (c.wave * 8 + li) * 8;
            ti[0] = ea; ti[1] = eb; ti[2] = atomicAdd(hist + ea, 1); ti[3] = atomicAdd(hist + eb, 1); ti[4] = __float_as_int(w1); ti[5] = __float_as_int(w2);
        }
    }
    __syncthreads();
    if (c.tid < 16) gbase[c.tid] = (int)__hip_atomic_fetch_add(CNT + c.tid, (unsigned)hist[c.tid], __ATOMIC_RELAXED, __HIP_MEMORY_SCOPE_AGENT);
    __syncthreads();
    if (c.lane < li) {
        const int r = c.gw + c.lane * c.NGW; const int* ti = tinfo + (c.wave * 8 + c.lane) * 8;
        const int s0 = gbase[ti[0]] + ti[2], s1 = gbase[ti[1]] + ti[3];
        RS[2 * r] = s0; RS[2 * r + 1] = s1;
        int* ROWTOK = (int*)(c.ws + WS_ROWTOK); float* ROWW = (float*)(c.ws + WS_ROWW);
        ROWTOK[(size_t)ti[0] * T + s0] = r; ROWTOK[(size_t)ti[1] * T + s1] = r; ROWW[(size_t)ti[0] * T + s0] = __int_as_float(ti[4]); ROWW[(size_t)ti[1] * T + s1] = __int_as_float(ti[5]);
    }
    __syncthreads();
}
__device__ __forceinline__ void p10c_scatter(const Ctx& c) {
    const bf16* H2 = (const bf16*)(c.ws + WS_H); bf16* AS = (bf16*)(c.ws + WS_ASORT);
    const int* RE = (const int*)(c.ws + WS_RE); const float* RW = (const float*)(c.ws + WS_RW); int* RS = (int*)(c.ws + WS_RS); float* ROWW = (float*)(c.ws + WS_ROWW);
    const unsigned* CNT = (const unsigned*)(c.ws + WS_CTL) + CW_CNT;
    for (int r = c.gw; r < T; r += c.NGW) {
        asm volatile("" ::: "memory");
        const int e0 = RE[2 * r], e1 = RE[2 * r + 1]; int b0 = 0, b1 = 0;
        for (int e = 0; e < 16; ++e) { const int tl = (int)((CNT[e] + 255u) >> 8) * 256; b0 += e < e0 ? tl : 0; b1 += e < e1 ? tl : 0; }
        const int r0 = b0 + RS[2 * r], r1 = b1 + RS[2 * r + 1];
        const v4u* src = (const v4u*)(H2 + (size_t)r * D);
        const v4u a = src[c.lane], b = src[c.lane + 64];
        v4u* d0 = (v4u*)(AS + (size_t)r0 * D); v4u* d1 = (v4u*)(AS + (size_t)r1 * D);
        d0[c.lane] = a; d0[c.lane + 64] = b; d1[c.lane] = a; d1[c.lane + 64] = b;
        if (c.lane == 0) { ROWW[r0] = RW[2 * r]; ROWW[r1] = RW[2 * r + 1]; RS[2 * r] = r0; RS[2 * r + 1] = r1; }
    }
}
__device__ __forceinline__ void p12b_final(const Ctx& c) {
    const float* g_post = inp(c, 9); const float* mod = (const float*)(c.ws + WS_MOD); const bf16* YR = (const bf16*)(c.ws + WS_YROW); const int* RS = (const int*)(c.ws + WS_RS);
    const int* RE = (const int*)(c.ws + WS_RE); const unsigned* CNT = (const unsigned*)(c.ws + WS_CTL) + CW_CNT;
    for (int r = c.gw; r < T; r += c.NGW) {
        asm volatile("" ::: "memory");
        const int e0 = RE[2 * r], e1 = RE[2 * r + 1]; int b0 = 0, b1 = 0;
#pragma unroll
        for (int e = 0; e < 16; ++e) { const int tl = (int)((CNT[e] + 255u) >> 8) * 256; b0 += e < e0 ? tl : 0; b1 += e < e1 ? tl : 0; }
        const int r0 = b0 + RS[2 * r], r1 = b1 + RS[2 * r + 1];
        f32x4 yv[4]; float ss = 0.f;
#pragma unroll
        for (int j = 0; j < 4; ++j) {
            const int col = 256 * j + 4 * c.lane;
            const uint2 a = *(const uint2*)(YR + (size_t)r0 * D + col), b = *(const uint2*)(YR + (size_t)r1 * D + col);
            yv[j] = (f32x4){lo16(a.x) + lo16(b.x), hi16(a.x) + hi16(b.x), lo16(a.y) + lo16(b.y), hi16(a.y) + hi16(b.y)};
            ss += yv[j].x * yv[j].x + yv[j].y * yv[j].y + yv[j].z * yv[j].z + yv[j].w * yv[j].w;
        }
        const float rinv = rsqrtf(wave_sum(ss) * (1.f / D) + EPS);
#pragma unroll
        for (int j = 0; j < 4; ++j) {
            const int col = 256 * j + 4 * c.lane;
            const f32x4 gg = *(const f32x4*)(g_post + col), g2 = *(const f32x4*)(mod + 5120 + col);
            f32x4* o = (f32x4*)(c.out + (size_t)r * D + col);
            *o = *o + g2 * (yv[j] * rinv * gg);
        }
    }
}


typedef unsigned v2u __attribute__((ext_vector_type(2)));
typedef short s16x4 __attribute__((ext_vector_type(4)));
typedef short h8 __attribute__((ext_vector_type(8)));
constexpr int TSB = 288;
constexpr int TILE_B = 128 * TSB;
#define MFMA16(a, b, c) __builtin_amdgcn_mfma_f32_16x16x32_bf16((a), (b), (c), 0, 0, 0)
__device__ __forceinline__ h8 frag_row(const LAS unsigned char* tile, int stride_b, int row0, int k0, int lane) {
    return *(const LAS h8*)(tile + (row0 + (lane & 15)) * stride_b + (k0 + 8 * (lane >> 4)) * 2);
}
__device__ __forceinline__ h8 frag_tr(const LAS unsigned char* tile, int stride_b, int k0, int n0, int lane) {
    const int g = lane >> 4, q = (lane & 15) >> 2, p = lane & 3;
    const LAS unsigned char* a = tile + (k0 + 8 * g + q) * stride_b + (n0 + 4 * p) * 2;
    const s16x4 lo = __builtin_amdgcn_ds_read_tr16_b64_v4i16((LAS s16x4*)a);
    const s16x4 hi = __builtin_amdgcn_ds_read_tr16_b64_v4i16((LAS s16x4*)(a + 4 * stride_b));
    return __builtin_shufflevector(lo, hi, 0, 1, 2, 3, 4, 5, 6, 7);
}
__device__ __forceinline__ void lds_atomic_add(LAS float* p, float v) { __hip_atomic_fetch_add(p, v, __ATOMIC_RELAXED, __HIP_MEMORY_SCOPE_WORKGROUP); }


__device__ __forceinline__ void p4m_summaries(const Ctx& c) {
    const bf16* Kb = (const bf16*)(c.ws + WS_K); const bf16* Vb = (const bf16*)(c.ws + WS_V);
    const float* IG = (const float*)(c.ws + WS_IG); const float* LF = (const float*)(c.ws + WS_LF);
    float* LT = (float*)(c.ws + WS_L); float* NL = (float*)(c.ws + WS_NL); float* AMAX = (float*)(c.ws + WS_AMAX); float* BTOT = (float*)(c.ws + WS_BTOT);
    LAS unsigned char* L = (LAS unsigned char*)c.lds; LAS unsigned char* Ks = L; LAS unsigned char* Vs = L + TILE_B;
    LAS float* lfs = (LAS float*)(L + 2 * TILE_B); LAS float* as = lfs + 128; LAS float* red = as + 128;
    const int lane = c.lane, rt = c.wave >> 1, cg = c.wave & 1, fr = lane & 15, fg = lane >> 4;
    for (int it = c.bid; it < 2 * NH * NCH; it += c.G) {
        const int d = it / (NH * NCH), h = (it / NCH) % NH, j = it % NCH, r0 = chunk_row0(d, j);
        const float* lf = LF + (size_t)(d * 4 + h) * NT + r0; const float* ig = IG + (size_t)(d * 4 + h) * NT + r0;
        {
            const float lfv = c.tid < 128 ? lf[c.tid] : 0.f, igv = c.tid < 128 ? ig[c.tid] : 0.f;
            const float b = scan128<false>(lfv, d != 0, lfs, c.tid, c.lane, c.wave);
            if (c.tid == (d == 0 ? 127 : 0)) red[0] = b;
            __syncthreads();
            if (c.tid < 128) as[c.tid] = red[0] - b + igv;
        }
        __syncthreads();
        if (c.tid < 64) { float m = fmaxf(as[c.tid], as[c.tid + 64]);
#pragma unroll
            for (int o = 1; o < 64; o <<= 1) m = fmaxf(m, __shfl_xor(m, o));
            if (c.tid == 0) red[1] = m; }
        __syncthreads();
        const float amax = red[1], btot = red[0];
        for (int e = c.tid; e < 128 * 16; e += NTHREADS) {
            const int l = e >> 4, ch = e & 15; const float w = __expf(as[l] - amax);
            float f[8];
            unpack8(*(const v4u*)(Kb + (size_t)(r0 + l) * DM + h * DH + ch * 8), f);
            v4u o; o.x = pk2(f[0] * w, f[1] * w); o.y = pk2(f[2] * w, f[3] * w); o.z = pk2(f[4] * w, f[5] * w); o.w = pk2(f[6] * w, f[7] * w);
            *(LAS v4u*)(Ks + l * TSB + ch * 16) = o;
            *(LAS v4u*)(Vs + l * TSB + ch * 16) = *(const v4u*)(Vb + (size_t)(r0 + l) * DM + h * DH + ch * 8);
        }
        __syncthreads();
        f32x4 acc[2][4];
#pragma unroll
        for (int mt = 0; mt < 2; ++mt)
#pragma unroll
            for (int nt = 0; nt < 4; ++nt) acc[mt][nt] = (f32x4){0.f, 0.f, 0.f, 0.f};
#pragma unroll
        for (int ks = 0; ks < 4; ++ks) {
            h8 a[2], b[4];
#pragma unroll
            for (int mt = 0; mt < 2; ++mt) a[mt] = frag_tr(Vs, TSB, 32 * ks, 32 * rt + 16 * mt, lane);
#pragma unroll
            for (int nt = 0; nt < 4; ++nt) b[nt] = frag_tr(Ks, TSB, 32 * ks, 64 * cg + 16 * nt, lane);
#pragma unroll
            for (int mt = 0; mt < 2; ++mt)
#pragma unroll
                for (int nt = 0; nt < 4; ++nt) acc[mt][nt] = MFMA16(a[mt], b[nt], acc[mt][nt]);
        }
        float* dst = LT + (size_t)((d * 4 + h) * NCH + j) * 16384;
#pragma unroll
        for (int mt = 0; mt < 2; ++mt)
#pragma unroll
            for (int nt = 0; nt < 4; ++nt)
#pragma unroll
                for (int r = 0; r < 4; ++r) dst[(32 * rt + 16 * mt + 4 * fg + r) * 128 + 64 * cg + 16 * nt + fr] = acc[mt][nt][r];
        if (c.tid < 128) {
            float sacc = 0.f;
            for (int l = 0; l < 128; ++l) sacc += bf2f(*(const LAS bf16*)(Ks + l * TSB + c.tid * 2));
            NL[(size_t)((d * 4 + h) * NCH + j) * 128 + c.tid] = sacc;
            if (c.tid == 0) { AMAX[(d * 4 + h) * NCH + j] = amax; BTOT[(d * 4 + h) * NCH + j] = btot; }
        }
        __syncthreads();
    }
}

__device__ __forceinline__ void p8m_mlstm_out(const Ctx& c) {
    const bf16* Q = (const bf16*)(c.ws + WS_Q); const bf16* Kb = (const bf16*)(c.ws + WS_K); const bf16* Vb = (const bf16*)(c.ws + WS_V);
    const bf16* ACT = (const bf16*)(c.ws + WS_ACT); const bf16* Z = (const bf16*)(c.ws + WS_Z);
    const float* IG = (const float*)(c.ws + WS_IG); const float* LF = (const float*)(c.ws + WS_LF);
    const bf16* C0 = (const bf16*)(c.ws + WS_C0); const float* N0 = (const float*)(c.ws + WS_N0); const float* M0 = (const float*)(c.ws + WS_M0);
    const float* norm_w = inp(c, 20); const float* skip = inp(c, 21);
    bf16* A2 = (bf16*)(c.ws + WS_H);
    LAS unsigned char* L = (LAS unsigned char*)c.lds;
    LAS unsigned char* Qs = L; LAS unsigned char* Ks = L + TILE_B; LAS unsigned char* Vs = L + 2 * TILE_B; LAS unsigned char* Ss = L + 3 * TILE_B;
    LAS float* gs = (LAS float*)(L + 4 * TILE_B); LAS float* Ms = gs + 128; LAS float* wis = Ms + 128; LAS float* emt = wis + 128; LAS float* nqs = emt + 128; LAS float* qns = nqs + 128;
    LAS float* rsum = qns + 128; LAS float* rsq = rsum + 128; LAS float* lfs = rsq + 128;
    const int lane0 = c.lane, rt = c.wave >> 1, cg = c.wave & 1, fr0 = lane0 & 15, fg0 = lane0 >> 4;
    for (int it = c.bid; it < NH * NCL; it += c.G) {
        const int h = it / NCL, ck = it % NCL, r0 = ck * CH;
        for (int e = c.tid; e < 128 * 16; e += NTHREADS) {
            const int l = e >> 4, ch = e & 15; const size_t go = (size_t)(r0 + l) * DM + h * DH + ch * 8;
            *(LAS v4u*)(Qs + l * TSB + ch * 16) = *(const v4u*)(Q + go);
            *(LAS v4u*)(Ks + l * TSB + ch * 16) = *(const v4u*)(Kb + go);
            *(LAS v4u*)(Vs + l * TSB + ch * 16) = *(const v4u*)(Vb + go);
        }
        if (c.tid < 128) { rsum[c.tid] = 0.f; rsq[c.tid] = 0.f; }
        f32x4 hsum[2][4];
#pragma unroll
        for (int mt = 0; mt < 2; ++mt)
#pragma unroll
            for (int nt = 0; nt < 4; ++nt) hsum[mt][nt] = (f32x4){0.f, 0.f, 0.f, 0.f};
#pragma unroll 1
        for (int d = 0; d < 2; ++d) {
            const int sidx = (d * 4 + h) * NCL + (d == 0 ? ck : NCL - 1 - ck);
            const float m0 = M0[sidx];
            int fr = fr0, fg = fg0, lane = lane0;
            asm volatile("" : "+v"(fr), "+v"(fg), "+v"(lane));
            float lfv = 0.f, igv = 0.f;
            if (c.tid < 128) { lfv = LF[(size_t)(d * 4 + h) * NT + r0 + c.tid]; igv = IG[(size_t)(d * 4 + h) * NT + r0 + c.tid]; lfs[c.tid] = N0[(size_t)sidx * 128 + c.tid]; }
            const float bt = scan128<false>(lfv, d != 0, rsq + 128 + 128, c.tid, c.lane, c.wave);
            const float gval = igv - bt;
            const float cm = scan128<true>(c.tid < 128 ? gval : -INFINITY, d != 0, rsq + 128 + 128, c.tid, c.lane, c.wave);
            if (c.tid < 128) {
                gs[c.tid] = gval;
                const float M = fmaxf(m0, cm);
                Ms[c.tid] = M; wis[c.tid] = __expf(m0 - M); emt[c.tid] = __expf(-(bt + M)); nqs[c.tid] = 0.f;
                float qn = 0.f;
#pragma unroll 4
                for (int k8 = 0; k8 < 16; ++k8) {
                    float qf[8]; unpack8(*(const LAS v4u*)(Qs + c.tid * TSB + k8 * 16), qf);
#pragma unroll
                    for (int u = 0; u < 8; ++u) qn += qf[u] * lfs[k8 * 8 + u];
                }
                qns[c.tid] = qn;
            }
            __syncthreads();
            {
                f32x4 acc[2][4];
#pragma unroll
                for (int mt = 0; mt < 2; ++mt)
#pragma unroll
                    for (int nt = 0; nt < 4; ++nt) acc[mt][nt] = (f32x4){0.f, 0.f, 0.f, 0.f};
#pragma unroll 1
                for (int ks = 0; ks < 4; ++ks) {
                    h8 a[2], b[4];
#pragma unroll
                    for (int mt = 0; mt < 2; ++mt) a[mt] = frag_row(Ks, TSB, 32 * rt + 16 * mt, 32 * ks, lane);
#pragma unroll
                    for (int nt = 0; nt < 4; ++nt) b[nt] = frag_row(Qs, TSB, 64 * cg + 16 * nt, 32 * ks, lane);
#pragma unroll
                    for (int mt = 0; mt < 2; ++mt)
#pragma unroll
                        for (int nt = 0; nt < 4; ++nt) acc[mt][nt] = MFMA16(a[mt], b[nt], acc[mt][nt]);
                }
#pragma unroll
                for (int nt = 0; nt < 4; ++nt) {
                    const int t = 64 * cg + 16 * nt + fr; const float Mt = Ms[t]; float csum = 0.f;
#pragma unroll
                    for (int mt = 0; mt < 2; ++mt) {
                        const int s0 = 32 * rt + 16 * mt + 4 * fg; float v[4];
#pragma unroll
                        for (int r = 0; r < 4; ++r) {
                            const int s = s0 + r; const bool ok = d == 0 ? (s <= t) : (s >= t);
                            v[r] = ok ? acc[mt][nt][r] * __expf(gs[s] - Mt) : 0.f; csum += v[r];
                        }
                        v2u w; w.x = pk2(v[0], v[1]); w.y = pk2(v[2], v[3]);
                        *(LAS v2u*)(Ss + t * TSB + s0 * 2) = w;
                    }
                    csum += __shfl_xor(csum, 16); csum += __shfl_xor(csum, 32);
                    if (fg == 0) lds_atomic_add(nqs + t, csum);
                }
            }
            __syncthreads();
            {
                f32x4 a1[2][4], a2[2][4];
#pragma unroll
                for (int mt = 0; mt < 2; ++mt)
#pragma unroll
                    for (int nt = 0; nt < 4; ++nt) { a1[mt][nt] = (f32x4){0.f, 0.f, 0.f, 0.f}; a2[mt][nt] = (f32x4){0.f, 0.f, 0.f, 0.f}; }
                h8 bc[4][4];
                {
                    const bf16* c0 = C0 + (size_t)sidx * 16384;
#pragma unroll
                    for (int ks = 0; ks < 4; ++ks)
#pragma unroll
                        for (int nt = 0; nt < 4; ++nt) bc[ks][nt] = *(const h8*)(c0 + (size_t)(64 * cg + 16 * nt + fr) * 128 + 32 * ks + 8 * fg);
                }
#pragma unroll
                for (int ks = 0; ks < 4; ++ks) {
                    h8 as_[2], aq[2], bv[4];
#pragma unroll
                    for (int mt = 0; mt < 2; ++mt) { as_[mt] = frag_row(Ss, TSB, 32 * rt + 16 * mt, 32 * ks, lane); aq[mt] = frag_row(Qs, TSB, 32 * rt + 16 * mt, 32 * ks, lane); }
#pragma unroll
                    for (int nt = 0; nt < 4; ++nt) bv[nt] = frag_tr(Vs, TSB, 32 * ks, 64 * cg + 16 * nt, lane);
#pragma unroll
                    for (int mt = 0; mt < 2; ++mt)
#pragma unroll
                        for (int nt = 0; nt < 4; ++nt) { a1[mt][nt] = MFMA16(as_[mt], bv[nt], a1[mt][nt]); a2[mt][nt] = MFMA16(aq[mt], bc[ks][nt], a2[mt][nt]); }
                }
#pragma unroll
                for (int mt = 0; mt < 2; ++mt)
#pragma unroll
                    for (int r = 0; r < 4; ++r) {
                        const int t = 32 * rt + 16 * mt + 4 * fg + r; const float wi = wis[t];
                        const float rden = 1.f / fmaxf(fabsf(nqs[t] + wi * qns[t]), emt[t]);
#pragma unroll
                        for (int nt = 0; nt < 4; ++nt) hsum[mt][nt][r] += (a1[mt][nt][r] + wi * a2[mt][nt][r]) * rden;
                    }
            }
            __syncthreads();
        }
        const int fr = fr0, fg = fg0;
#pragma unroll
        for (int mt = 0; mt < 2; ++mt)
#pragma unroll
            for (int r = 0; r < 4; ++r) {
                const int t = 32 * rt + 16 * mt + 4 * fg + r; float s1 = 0.f, s2 = 0.f;
#pragma unroll
                for (int nt = 0; nt < 4; ++nt) { const float x = hsum[mt][nt][r]; s1 += x; s2 += x * x; *(LAS bf16*)(Ss + t * TSB + (64 * cg + 16 * nt + fr) * 2) = (bf16)f2bf(x); }
#pragma unroll
                for (int o = 1; o < 16; o <<= 1) { s1 += __shfl_xor(s1, o); s2 += __shfl_xor(s2, o); }
                if (fr == 0) { lds_atomic_add(rsum + t, s1); lds_atomic_add(rsq + t, s2); }
            }
        __syncthreads();
        for (int e = c.tid; e < 128 * 16; e += NTHREADS) {
            const int t = e >> 4, ch = e & 15, col0 = h * DH + ch * 8; const size_t row = (size_t)(r0 + t);
            const float mu = rsum[t] * (1.f / 128.f), var = fmaxf(rsq[t] * (1.f / 128.f) - mu * mu, 0.f), rstd = rsqrtf(var + EPS);
            float hf[8], af[8], zf[8], o[8];
            unpack8(*(const LAS v4u*)(Ss + t * TSB + ch * 16), hf); unpack8(*(const v4u*)(ACT + row * DM + col0), af); unpack8(*(const v4u*)(Z + row * DM + col0), zf);
#pragma unroll
            for (int u = 0; u < 8; ++u) { const float hn = (hf[u] - mu) * rstd * norm_w[col0 + u]; o[u] = (hn + skip[col0 + u] * af[u]) * siluf(zf[u]); }
            v4u w; w.x = pk2(o[0], o[1]); w.y = pk2(o[2], o[3]); w.z = pk2(o[4], o[5]); w.w = pk2(o[6], o[7]);
            *(v4u*)(A2 + row * D + col0) = w;
        }
        __syncthreads();
    }
}


__device__ __forceinline__ void p6m_fourier_a(const Ctx& c) {
    const bf16* U = (const bf16*)(c.ws + WS_U); bf16* FB = (bf16*)c.out;
    LAS unsigned char* L = (LAS unsigned char*)c.lds; LAS unsigned char* Ws = L; LAS unsigned char* Us = L + 256 * TSB;
    constexpr int USB = 544;
    const int lane = c.lane, rt = c.wave >> 1, cg = c.wave & 1, fr = lane & 15, fg = lane >> 4;
    for (int e = c.tid; e < 256 * 128; e += NTHREADS) {
        const int row = e >> 7, t1 = e & 127, k1 = 16 * (row >> 5) + (row & 15), ri = (row >> 4) & 1;
        const float ph = (float)((k1 * t1) & 127) * (1.f / 64.f);
        *(LAS bf16*)(Ws + row * TSB + t1 * 2) = (bf16)f2bf(ri ? -sinpif(ph) : cospif(ph));
    }
    __syncthreads();
    for (int it = c.bid; it < 256; it += c.G) {
        const int t2 = it >> 1, nh = it & 1;
        for (int e = c.tid; e < 128 * 32; e += NTHREADS) {
            const int t1 = e >> 5, ch = e & 31;
            *(LAS v4u*)(Us + t1 * USB + ch * 16) = *(const v4u*)(U + (size_t)(128 * t1 + t2) * DM + 256 * nh + ch * 8);
        }
        __syncthreads();
#pragma unroll 1
        for (int np = 0; np < 2; ++np) {
            f32x4 acc[4][4];
#pragma unroll
            for (int mt = 0; mt < 4; ++mt)
#pragma unroll
                for (int nt = 0; nt < 4; ++nt) acc[mt][nt] = (f32x4){0.f, 0.f, 0.f, 0.f};
            const int n0 = 128 * cg + 64 * np;
#pragma unroll 1
            for (int ks = 0; ks < 4; ++ks) {
                h8 a[4], b[4];
#pragma unroll
                for (int mt = 0; mt < 4; ++mt) a[mt] = frag_row(Ws, TSB, 64 * rt + 16 * mt, 32 * ks, lane);
#pragma unroll
                for (int nt = 0; nt < 4; ++nt) b[nt] = frag_tr(Us, USB, 32 * ks, n0 + 16 * nt, lane);
#pragma unroll
                for (int mt = 0; mt < 4; ++mt)
#pragma unroll
                    for (int nt = 0; nt < 4; ++nt) acc[mt][nt] = MFMA16(a[mt], b[nt], acc[mt][nt]);
            }
#pragma unroll
            for (int pi = 0; pi < 2; ++pi)
#pragma unroll
                for (int r = 0; r < 4; ++r) {
                    const int k1 = 16 * (2 * rt + pi) + 4 * fg + r;
                    const float rev = (float)(k1 * t2) * (1.f / 16384.f); const float tc = __builtin_amdgcn_cosf(rev), ts = __builtin_amdgcn_sinf(rev);
                    bf16* dr = FB + ((size_t)(k1 * 128 + t2) * 2) * 512 + 256 * nh + n0 + fr; bf16* di = dr + 512;
#pragma unroll
                    for (int nt = 0; nt < 4; ++nt) {
                        const float ar = acc[2 * pi][nt][r], ai = acc[2 * pi + 1][nt][r];
                        dr[16 * nt] = (bf16)f2bf(ar * tc + ai * ts); di[16 * nt] = (bf16)f2bf(ai * tc - ar * ts);
                    }
                }
        }
        __syncthreads();
    }
}

__device__ __forceinline__ void p7m_fourier_c(const Ctx& c) {
    const bf16* FB = (const bf16*)c.out; const bf16* Gt = (const bf16*)(c.ws + WS_G); bf16* A2 = (bf16*)(c.ws + WS_H);
    LAS unsigned char* L = (LAS unsigned char*)c.lds; LAS unsigned char* Cs = L; LAS unsigned char* Sn = L + TILE_B; LAS unsigned char* BrS = L + 2 * TILE_B; LAS unsigned char* BiS = L + 3 * TILE_B;
    const int lane = c.lane, rt = c.wave >> 1, cg = c.wave & 1, fr = lane & 15, fg = lane >> 4;
    for (int e = c.tid; e < 128 * 128; e += NTHREADS) {
        const int k2 = e >> 7, t2 = e & 127; const float ph = (float)((k2 * t2) & 127) * (1.f / 64.f);
        *(LAS bf16*)(Cs + k2 * TSB + t2 * 2) = (bf16)f2bf(cospif(ph)); *(LAS bf16*)(Sn + k2 * TSB + t2 * 2) = (bf16)f2bf(sinpif(ph));
    }
    __syncthreads();
    for (int it = c.bid; it < 128 * 4; it += c.G) {
        const int k1 = it >> 2, g = it & 3;
        for (int e = c.tid; e < 128 * 32; e += NTHREADS) {
            const int t2 = e >> 5, ri = (e >> 4) & 1, ch = e & 15;
            *(LAS v4u*)((ri ? BiS : BrS) + t2 * TSB + ch * 16) = *(const v4u*)(FB + ((size_t)(k1 * 128 + t2) * 2 + ri) * 512 + g * 128 + ch * 8);
        }
        __syncthreads();
        {
            f32x4 xr[2][4], xi[2][4];
#pragma unroll
            for (int mt = 0; mt < 2; ++mt)
#pragma unroll
                for (int nt = 0; nt < 4; ++nt) { xr[mt][nt] = (f32x4){0.f, 0.f, 0.f, 0.f}; xi[mt][nt] = (f32x4){0.f, 0.f, 0.f, 0.f}; }
#pragma unroll 1
            for (int ks = 0; ks < 4; ++ks) {
                h8 ar[2], ai[2], an[2], bc[4], bs[4];
#pragma unroll
                for (int mt = 0; mt < 2; ++mt) {
                    ar[mt] = frag_tr(BrS, TSB, 32 * ks, 32 * rt + 16 * mt, lane); ai[mt] = frag_tr(BiS, TSB, 32 * ks, 32 * rt + 16 * mt, lane);
                    an[mt] = ar[mt] ^ (short)0x8000;
                }
#pragma unroll
                for (int nt = 0; nt < 4; ++nt) { bc[nt] = frag_row(Cs, TSB, 64 * cg + 16 * nt, 32 * ks, lane); bs[nt] = frag_row(Sn, TSB, 64 * cg + 16 * nt, 32 * ks, lane); }
#pragma unroll
                for (int mt = 0; mt < 2; ++mt)
#pragma unroll
                    for (int nt = 0; nt < 4; ++nt) {
                        xr[mt][nt] = MFMA16(ar[mt], bc[nt], xr[mt][nt]); xr[mt][nt] = MFMA16(ai[mt], bs[nt], xr[mt][nt]);
                        xi[mt][nt] = MFMA16(ai[mt], bc[nt], xi[mt][nt]); xi[mt][nt] = MFMA16(an[mt], bs[nt], xi[mt][nt]);
                    }
            }
            __syncthreads();
#pragma unroll
            for (int mt = 0; mt < 2; ++mt)
#pragma unroll
                for (int nt = 0; nt < 4; ++nt) {
                    const int k2 = 64 * cg + 16 * nt + fr, c0 = 32 * rt + 16 * mt + 4 * fg;
                    v2u w; w.x = pk2(xr[mt][nt][0], xr[mt][nt][1]); w.y = pk2(xr[mt][nt][2], xr[mt][nt][3]); *(LAS v2u*)(BrS + k2 * TSB + c0 * 2) = w;
                    w.x = pk2(xi[mt][nt][0], xi[mt][nt][1]); w.y = pk2(xi[mt][nt][2], xi[mt][nt][3]); *(LAS v2u*)(BiS + k2 * TSB + c0 * 2) = w;
                }
        }
        __syncthreads();
        {
            f32x4 acc[2][4];
#pragma unroll
            for (int mt = 0; mt < 2; ++mt)
#pragma unroll
                for (int nt = 0; nt < 4; ++nt) acc[mt][nt] = (f32x4){0.f, 0.f, 0.f, 0.f};
            const bf16* gt = Gt + (size_t)g * 128 * 256;
#pragma unroll 2
            for (int ks = 0; ks < 8; ++ks) {
                h8 a[2], b[4];
                const LAS unsigned char* xs = ks < 4 ? BrS : BiS;
#pragma unroll
                for (int nt = 0; nt < 4; ++nt) b[nt] = *(const h8*)(gt + (size_t)(64 * cg + 16 * nt + fr) * 256 + 32 * ks + 8 * fg);
#pragma unroll
                for (int mt = 0; mt < 2; ++mt) a[mt] = frag_row(xs, TSB, 32 * rt + 16 * mt, 32 * (ks & 3), lane);
#pragma unroll
                for (int mt = 0; mt < 2; ++mt)
#pragma unroll
                    for (int nt = 0; nt < 4; ++nt) acc[mt][nt] = MFMA16(a[mt], b[nt], acc[mt][nt]);
            }
#pragma unroll
            for (int mt = 0; mt < 2; ++mt)
#pragma unroll
                for (int r = 0; r < 4; ++r) {
                    const int k2 = 32 * rt + 16 * mt + 4 * fg + r; bf16* dst = A2 + (size_t)(k1 + 128 * k2) * D + 512 + g * 128 + 64 * cg + fr;
#pragma unroll
                    for (int nt = 0; nt < 4; ++nt) dst[16 * nt] = (bf16)f2bf(acc[mt][nt][r]);
                }
        }
        __syncthreads();
    }
}

#define XB_TMO      128
#define XB_XCNT(j)  (256  + 64 * (j))
#define XB_XSUB(j)  (1280 + 64 * (j))
#define XB_XGEN(j)  (2304 + 64 * (j))
#define XB_TOP      3328
#define XB_TOPGEN   3392
#define XCD_BAR_WORDS 3456
#define XB_SPIN_CAP (1u << 18)
__device__ __forceinline__ unsigned xb_ld(unsigned* p)              { return __hip_atomic_load(p, __ATOMIC_RELAXED, __HIP_MEMORY_SCOPE_AGENT); }
__device__ __forceinline__ unsigned xb_add(unsigned* p, unsigned v) { return __hip_atomic_fetch_add(p, v, __ATOMIC_RELAXED, __HIP_MEMORY_SCOPE_AGENT); }
__device__ __forceinline__ unsigned xb_xcc_id() { return (unsigned)__builtin_amdgcn_s_getreg((3 << 11) | 20) & 0xFu; }
#define XB_SPIN(cond, bar) do { unsigned _sp = 0; while (cond) { __builtin_amdgcn_s_sleep(1); \
    if ((++_sp & 255u) == 0u) { if (xb_ld(&(bar)[XB_TMO])) break; if (_sp > XB_SPIN_CAP) { atomicAdd(&(bar)[XB_TMO], 1u); break; } } } } while (0)
struct XcdBarrier { unsigned* bar; unsigned x; volatile LAS unsigned* st; };
__device__ __forceinline__ XcdBarrier xcd_barrier_post(unsigned* bar, volatile LAS unsigned* st) {
    XcdBarrier b; b.bar = bar; b.x = xb_xcc_id(); b.st = st;
    if (threadIdx.x == 0) (void)xb_add(&bar[XB_XCNT(b.x)], 1u);
    return b;
}
__device__ __forceinline__ void xcd_barrier_complete(unsigned* bar, unsigned x, unsigned& nloc, unsigned& nx) {
    const unsigned G = gridDim.x * gridDim.y * gridDim.z;
    unsigned sum, cnt, mine, sp = 0u;
    for (;;) {
        sum = 0u; cnt = 0u; mine = 0u;
#pragma unroll
        for (unsigned j = 0; j < 16; ++j) { const unsigned c = xb_ld(&bar[XB_XCNT(j)]); sum += c; cnt += (c > 0u) ? 1u : 0u; mine = (j == x) ? c : mine; }
        if (sum == G) break;
        __builtin_amdgcn_s_sleep(1);
        if ((++sp & 255u) == 0u) { if (xb_ld(&bar[XB_TMO])) break; if (sp > XB_SPIN_CAP) { atomicAdd(&bar[XB_TMO], 1u); break; } }
    }
    nloc = mine > 0u ? mine : 1u; nx = cnt > 0u ? cnt : 1u;
}
__device__ __forceinline__ void xcd_barrier(const XcdBarrier& b) {
    asm volatile("s_waitcnt vmcnt(0)" ::: "memory");
    __syncthreads();
    if (threadIdx.x == 0) {
        unsigned* bar = b.bar;
        __builtin_amdgcn_s_waitcnt(0);
        unsigned nloc = b.st[0], nx = b.st[1];
        if (nloc == 0u) { xcd_barrier_complete(bar, b.x, nloc, nx); b.st[0] = nloc; b.st[1] = nx; }
        const unsigned old = xb_add(&bar[XB_XSUB(b.x)], 1u);
        const unsigned gen = old / nloc;
        if (old + 1u == (gen + 1u) * nloc) {
            __builtin_amdgcn_fence(__ATOMIC_RELEASE, "agent");
            asm volatile("s_waitcnt vmcnt(0)" ::: "memory");
            const unsigned og = xb_add(&bar[XB_TOP], 1u);
            const unsigned tg = og / nx;
            if (og + 1u == (tg + 1u) * nx) xb_add(&bar[XB_TOPGEN], 1u);
            else XB_SPIN(xb_ld(&bar[XB_TOPGEN]) == tg, bar);
            __builtin_amdgcn_fence(__ATOMIC_ACQUIRE, "agent");
            xb_add(&bar[XB_XGEN(b.x)], 1u);
            asm volatile("s_waitcnt vmcnt(0)" ::: "memory");
        } else {
            XB_SPIN(xb_ld(&bar[XB_XGEN(b.x)]) == gen, bar);
            __builtin_amdgcn_fence(__ATOMIC_ACQUIRE, "agent");
            asm volatile("s_waitcnt vmcnt(0)" ::: "memory");
        }
    }
    __syncthreads();
}

#ifndef MK_CG_SYNC
#define MK_CG_SYNC 0
#endif
constexpr int MISC_OFF = LDS_BYTES - 256;
constexpr int TAB_OFF = LDS_BYTES - 1024;
__global__ void __launch_bounds__(NTHREADS, 2) fwd_kernel(Args a) {
    extern __shared__ __attribute__((aligned(16))) unsigned char lds_raw[];
    Ctx c;
    c.tid = threadIdx.x; c.lane = c.tid & 63; c.wave = __builtin_amdgcn_readfirstlane(c.tid >> 6);
    c.G = gridDim.x; c.bid = blockIdx.x; c.gw = c.bid * NWAVES + c.wave; c.NGW = c.G * NWAVES; c.gtid = c.bid * NTHREADS + c.tid; c.NTHR = c.G * NTHREADS;
    c.lds = (float*)lds_raw;
    {
        volatile LAS unsigned* tabw = (volatile LAS unsigned*)((LAS unsigned char*)lds_raw + TAB_OFF);
        if (c.tid == 0) {
#define PUT(i, p) do { tabw[2 * (i)] = (unsigned)(size_t)(p); tabw[2 * (i) + 1] = (unsigned)((size_t)(p) >> 32); } while (0)
            PUT(0, a.in[0]); PUT(1, a.in[1]); PUT(2, a.in[2]); PUT(3, a.in[3]); PUT(4, a.in[4]); PUT(5, a.in[5]); PUT(6, a.in[6]); PUT(7, a.in[7]);
            PUT(8, a.in[8]); PUT(9, a.in[9]); PUT(10, a.in[10]); PUT(11, a.in[11]); PUT(12, a.in[12]); PUT(13, a.in[13]); PUT(14, a.in[14]); PUT(15, a.in[15]);
            PUT(16, a.in[16]); PUT(17, a.in[17]); PUT(18, a.in[18]); PUT(19, a.in[19]); PUT(20, a.in[20]); PUT(21, a.in[21]); PUT(22, a.in[22]); PUT(23, a.in[23]);
            PUT(24, a.in[24]); PUT(25, a.in[25]); PUT(26, a.in[26]); PUT(27, a.in[27]); PUT(28, a.in[28]); PUT(29, a.in[29]); PUT(30, a.in[30]); PUT(31, a.ws); PUT(32, a.out);
#undef PUT
        }
        c.tab = tabw; c.ws = a.ws; c.out = a.out;
    }
    __syncthreads();
#if MK_CG_SYNC
    cooperative_groups::grid_group grid = cooperative_groups::this_grid();
#define GRID_BAR() do { grid.sync(); } while (0)
#else
    volatile LAS unsigned* misc = (volatile LAS unsigned*)((LAS unsigned char*)lds_raw + MISC_OFF);
    if (c.tid < 64) misc[c.tid] = 0u;
    __syncthreads();
    const XcdBarrier bar = xcd_barrier_post((unsigned*)(a.ws + WS_CTL) + 4096, misc + 8);
#define GRID_BAR() do { xcd_barrier(bar); } while (0)
#endif
    volatile LAS int* ts = (volatile LAS int*)((LAS unsigned char*)lds_raw + MISC_OFF) + 16;
#ifndef DUP_MASK
#define DUP_MASK 0
#endif
#define DUP(bit, stmt) do { if (DUP_MASK & (1 << (bit))) { GRID_BAR(); stmt; } } while (0)
    p0_prologue(fresh(c)); conv_small_weights(fresh(c));   GRID_BAR();
    p1_hrows(fresh(c));               GRID_BAR();
    DUP(1, p0_prologue(fresh(c)); conv_small_weights(fresh(c)); GRID_BAR(); p1_hrows(fresh(c)); GRID_BAR());
    g1_gemm1(fresh(c));               GRID_BAR();
    DUP(0, g1_gemm1(fresh(c)); GRID_BAR());
    p3_features(fresh(c)); p6m_fourier_a(fresh(c));  GRID_BAR();
    DUP(6, p3_features(fresh(c)); GRID_BAR());
    DUP(4, p6m_fourier_a(fresh(c)); GRID_BAR());
    p4m_summaries(fresh(c));          GRID_BAR();
    DUP(3, p4m_summaries(fresh(c)); GRID_BAR());
    p5_scan(fresh(c)); p7m_fourier_c(fresh(c));      GRID_BAR();
    DUP(2, p5_scan(fresh(c)); GRID_BAR());
    DUP(4, p7m_fourier_c(fresh(c)); GRID_BAR());
    p8m_mlstm_out(fresh(c)); conv_moe_weights(fresh(c));   GRID_BAR();
    DUP(7, p8m_mlstm_out(fresh(c)); GRID_BAR());
    DUP(5, conv_moe_weights(fresh(c)); GRID_BAR());
    g2_outproj(fresh(c));             GRID_BAR();
    DUP(0, g2_outproj(fresh(c)); GRID_BAR());
    p10b_token(fresh(c));             GRID_BAR();
    g3_moe_up(fresh(c), ts);          GRID_BAR();
    DUP(0, g3_moe_up(fresh(c), ts); GRID_BAR());
    g4_moe_down(fresh(c), ts);        GRID_BAR();
    DUP(0, g4_moe_down(fresh(c), ts); GRID_BAR());
    DUP(8, GRID_BAR(); GRID_BAR(); GRID_BAR(); GRID_BAR(); GRID_BAR(); GRID_BAR(); GRID_BAR());
    p12b_final(fresh(c));
}

extern "C" void kernel_launch(void* const* d_in, const int* in_sizes, int n_in, void* d_out, int out_size, void* d_ws, size_t ws_size, hipStream_t stream) {
    static int grid = 0;
    if (grid == 0) {
        if (n_in != 31 || out_size != T * D || ws_size < 256 * MiB) { fprintf(stderr, "kernel_launch: unexpected shapes n_in %d out %d ws %zu\n", n_in, out_size, ws_size); grid = -1; return; }
        int dev = 0, cus = 0, per_cu = 0;
        (void)hipGetDevice(&dev); (void)hipDeviceGetAttribute(&cus, hipDeviceAttributeMultiprocessorCount, dev);
        if (hipFuncSetAttribute((const void*)fwd_kernel, hipFuncAttributeMaxDynamicSharedMemorySize, LDS_BYTES) != hipSuccess) { fprintf(stderr, "kernel_launch: hipFuncSetAttribute failed\n"); grid = -1; return; }
        if (hipOccupancyMaxActiveBlocksPerMultiprocessor(&per_cu, (const void*)fwd_kernel, NTHREADS, LDS_BYTES) != hipSuccess || per_cu < 1) { fprintf(stderr, "kernel_launch: occupancy query says %d blocks per CU\n", per_cu); (void)hipGetLastError(); per_cu = 1; }
        grid = (cus > 0 ? cus : 256);
        fprintf(stderr, "kernel_launch: cus %d occupancy %d grid %d\n", cus, per_cu, grid);
    }
    if (grid < 0) return;
    (void)hipMemsetAsync((char*)d_ws + WS_CTL, 0, 65536, stream);
    Args a{};
    for (int i = 0; i < 31; ++i) a.in[i] = (const float*)d_in[i];
    a.out = (float*)d_out; a.ws = (unsigned char*)d_ws; a.ph_lo = 0; a.ph_hi = 0;
    void* kargs[] = {&a};
    hipError_t e = hipLaunchCooperativeKernel((const void*)fwd_kernel, dim3(grid), dim3(NTHREADS), kargs, LDS_BYTES, stream);
    if (e != hipSuccess) fprintf(stderr, "kernel_launch: cooperative launch failed: %s (grid %d)\n", hipGetErrorString(e), grid);
}
```

```cpp
#include <hip/hip_runtime.h>
#include <hip/hip_cooperative_groups.h>
#include <cstdio>

typedef unsigned short bf16;
typedef unsigned v4u __attribute__((ext_vector_type(4)));
typedef float f32x4 __attribute__((ext_vector_type(4)));

constexpr int D = 1024, T = 16384, TC = 256, NT = T + TC;
constexpr int DM = 512, NH = 4, DH = 128, CH = 128, NCL = T / CH, NCC = TC / CH, NCH = NCL + NCC;
constexpr int DIN = 1536, NE = 16, DE = 512;
constexpr float EPS = 1e-6f;
constexpr int NTHREADS = 512, NWAVES = 8;
constexpr int LDS_BYTES = 163840;

constexpr size_t MiB = 1u << 20;
constexpr size_t WS_CTL = 0;
constexpr size_t WS_MOD = 1 * MiB;
constexpr size_t WS_MODC = 1 * MiB + 32768;
constexpr size_t WS_POSR = 1 * MiB + 65536;
constexpr size_t WS_POSC = WS_POSR + 256 * 512 * 4;
constexpr size_t WS_G = 2 * MiB;
constexpr size_t WS_IG = 3 * MiB;
constexpr size_t WS_LF = 4 * MiB;
constexpr size_t WS_AMAX = 5 * MiB;
constexpr size_t WS_BTOT = 5 * MiB + 8192;
constexpr size_t WS_M0 = 5 * MiB + 16384;
constexpr size_t WS_NL = 5 * MiB + 65536;
constexpr size_t WS_N0 = 6 * MiB;
constexpr size_t WS_RE = 7 * MiB;
constexpr size_t WS_RW = 7 * MiB + 256 * 1024;
constexpr size_t WS_H = 13 * MiB;
constexpr size_t WS_XM = 46 * MiB;
constexpr size_t WS_U = WS_XM + (size_t)NT * 1024;
constexpr size_t WS_Z = 79 * MiB;
constexpr size_t WS_C0 = 46 * MiB;
constexpr size_t WS_Q = 96 * MiB, WS_K = WS_Q + (size_t)NT * 1024, WS_V = WS_K + (size_t)NT * 1024, WS_ACT = WS_V + (size_t)NT * 1024;
constexpr size_t WS_L = 163 * MiB;
constexpr size_t WS_Y = 96 * MiB;
static_assert(WS_U + (size_t)NT * 1024 <= WS_Z && WS_Z + (size_t)NT * 1024 <= WS_Q && WS_ACT + (size_t)NT * 1024 <= WS_L && WS_L + 65 * MiB <= 256 * MiB, "ws map");
static_assert(WS_C0 + 32 * MiB <= WS_Z && WS_Y + 64 * MiB <= WS_L && WS_H + (size_t)NT * 2048 <= WS_XM, "ws map 2");
constexpr size_t WS_WIN_T = 8 * MiB;
constexpr size_t WS_WOUT_T = 11 * MiB;
constexpr size_t WS_WGU_T = 168 * MiB;
constexpr size_t WS_WD_T = 200 * MiB;
constexpr size_t WS_ASORT = 96 * MiB;
constexpr size_t WS_YROW = 96 * MiB;
constexpr size_t WS_ACTS = 46 * MiB;
constexpr size_t WS_RS = 7 * MiB + 512 * 1024;
constexpr size_t WS_ROWW = 216 * MiB;
constexpr size_t WS_ROWTOK = 217 * MiB;
constexpr int CW_CNT = 8192;
static_assert(WS_ASORT + 72 * MiB <= WS_WGU_T && WS_WD_T + 16 * MiB <= WS_ROWW && WS_ACTS + 36 * MiB <= WS_ASORT, "ws map 3");

#define LAS __attribute__((address_space(3)))
struct Args { const float* in[31]; float* out; unsigned char* ws; int ph_lo, ph_hi; };

__device__ __forceinline__ float bf2f(unsigned b) { return __uint_as_float(b << 16); }
__device__ __forceinline__ unsigned f2bf(float f) { unsigned u = __float_as_uint(f); return (u + 0x7fffu + ((u >> 16) & 1u)) >> 16; }
__device__ __forceinline__ unsigned pk2(float lo, float hi) { return f2bf(lo) | (f2bf(hi) << 16); }
__device__ __forceinline__ float lo16(unsigned w) { return __uint_as_float(w << 16); }
__device__ __forceinline__ float hi16(unsigned w) { return __uint_as_float(w & 0xffff0000u); }
__device__ __forceinline__ float wave_sum(float v) {
#pragma unroll
    for (int o = 1; o < 64; o <<= 1) v += __shfl_xor(v, o);
    return v;
}
__device__ __forceinline__ float siluf(float x) { return x / (1.f + __expf(-x)); }
__device__ __forceinline__ float logsigf(float x) { return fminf(x, 0.f) - log1pf(__expf(-fabsf(x))); }
__device__ __forceinline__ void unpack8(const v4u w, float (&f)[8]) {
    f[0] = lo16(w.x); f[1] = hi16(w.x); f[2] = lo16(w.y); f[3] = hi16(w.y); f[4] = lo16(w.z); f[5] = hi16(w.z); f[6] = lo16(w.w); f[7] = hi16(w.w);
}
template <bool MAXOP>
__device__ __forceinline__ float scan128(float v, bool rev, LAS float* tmp, int tid, int lane, int wave) {
    float x = v;
#pragma unroll
    for (int o = 1; o < 64; o <<= 1) {
        const float y = rev ? __shfl_down(x, o) : __shfl_up(x, o);
        const bool ok = rev ? (lane + o < 64) : (lane >= o);
        if (ok) x = MAXOP ? fmaxf(x, y) : x + y;
    }
    if (wave < 2 && lane == (rev ? 0 : 63)) tmp[wave] = x;
    __syncthreads();
    if (tid < 128) {
        if (!rev && wave == 1) x = MAXOP ? fmaxf(x, tmp[0]) : x + tmp[0];
        if (rev && wave == 0) x = MAXOP ? fmaxf(x, tmp[1]) : x + tmp[1];
    }
    __syncthreads();
    return x;
}
__device__ __forceinline__ int chunk_row0(int d, int j) {
    if (d == 0) return j < NCC ? T + j * CH : (j - NCC) * CH;
    return j < NCC ? T + (NCC - 1 - j) * CH : (NCL - 1 - (j - NCC)) * CH;
}

struct Ctx {
    int tid, lane, wave, gw, NGW, gtid, NTHR, G, bid;
    unsigned char* ws; float* out; const volatile LAS unsigned* tab;
    float* lds;
};

__device__ __forceinline__ const void* tab_ptr(const volatile LAS unsigned* tab, int i) {
    unsigned lo = tab[2 * i], hi = tab[2 * i + 1];
    lo = __builtin_amdgcn_readfirstlane(lo); hi = __builtin_amdgcn_readfirstlane(hi);
    return (const void*)(((size_t)hi << 32) | lo);
}
__device__ __forceinline__ const float* inp(const Ctx& c, int i) { return (const float*)tab_ptr(c.tab, i); }
__device__ __forceinline__ Ctx fresh(const Ctx& c0) {
    Ctx c = c0;
    int t = threadIdx.x; asm volatile("" : "+v"(t));
    c.tid = t; c.lane = t & 63; c.wave = __builtin_amdgcn_readfirstlane(t >> 6);
    c.gw = c.bid * NWAVES + c.wave; c.gtid = c.bid * NTHREADS + t;
    c.ws = (unsigned char*)tab_ptr(c0.tab, 31); c.out = (float*)tab_ptr(c0.tab, 32);
    return c;
}
template <int K>
__device__ __forceinline__ void gemm_8x64(const bf16* a0, const bf16* a1, const bf16* a2, const bf16* a3, const bf16* a4, const bf16* a5, const bf16* a6, const bf16* a7,
                                          const float* B, int ldb, int col, float (&acc)[8]) {
    for (int k0 = 0; k0 < K; k0 += 8) {
        float a[8][8];
        unpack8(*(const v4u*)(a0 + k0), a[0]); unpack8(*(const v4u*)(a1 + k0), a[1]); unpack8(*(const v4u*)(a2 + k0), a[2]); unpack8(*(const v4u*)(a3 + k0), a[3]);
        unpack8(*(const v4u*)(a4 + k0), a[4]); unpack8(*(const v4u*)(a5 + k0), a[5]); unpack8(*(const v4u*)(a6 + k0), a[6]); unpack8(*(const v4u*)(a7 + k0), a[7]);
#pragma unroll
        for (int kk = 0; kk < 8; ++kk) {
            const float b = B[(size_t)(k0 + kk) * ldb + col];
#pragma unroll
            for (int r = 0; r < 8; ++r) acc[r] += a[r][kk] * b;
        }
    }
}

__device__ __forceinline__ void p0_prologue(const Ctx& c) {
    const float* cvec = inp(c, 1); const float* ccvec = inp(c, 3); const float* w_ada = inp(c, 4); const float* b_ada = inp(c, 5);
    float* mod = (float*)(c.ws + WS_MOD); float* modc = (float*)(c.ws + WS_MODC);
    for (int it = c.bid; it < 96; it += c.G) {
        const int col = it * 64 + c.lane; float al = 0.f, ac = 0.f;
#pragma unroll 16
        for (int k = c.wave * 128; k < c.wave * 128 + 128; ++k) {
            const float w = w_ada[(size_t)k * 6144 + col];
            al += siluf(cvec[k]) * w; ac += siluf(ccvec[k]) * w;
        }
        c.lds[(c.wave * 64 + c.lane) * 2] = al; c.lds[(c.wave * 64 + c.lane) * 2 + 1] = ac;
        __syncthreads();
        if (c.wave == 0) {
            float sl = 0.f, sc = 0.f;
            for (int w = 0; w < 8; ++w) { sl += c.lds[(w * 64 + c.lane) * 2]; sc += c.lds[(w * 64 + c.lane) * 2 + 1]; }
            mod[col] = sl + b_ada[col];
            if (col < 2048) modc[col] = sc + b_ada[col];
        }
        __syncthreads();
    }
    float* posR = (float*)(c.ws + WS_POSR);
    for (int i = c.gtid; i < 320 * 512; i += c.NTHR) {
        const int r = i >> 9, j = i & 511, p = r < 256 ? r : r - 256, fi = j & 255;
        const float freq = 1.0f / powf(10000.0f, (float)fi / 256.0f);
        const float ang = (float)p * freq;
        posR[i] = j < 256 ? sinf(ang) : cosf(ang);
    }
    const float* wf = inp(c, 22); bf16* Gt = (bf16*)(c.ws + WS_G);
    const float scale = 1.0f / sqrtf(16384.0f * 128.0f);
    LAS float* tab = (LAS float*)c.lds + 2048;
    if (c.tid < 128) { tab[c.tid] = cospif((float)c.tid * (1.f / 64.f)); tab[128 + c.tid] = sinpif((float)c.tid * (1.f / 64.f)); }
    __syncthreads();
    for (int i = c.gtid; i < 4 * 128 * 256; i += c.NTHR) {
        const int g = i >> 15, d = (i >> 8) & 127, row = i & 255, cc = row & 127; float s = 0.f;
        const LAS float* tb = tab + (row < 128 ? 0 : 128); const float* wp = wf + (size_t)g * 128 * 128 + d;
#pragma unroll 8
        for (int c2 = 0; c2 < 128; ++c2) s += tb[(cc * c2) & 127] * wp[c2 * 128];
        Gt[i] = (bf16)f2bf(s * scale);
    }
}

__device__ __forceinline__ void p1_hrows(const Ctx& c) {
    const float* x = inp(c, 0); const float* ctx = inp(c, 2); const float* g = inp(c, 6);
    const float* mod = (const float*)(c.ws + WS_MOD); const float* modc = (const float*)(c.ws + WS_MODC);
    const float* posR = (const float*)(c.ws + WS_POSR); const float* posC = (const float*)(c.ws + WS_POSC);
    bf16* H = (bf16*)(c.ws + WS_H);
    constexpr int RB = 4;
    for (int rb = c.gw; rb < NT; rb += RB * c.NGW) {
        asm volatile("" ::: "memory");
        f32x4 v[RB][4];
#pragma unroll
        for (int b = 0; b < RB; ++b) {
            const int r = rb + b * c.NGW; const bool ok = r < NT, lat = r < T;
            const float* src = lat ? x + (size_t)r * D : ctx + (size_t)(ok ? r - T : 0) * D;
#pragma unroll
            for (int j = 0; j < 4; ++j) {
                const int col = 256 * j + 4 * c.lane;
                v[b][j] = *(const f32x4*)(src + col);
                if (lat) { const float* pp = col < 512 ? posR + (r >> 6) * 512 + col : posC + (r & 63) * 512 + (col - 512); v[b][j] += *(const f32x4*)pp; }
            }
        }
#pragma unroll
        for (int b = 0; b < RB; ++b) {
            const int r = rb + b * c.NGW; if (r >= NT) continue;
            const float* md = r < T ? mod : modc;
            float ss = 0.f;
#pragma unroll
            for (int j = 0; j < 4; ++j) ss += v[b][j].x * v[b][j].x + v[b][j].y * v[b][j].y + v[b][j].z * v[b][j].z + v[b][j].w * v[b][j].w;
            const float rinv = rsqrtf(wave_sum(ss) * (1.f / D) + EPS);
#pragma unroll
            for (int j = 0; j < 4; ++j) {
                const int col = 256 * j + 4 * c.lane;
                const f32x4 gg = *(const f32x4*)(g + col), sh = *(const f32x4*)(md + col), sc = *(const f32x4*)(md + 1024 + col);
                const f32x4 o = v[b][j] * rinv * gg * (sc + 1.f) + sh;
                uint2 w; w.x = pk2(o.x, o.y); w.y = pk2(o.z, o.w);
                *(uint2*)(H + (size_t)r * D + col) = w;
            }
        }
    }
}

__device__ __forceinline__ void p3_features(const Ctx& c) {
    const bf16* XM = (const bf16*)(c.ws + WS_XM);
    bf16* Q = (bf16*)(c.ws + WS_Q); bf16* Kb = (bf16*)(c.ws + WS_K); bf16* Vb = (bf16*)(c.ws + WS_V); bf16* ACT = (bf16*)(c.ws + WS_ACT);
    float* IG = (float*)(c.ws + WS_IG); float* LF = (float*)(c.ws + WS_LF);
    LAS float* WL = (LAS float*)c.lds; LAS float* PW = WL + 24 * 64 * 20;
    {
        const float* wf_ = inp(c, 16); const float* wb_ = inp(c, 18);
        for (int idx = c.tid; idx < 24 * 64 * 16; idx += NTHREADS) {
            const int pi = idx >> 10, ln = (idx >> 4) & 63, dj = idx & 15, part = pi >> 3, i = pi & 7, d = dj >> 3, j = dj & 7;
            WL[(pi * 64 + ln) * 20 + dj] = (d ? wb_ : wf_)[(size_t)(part * 512 + 8 * ln + i) * 8 + j];
        }
        const float* conv_w = inp(c, 11); const float* conv_b = inp(c, 12); const float* wq = inp(c, 13); const float* wk = inp(c, 14); const float* wv = inp(c, 15);
        for (int idx = c.tid; idx < 64 * 128; idx += NTHREADS) {
            const int ln = idx >> 7, k = idx & 127; float v;
            if (k < 32) v = wq[ln * 32 + k]; else if (k < 64) v = wk[ln * 32 + k - 32]; else if (k < 96) v = wv[ln * 32 + k - 64];
            else if (k < 120) v = conv_w[((k - 96) >> 3) * DM + 8 * ln + ((k - 96) & 7)]; else v = conv_b[8 * ln + k - 120];
            PW[((k >> 2) * 64 + ln) * 4 + (k & 3)] = v;
        }
    }
    __syncthreads();
    const float bias_ = 0.f; (void)bias_;
    const float* bif_f = inp(c, 17); const float* bif_b = inp(c, 19);
    const int ch0 = 8 * c.lane;
#define PWV(k4) (*(const LAS f32x4*)(PW + ((k4) * 64 + c.lane) * 4))
    for (int r = c.gw; r < NT; r += c.NGW) {
        const bool lat = r < T;
        const bool hasp = lat ? (r > 0) : (r > T), hasn = lat ? (r < T - 1) : (r < NT - 1);
        float xc[8], xp[8], xn[8];
        unpack8(*(const v4u*)(XM + (size_t)r * DM + ch0), xc);
        if (hasp) unpack8(*(const v4u*)(XM + (size_t)(r - 1) * DM + ch0), xp); else { for (int i = 0; i < 8; ++i) xp[i] = 0.f; }
        if (hasn) unpack8(*(const v4u*)(XM + (size_t)(r + 1) * DM + ch0), xn); else { for (int i = 0; i < 8; ++i) xn[i] = 0.f; }
        float act[8], q[8], k[8], v[8];
        {
            const f32x4 w0a = PWV(24), w0b = PWV(25), w1a = PWV(26), w1b = PWV(27), w2a = PWV(28), w2b = PWV(29), cba = PWV(30), cbb = PWV(31);
#pragma unroll
            for (int i = 0; i < 4; ++i) {
                act[i] = siluf(w0a[i] * xp[i] + w1a[i] * xc[i] + w2a[i] * xn[i] + cba[i]);
                act[4 + i] = siluf(w0b[i] * xp[4 + i] + w1b[i] * xc[4 + i] + w2b[i] * xn[4 + i] + cbb[i]);
            }
        }
#pragma unroll
        for (int b = 0; b < 2; ++b) {
#pragma unroll
            for (int o = 0; o < 4; ++o) { q[4 * b + o] = 0.f; k[4 * b + o] = 0.f; v[4 * b + o] = 0.f; }
#pragma unroll
            for (int i = 0; i < 4; ++i) {
                const f32x4 wq4 = PWV(b * 4 + i), wk4 = PWV(8 + b * 4 + i), wv4 = PWV(16 + b * 4 + i);
#pragma unroll
                for (int o = 0; o < 4; ++o) { q[4 * b + o] += act[4 * b + i] * wq4[o]; k[4 * b + o] += act[4 * b + i] * wk4[o]; v[4 * b + o] += xc[4 * b + i] * wv4[o]; }
            }
        }
        float sg[16];
#pragma unroll
        for (int u = 0; u < 16; ++u) sg[u] = 0.f;
#pragma unroll
        for (int part = 0; part < 3; ++part)
#pragma unroll
            for (int i = 0; i < 8; ++i) {
                const float xv = part == 0 ? q[i] : (part == 1 ? k[i] : v[i]);
                const LAS float* wp = WL + ((part * 8 + i) * 64 + c.lane) * 20;
#pragma unroll
                for (int u4 = 0; u4 < 4; ++u4) { const f32x4 w4 = *(const LAS f32x4*)(wp + 4 * u4);
#pragma unroll
                    for (int e = 0; e < 4; ++e) sg[4 * u4 + e] += xv * w4[e]; }
            }
        float t8[8], t4[4], t2[2];
        { const bool hi = (c.lane & 32) != 0;
#pragma unroll
          for (int u = 0; u < 8; ++u) { const float send = hi ? sg[u] : sg[u + 8], keep = hi ? sg[u + 8] : sg[u]; t8[u] = keep + __shfl_xor(send, 32); } }
        { const bool hi = (c.lane & 16) != 0;
#pragma unroll
          for (int u = 0; u < 4; ++u) { const float send = hi ? t8[u] : t8[u + 4], keep = hi ? t8[u + 4] : t8[u]; t4[u] = keep + __shfl_xor(send, 16); } }
        { const bool hi = (c.lane & 8) != 0;
#pragma unroll
          for (int u = 0; u < 2; ++u) { const float send = hi ? t4[u] : t4[u + 2], keep = hi ? t4[u + 2] : t4[u]; t2[u] = keep + __shfl_xor(send, 8); } }
        float gsum;
        { const bool hi = (c.lane & 4) != 0; const float send = hi ? t2[0] : t2[1], keep = hi ? t2[1] : t2[0]; gsum = keep + __shfl_xor(send, 4); }
        gsum += __shfl_xor(gsum, 2); gsum += __shfl_xor(gsum, 1);
        if ((c.lane & 3) == 0) {
            const int gi = (c.lane >> 2) & 15, d = gi >> 3, j = gi & 7;
            const float val = gsum + (d ? bif_b : bif_f)[j];
            if (j < 4) IG[(size_t)(d * 4 + j) * NT + r] = val; else LF[(size_t)(d * 4 + (j - 4)) * NT + r] = logsigf(val);
        }
        const float qs = 0.08838834764831845f;
        v4u w;
        w.x = pk2(q[0] * qs, q[1] * qs); w.y = pk2(q[2] * qs, q[3] * qs); w.z = pk2(q[4] * qs, q[5] * qs); w.w = pk2(q[6] * qs, q[7] * qs); *(v4u*)(Q + (size_t)r * DM + ch0) = w;
        w.x = pk2(k[0], k[1]); w.y = pk2(k[2], k[3]); w.z = pk2(k[4], k[5]); w.w = pk2(k[6], k[7]); *(v4u*)(Kb + (size_t)r * DM + ch0) = w;
        w.x = pk2(v[0], v[1]); w.y = pk2(v[2], v[3]); w.z = pk2(v[4], v[5]); w.w = pk2(v[6], v[7]); *(v4u*)(Vb + (size_t)r * DM + ch0) = w;
        w.x = pk2(act[0], act[1]); w.y = pk2(act[2], act[3]); w.z = pk2(act[4], act[5]); w.w = pk2(act[6], act[7]); *(v4u*)(ACT + (size_t)r * DM + ch0) = w;
    }
#undef PWV
    __syncthreads();
}

__device__ __forceinline__ void p5_scan(const Ctx& c) {
    const float* LT = (const float*)(c.ws + WS_L); const float* NL = (const float*)(c.ws + WS_NL);
    const float* AMAX = (const float*)(c.ws + WS_AMAX); const float* BTOT = (const float*)(c.ws + WS_BTOT);
    bf16* C0 = (bf16*)(c.ws + WS_C0); float* N0 = (float*)(c.ws + WS_N0); float* M0 = (float*)(c.ws + WS_M0);
    constexpr int PER = 16384 + 128, JB = 13;
    for (int e = c.gtid; e < 8 * PER; e += c.NTHR) {
        const int dh = e / PER, rem = e % PER; const bool isC = rem < 16384; const int idx = isC ? rem : rem - 16384;
        const float* src = isC ? LT + (size_t)dh * NCH * 16384 + idx : NL + (size_t)dh * NCH * 128 + idx; const size_t sstep = isC ? 16384 : 128;
        float m = 0.f, val = 0.f;
#pragma unroll 1
        for (int jb = 0; jb < NCH; jb += JB) {
            float lv[JB], bt[JB], am[JB];
#pragma unroll
            for (int u = 0; u < JB; ++u) { lv[u] = src[(size_t)(jb + u) * sstep]; bt[u] = BTOT[dh * NCH + jb + u]; am[u] = AMAX[dh * NCH + jb + u]; }
#pragma unroll
            for (int u = 0; u < JB; ++u) {
                const int j = jb + u;
                if (j >= NCC) {
                    if (isC) C0[((size_t)(dh * NCL + (j - NCC))) * 16384 + idx] = (bf16)f2bf(val);
                    else N0[(size_t)(dh * NCL + (j - NCC)) * 128 + idx] = val;
                    if (rem == 0) M0[dh * NCL + (j - NCC)] = m;
                }
                const float mn = fmaxf(bt[u] + m, am[u]), dec = __expf(bt[u] + m - mn), sc = __expf(am[u] - mn);
                val = dec * val + sc * lv[u]; m = mn;
            }
        }
    }
}

namespace pg8 {
#define PG8_LAS __attribute__((address_space(3)))
typedef unsigned short bf16_t;
typedef short bf16x8 __attribute__((ext_vector_type(8)));
typedef float f32x4 __attribute__((ext_vector_type(4)));
typedef unsigned u32x4 __attribute__((ext_vector_type(4)));
constexpr int BM = 256, BK = 64, HALF = 128, HTB = HALF * BK * 2  , STAGE_BYTES = 8 * HTB, NXCD = 8, WGM = 8;

__host__ __device__ __forceinline__ int lds_byte(int r, int c) { const int st = (r >> 4) * 2 + (c >> 5), rr = r & 15, cc = c & 31, ob = rr * 64 + cc * 2; return st * 1024 + (ob ^ (((ob >> 9) & 1) << 5)); }
__host__ __device__ __forceinline__ void stage_rc(int b, int& R, int& C) { const int st = b / 1024, sb = b % 1024, swz = sb ^ (((sb >> 9) & 1) << 5); R = (st >> 1) * 16 + swz / 64; C = (st & 1) * 32 + (swz % 64) / 2; }
__host__ __device__ __forceinline__ int perm32(int rho) { const int n = rho >> 4, i = rho & 15; return 8 * (i >> 2) + 4 * n + (i & 3); }

struct Unit { int pm, pn; };
struct Gemm { const bf16_t* A; const bf16_t* Bt; int M, N, K; };

struct StaticOrder {
    int nM, nN, nwg, G, c;
    __host__ __device__ void init(int M, int N, int G_, int c_) { nM = M / BM; nN = N / BM; nwg = nM * nN; G = G_; c = c_; }
    __host__ __device__ bool next(int i, Unit& u) const {
        const long L = (long)i * G + c; if (L >= nwg) return false;
        int wgid = (int)L; { const int q = nwg / NXCD, r = nwg % NXCD, xcd = wgid % NXCD, off = wgid / NXCD; wgid = (xcd < r ? xcd * (q + 1) : r * (q + 1) + (xcd - r) * q) + off; }
        const int nig = WGM * nN, gid = wgid / nig, fm = gid * WGM, gsz = (nM - fm) < WGM ? (nM - fm) : WGM;
        u.pm = fm + ((wgid % nig) % gsz); u.pn = (wgid % nig) / gsz; return true;
    }
    __device__ __forceinline__ void a_ready(const Unit&) const {}
    __device__ __forceinline__ void done(const Unit&) const {}
};
__device__ __forceinline__ unsigned cvt_pk_bf16(float lo, float hi) { unsigned r; asm volatile("v_cvt_pk_bf16_f32 %0, %1, %2" : "=v"(r) : "v"(lo), "v"(hi)); return r; }
template <class Epi, class Sched, bool ALIGN_EPI = false, bool SP2 = false>
__device__ __forceinline__ void gemm_phase(PG8_LAS unsigned char* lds, const Gemm g, const Sched& S, const Epi& E) {
    int tid_ = threadIdx.x; asm volatile("" : "+v"(tid_));
    const int tid = tid_, wid = __builtin_amdgcn_readfirstlane(tid >> 6), lane = tid & 63, wr = wid >> 2, wc = wid & 3, fr = lane & 15, fq = lane >> 4;
    const int K = g.K, nt = K / BK;
    unsigned voffA[2], voffB[2];
#pragma unroll
    for (int i = 0; i < 2; ++i) { int R, C; stage_rc(tid * 16 + i * 8192, R, C); const int Rb = Epi::PERM ? ((R & ~31) + perm32(R & 31)) : R;
        voffA[i] = (unsigned)(R * K + C) * 2u; voffB[i] = (unsigned)(Rb * K + C) * 2u; }
    const size_t kstep = (size_t)(BK * 2);
    const size_t hstep = (size_t)HALF * K * 2;
    const size_t tstep = 2 * hstep;
    const unsigned ldsw = (unsigned)wid * 1024u;
    const int aoff = lds_byte(wr * 64 + fr, fq * 8), boff = lds_byte(wc * 32 + fr, fq * 8);
#define PG8_SA(b, h) (((b) * 2 + (h)) * HTB)
#define PG8_SB(b, h) ((4 + (b) * 2 + (h)) * HTB)
#define PG8_STAGE(bufoff, gbase, voff) do { _Pragma("unroll") for (int _i = 0; _i < 2; ++_i) \
        __builtin_amdgcn_global_load_lds((const unsigned*)((const char*)(gbase) + (voff)[_i]), (PG8_LAS unsigned*)(lds + (bufoff) + ldsw + _i * 8192), 16, 0, 0); } while (0)
#define PG8_LDA(dst, b, h) do { _Pragma("unroll") for (int m = 0; m < 4; ++m) _Pragma("unroll") for (int k = 0; k < 2; ++k) dst[m][k] = *(const PG8_LAS bf16x8*)(lds + PG8_SA(b, h) + aoff + m * 2048 + k * 1024); } while (0)
#define PG8_LDB(dst, b, h) do { _Pragma("unroll") for (int n = 0; n < 2; ++n) _Pragma("unroll") for (int k = 0; k < 2; ++k) dst[n][k] = *(const PG8_LAS bf16x8*)(lds + PG8_SB(b, h) + boff + n * 2048 + k * 1024); } while (0)
#define PG8_MMA(ai, bj, At, Bt) do { __builtin_amdgcn_s_setprio(1); _Pragma("unroll") for (int m = 0; m < 4; ++m) _Pragma("unroll") for (int n = 0; n < 2; ++n) _Pragma("unroll") for (int k = 0; k < 2; ++k) \
        acc[ai][bj][m][n] = __builtin_amdgcn_mfma_f32_16x16x32_bf16(Bt[n][k], At[m][k], acc[ai][bj][m][n], 0, 0, 0); __builtin_amdgcn_s_setprio(0); } while (0)
#define PG8_WAIT_V(n) asm volatile("s_waitcnt vmcnt(" #n ")" ::: "memory")
#define PG8_WAIT_L(n) asm volatile("s_waitcnt lgkmcnt(" #n ")" ::: "memory")
#define PG8_BAR __builtin_amdgcn_s_barrier()
#define PG8_SCHED __builtin_amdgcn_sched_barrier(0)
    Unit cur, nxt; int ui = 0;
    if (!S.next(0, cur)) return;
    f32x4 acc[2][2][4][2];
#pragma unroll
    for (int a = 0; a < 2; ++a)
#pragma unroll
        for (int b = 0; b < 2; ++b)
#pragma unroll
            for (int m = 0; m < 4; ++m)
#pragma unroll
                for (int n = 0; n < 2; ++n) acc[a][b][m][n] = (f32x4){0.f, 0.f, 0.f, 0.f};
    bf16x8 At[4][2], B0[2][2], B1[2][2];
    const char* cA = (const char*)g.A + (size_t)cur.pm * tstep; const char* cB = (const char*)g.Bt + (size_t)cur.pn * tstep;
    S.a_ready(cur);
    if constexpr (SP2) {
        PG8_STAGE(PG8_SB(0, 0), cB, voffB); PG8_STAGE(PG8_SB(0, 1), cB + hstep, voffB); PG8_STAGE(PG8_SA(0, 0), cA, voffA); PG8_STAGE(PG8_SA(0, 1), cA + hstep, voffA);
        if (wr == 1) PG8_BAR;
        PG8_WAIT_V(2); PG8_BAR;
        PG8_STAGE(PG8_SB(1, 0), cB + kstep, voffB); PG8_STAGE(PG8_SA(1, 0), cA + kstep, voffA); PG8_STAGE(PG8_SB(1, 1), cB + hstep + kstep, voffB);
        PG8_WAIT_V(6); PG8_BAR;
    } else {
        PG8_STAGE(PG8_SB(0, 0), cB, voffB); PG8_STAGE(PG8_SA(0, 0), cA, voffA); PG8_STAGE(PG8_SB(0, 1), cB + hstep, voffB); PG8_STAGE(PG8_SA(0, 1), cA + hstep, voffA);
        if (wr == 1) PG8_BAR;
        PG8_WAIT_V(4); PG8_BAR;
        PG8_STAGE(PG8_SB(1, 0), cB + kstep, voffB); PG8_STAGE(PG8_SA(1, 0), cA + kstep, voffA); PG8_STAGE(PG8_SB(1, 1), cB + hstep + kstep, voffB);
        PG8_WAIT_V(6); PG8_BAR;
    }
    for (;;) {
        const bool has_next = S.next(ui + 1, nxt);
        const char* nA = has_next ? (const char*)g.A + (size_t)nxt.pm * tstep : cA; const char* nB = has_next ? (const char*)g.Bt + (size_t)nxt.pn * tstep : cB;
        for (int t = 0; t < nt; t += 2) {
            const bool last = (t == nt - 2);
            const char* a1 = cA + (size_t)(t + 1) * kstep;
            const char* a2 = last ? nA : cA + (size_t)(t + 2) * kstep; const char* b2 = last ? nB : cB + (size_t)(t + 2) * kstep;
            const char* a3 = a2 + kstep; const char* b3 = b2 + kstep;
            if (last && has_next) S.a_ready(nxt);
            if constexpr (SP2) {
            PG8_LDB(B0, 0, 0); PG8_LDB(B1, 0, 1); PG8_SCHED; PG8_LDA(At, 0, 0); PG8_STAGE(PG8_SA(1, 1), a1 + hstep, voffA);
            PG8_WAIT_V(8); PG8_WAIT_L(0); PG8_BAR; PG8_MMA(0, 0, At, B0); PG8_MMA(0, 1, At, B1); PG8_BAR; PG8_SCHED;
            PG8_LDA(At, 0, 1); PG8_STAGE(PG8_SB(0, 0), b2, voffB); PG8_STAGE(PG8_SB(0, 1), b2 + hstep, voffB); PG8_STAGE(PG8_SA(0, 0), a2, voffA);
            PG8_WAIT_V(8); PG8_WAIT_L(0); PG8_BAR; PG8_MMA(1, 0, At, B0); PG8_MMA(1, 1, At, B1); PG8_BAR; PG8_SCHED;
            PG8_LDB(B0, 1, 0); PG8_LDB(B1, 1, 1); PG8_SCHED; PG8_LDA(At, 1, 0); PG8_STAGE(PG8_SA(0, 1), a2 + hstep, voffA);
            PG8_WAIT_V(8); PG8_WAIT_L(0); PG8_BAR; PG8_MMA(0, 0, At, B0); PG8_MMA(0, 1, At, B1); PG8_BAR; PG8_SCHED;
            PG8_LDA(At, 1, 1); PG8_STAGE(PG8_SB(1, 0), b3, voffB); PG8_STAGE(PG8_SB(1, 1), b3 + hstep, voffB); PG8_STAGE(PG8_SA(1, 0), a3, voffA);
            PG8_WAIT_V(8); PG8_WAIT_L(0); PG8_BAR; PG8_MMA(1, 0, At, B0); PG8_MMA(1, 1, At, B1); PG8_BAR; PG8_SCHED;
            } else {
            PG8_LDB(B0, 0, 0); PG8_SCHED; PG8_LDA(At, 0, 0); PG8_STAGE(PG8_SA(1, 1), a1 + hstep, voffA);
            PG8_WAIT_L(8); PG8_BAR; PG8_WAIT_L(0); PG8_MMA(0, 0, At, B0); PG8_BAR; PG8_SCHED;
            PG8_LDB(B1, 0, 1); PG8_STAGE(PG8_SB(0, 0), b2, voffB);
            PG8_BAR; PG8_WAIT_L(0); PG8_MMA(0, 1, At, B1); PG8_BAR;
            PG8_LDA(At, 0, 1); PG8_STAGE(PG8_SA(0, 0), a2, voffA);
            PG8_BAR; PG8_WAIT_L(0); PG8_MMA(1, 0, At, B0); PG8_BAR; PG8_SCHED;
            PG8_STAGE(PG8_SB(0, 1), b2 + hstep, voffB);
            PG8_WAIT_V(6); PG8_BAR; PG8_MMA(1, 1, At, B1); PG8_BAR;
            PG8_LDB(B0, 1, 0); PG8_SCHED; PG8_LDA(At, 1, 0); PG8_STAGE(PG8_SA(0, 1), a2 + hstep, voffA);
            PG8_WAIT_L(8); PG8_BAR; PG8_WAIT_L(0); PG8_MMA(0, 0, At, B0); PG8_BAR; PG8_SCHED;
            PG8_LDB(B1, 1, 1); PG8_STAGE(PG8_SB(1, 0), b3, voffB);
            PG8_BAR; PG8_WAIT_L(0); PG8_MMA(0, 1, At, B1); PG8_BAR;
            PG8_LDA(At, 1, 1); PG8_STAGE(PG8_SA(1, 0), a3, voffA);
            PG8_BAR; PG8_WAIT_L(0); PG8_MMA(1, 0, At, B0); PG8_BAR; PG8_SCHED;
            PG8_STAGE(PG8_SB(1, 1), b3 + hstep, voffB);
            PG8_WAIT_V(6); PG8_BAR; PG8_MMA(1, 1, At, B1); PG8_BAR;
            }
        }
        if constexpr (ALIGN_EPI) { if (wr == 0) PG8_BAR; }
        if constexpr (!Epi::AFTER_DRAIN) { E(acc, cur, wr, wc, fr, fq); S.done(cur); }
        if (!has_next) break;
#pragma unroll
        for (int a = 0; a < 2; ++a)
#pragma unroll
            for (int b = 0; b < 2; ++b)
#pragma unroll
                for (int m = 0; m < 4; ++m)
#pragma unroll
                    for (int n = 0; n < 2; ++n) acc[a][b][m][n] = (f32x4){0.f, 0.f, 0.f, 0.f};
        cur = nxt; cA = nA; cB = nB; ++ui;
        if constexpr (ALIGN_EPI) { if (wr == 1) PG8_BAR; }
    }
    PG8_WAIT_V(0);
    if constexpr (!ALIGN_EPI) { if (wr == 0) PG8_BAR; }
    PG8_BAR;
    if constexpr (Epi::AFTER_DRAIN) { E.fused(acc, cur, wr, wc, fr, fq, lds, wid, lane); S.done(cur); }
#undef PG8_SA
#undef PG8_SB
#undef PG8_STAGE
#undef PG8_LDA
#undef PG8_LDB
#undef PG8_MMA
#undef PG8_WAIT_V
#undef PG8_WAIT_L
#undef PG8_BAR
#undef PG8_SCHED
}
template <class Epi, class Sched>
__device__ __forceinline__ void gemm_phase_g(PG8_LAS unsigned char* lds, const Gemm g, const Sched& S, const Epi& E) {
    int tid_ = threadIdx.x; asm volatile("" : "+v"(tid_));
    const int tid = tid_, wid = __builtin_amdgcn_readfirstlane(tid >> 6), lane = tid & 63, wr = wid >> 2, wc = wid & 3, fr = lane & 15, fq = lane >> 4;
    const int K = g.K, nt = K / BK;
    unsigned voffA[2], voffB[2];
#pragma unroll
    for (int i = 0; i < 2; ++i) { int R, C; stage_rc(tid * 16 + i * 8192, R, C); const int Rb = Epi::PERM ? ((R & ~31) + perm32(R & 31)) : R;
        voffA[i] = (unsigned)(R * K + C) * 2u; voffB[i] = (unsigned)(Rb * K + C) * 2u; }
    const size_t kstep = (size_t)(BK * 2);
    const size_t hstep = (size_t)HALF * K * 2;
    const size_t tstep = 2 * hstep;
    const unsigned ldsw = (unsigned)wid * 1024u;
    const int aoff = lds_byte(wr * 64 + fr, fq * 8), boff = lds_byte(wc * 32 + fr, fq * 8);
#define PG8_SA(b, h) (((b) * 2 + (h)) * HTB)
#define PG8_SB(b, h) ((4 + (b) * 2 + (h)) * HTB)
#define PG8_STAGE(bufoff, gbase, voff) do { _Pragma("unroll") for (int _i = 0; _i < 2; ++_i) \
        __builtin_amdgcn_global_load_lds((const unsigned*)((const char*)(gbase) + (voff)[_i]), (PG8_LAS unsigned*)(lds + (bufoff) + ldsw + _i * 8192), 16, 0, 0); } while (0)
#define PG8_STAGE_A(bufoff, kt, o) do { _Pragma("unroll") for (int _i = 0; _i < 2; ++_i) \
        __builtin_amdgcn_global_load_lds((const unsigned*)((const char*)g.A + (size_t)(kt) * kstep + (o)[_i]), (PG8_LAS unsigned*)(lds + (bufoff) + ldsw + _i * 8192), 16, 0, 0); } while (0)
#define PG8_LDA(dst, b, h) do { _Pragma("unroll") for (int m = 0; m < 4; ++m) _Pragma("unroll") for (int k = 0; k < 2; ++k) dst[m][k] = *(const PG8_LAS bf16x8*)(lds + PG8_SA(b, h) + aoff + m * 2048 + k * 1024); } while (0)
#define PG8_LDB(dst, b, h) do { _Pragma("unroll") for (int n = 0; n < 2; ++n) _Pragma("unroll") for (int k = 0; k < 2; ++k) dst[n][k] = *(const PG8_LAS bf16x8*)(lds + PG8_SB(b, h) + boff + n * 2048 + k * 1024); } while (0)
#define PG8_MMA(ai, bj, At, Bt) do { __builtin_amdgcn_s_setprio(1); _Pragma("unroll") for (int m = 0; m < 4; ++m) _Pragma("unroll") for (int n = 0; n < 2; ++n) _Pragma("unroll") for (int k = 0; k < 2; ++k) \
        acc[ai][bj][m][n] = __builtin_amdgcn_mfma_f32_16x16x32_bf16(Bt[n][k], At[m][k], acc[ai][bj][m][n], 0, 0, 0); __builtin_amdgcn_s_setprio(0); } while (0)
#define PG8_WAIT_V(n) asm volatile("s_waitcnt vmcnt(" #n ")" ::: "memory")
#define PG8_WAIT_L(n) asm volatile("s_waitcnt lgkmcnt(" #n ")" ::: "memory")
#define PG8_BAR __builtin_amdgcn_s_barrier()
#define PG8_SCHED __builtin_amdgcn_sched_barrier(0)
    Unit cur, nxt; int ui = 0;
    if (!S.next(0, cur)) return;
    f32x4 acc[2][2][4][2];
#pragma unroll
    for (int a = 0; a < 2; ++a)
#pragma unroll
        for (int b = 0; b < 2; ++b)
#pragma unroll
            for (int m = 0; m < 4; ++m)
#pragma unroll
                for (int n = 0; n < 2; ++n) acc[a][b][m][n] = (f32x4){0.f, 0.f, 0.f, 0.f};
    bf16x8 At[4][2], B0[2][2], B1[2][2];
    const char* cB = (const char*)g.Bt + (size_t)cur.pn * tstep;
    S.a_ready(cur);
    int R0_, C0_; stage_rc(tid * 16, R0_, C0_);
    unsigned oc[2][2], on[2][2];
    S.a_offsets(cur, R0_, C0_ * 2, K, oc);
    if constexpr (true) {
        PG8_STAGE(PG8_SB(0, 0), cB, voffB); PG8_STAGE(PG8_SB(0, 1), cB + hstep, voffB); PG8_STAGE_A(PG8_SA(0, 0), 0, oc[0]); PG8_STAGE_A(PG8_SA(0, 1), 0, oc[1]);
        if (wr == 1) PG8_BAR;
        PG8_WAIT_V(2); PG8_BAR;
        PG8_STAGE(PG8_SB(1, 0), cB + kstep, voffB); PG8_STAGE_A(PG8_SA(1, 0), 1, oc[0]); PG8_STAGE(PG8_SB(1, 1), cB + hstep + kstep, voffB);
        PG8_WAIT_V(6); PG8_BAR;
    }
    for (;;) {
        const bool has_next = S.next(ui + 1, nxt);
        const char* nB = has_next ? (const char*)g.Bt + (size_t)nxt.pn * tstep : cB;
        if (has_next) S.a_offsets(nxt, R0_, C0_ * 2, K, on); else { on[0][0] = oc[0][0]; on[0][1] = oc[0][1]; on[1][0] = oc[1][0]; on[1][1] = oc[1][1]; }
        for (int t = 0; t < nt; t += 2) {
            const bool last = (t == nt - 2);
            const char* b2 = last ? nB : cB + (size_t)(t + 2) * kstep;
            const char* b3 = b2 + kstep;
            const int kt2 = last ? 0 : t + 2;
            unsigned o2[2][2];
            o2[0][0] = last ? on[0][0] : oc[0][0]; o2[0][1] = last ? on[0][1] : oc[0][1]; o2[1][0] = last ? on[1][0] : oc[1][0]; o2[1][1] = last ? on[1][1] : oc[1][1];
            if (last && has_next) S.a_ready(nxt);
            if constexpr (true) {
            PG8_LDB(B0, 0, 0); PG8_LDB(B1, 0, 1); PG8_SCHED; PG8_LDA(At, 0, 0); PG8_STAGE_A(PG8_SA(1, 1), t + 1, oc[1]);
            PG8_WAIT_V(8); PG8_WAIT_L(0); PG8_BAR; PG8_MMA(0, 0, At, B0); PG8_MMA(0, 1, At, B1); PG8_BAR; PG8_SCHED;
            PG8_LDA(At, 0, 1); PG8_STAGE(PG8_SB(0, 0), b2, voffB); PG8_STAGE(PG8_SB(0, 1), b2 + hstep, voffB); PG8_STAGE_A(PG8_SA(0, 0), kt2, o2[0]);
            PG8_WAIT_V(8); PG8_WAIT_L(0); PG8_BAR; PG8_MMA(1, 0, At, B0); PG8_MMA(1, 1, At, B1); PG8_BAR; PG8_SCHED;
            PG8_LDB(B0, 1, 0); PG8_LDB(B1, 1, 1); PG8_SCHED; PG8_LDA(At, 1, 0); PG8_STAGE_A(PG8_SA(0, 1), kt2, o2[1]);
            PG8_WAIT_V(8); PG8_WAIT_L(0); PG8_BAR; PG8_MMA(0, 0, At, B0); PG8_MMA(0, 1, At, B1); PG8_BAR; PG8_SCHED;
            PG8_LDA(At, 1, 1); PG8_STAGE(PG8_SB(1, 0), b3, voffB); PG8_STAGE(PG8_SB(1, 1), b3 + hstep, voffB); PG8_STAGE_A(PG8_SA(1, 0), kt2 + 1, o2[0]);
            PG8_WAIT_V(8); PG8_WAIT_L(0); PG8_BAR; PG8_MMA(1, 0, At, B0); PG8_MMA(1, 1, At, B1); PG8_BAR; PG8_SCHED;
            }
        }
        if constexpr (true) { if (wr == 0) PG8_BAR; }
        if constexpr (!Epi::AFTER_DRAIN) { E(acc, cur, wr, wc, fr, fq); S.done(cur); }
        if (!has_next) break;
#pragma unroll
        for (int a = 0; a < 2; ++a)
#pragma unroll
            for (int b = 0; b < 2; ++b)
#pragma unroll
                for (int m = 0; m < 4; ++m)
#pragma unroll
                    for (int n = 0; n < 2; ++n) acc[a][b][m][n] = (f32x4){0.f, 0.f, 0.f, 0.f};
        cur = nxt; cB = nB; ++ui; oc[0][0] = on[0][0]; oc[0][1] = on[0][1]; oc[1][0] = on[1][0]; oc[1][1] = on[1][1];
        if constexpr (true) { if (wr == 1) PG8_BAR; }
    }
    PG8_WAIT_V(0);
    if constexpr (false) { if (wr == 0) PG8_BAR; }
    PG8_BAR;
    if constexpr (Epi::AFTER_DRAIN) { E.fused(acc, cur, wr, wc, fr, fq, lds, wid, lane); S.done(cur); }
#undef PG8_SA
#undef PG8_SB
#undef PG8_STAGE
#undef PG8_STAGE_A
#undef PG8_LDA
#undef PG8_LDB
#undef PG8_MMA
#undef PG8_WAIT_V
#undef PG8_WAIT_L
#undef PG8_BAR
#undef PG8_SCHED
}
}

#define PG8_SP2 true
#define PG8_ALIGN true
template <class RowMap>
__device__ __forceinline__ void transpose_item(const float* W, int K, int N, bf16* WT, const RowMap& rm, LAS float* scr, int item, int lane) {
    const int nblk = N / 32, kb = item / nblk, nb = item % nblk, k0 = 64 * kb, n0 = 32 * nb;
    {
        f32x4 v[8];
#pragma unroll
        for (int i = 0; i < 8; ++i) v[i] = *(const f32x4*)(W + (size_t)(k0 + 8 * i + (lane >> 3)) * N + n0 + 4 * (lane & 7));
#pragma unroll
        for (int i = 0; i < 8; ++i) { LAS float* d = scr + (8 * i + (lane >> 3)) * 33 + 4 * (lane & 7); d[0] = v[i][0]; d[1] = v[i][1]; d[2] = v[i][2]; d[3] = v[i][3]; }
    }
    asm volatile("s_waitcnt lgkmcnt(0)" ::: "memory");
    const int c = lane & 7;
#pragma unroll
    for (int j = 0; j < 4; ++j) { const int n = (lane >> 3) + 8 * j; const LAS float* sp = scr + (8 * c) * 33 + n;
        v4u o; o.x = pk2(sp[0 * 33], sp[1 * 33]); o.y = pk2(sp[2 * 33], sp[3 * 33]); o.z = pk2(sp[4 * 33], sp[5 * 33]); o.w = pk2(sp[6 * 33], sp[7 * 33]);
        *(v4u*)(WT + (size_t)rm(n0 + n) * K + k0 + 8 * c) = o; }
    asm volatile("s_waitcnt lgkmcnt(0)" ::: "memory");
}
struct RowId { __device__ __forceinline__ int operator()(int n) const { return n; } };
struct RowGU { int off; __device__ __forceinline__ int operator()(int n) const { return 256 * (n >> 7) + (n & 127) + off; } };
__device__ __forceinline__ void conv_small_weights(const Ctx& c) {
    LAS float* scr = (LAS float*)c.lds + c.wave * 4096;
    constexpr int I_IN = (D / 64) * (DIN / 32), I_OUT = (D / 64) * (D / 32);
    for (int it = c.gw; it < I_IN + I_OUT; it += c.NGW) {
        if (it < I_IN) transpose_item(inp(c, 10), D, DIN, (bf16*)(c.ws + WS_WIN_T), RowId{}, scr, it, c.lane);
        else transpose_item(inp(c, 23), D, D, (bf16*)(c.ws + WS_WOUT_T), RowId{}, scr, it - I_IN, c.lane);
    }
}
__device__ __forceinline__ void conv_moe_weights(const Ctx& c) {
    LAS float* scr = (LAS float*)c.lds + c.wave * 4096;
    constexpr int I_G = (D / 64) * (DE / 32), I_D = (DE / 64) * (D / 32), PER_E = 2 * I_G + I_D;
    for (int it = c.gw; it < NE * PER_E; it += c.NGW) {
        const int e = it / PER_E; int r = it % PER_E;
        bf16* gu = (bf16*)(c.ws + WS_WGU_T) + (size_t)e * 1024 * 1024; bf16* dn = (bf16*)(c.ws + WS_WD_T) + (size_t)e * 1024 * 512;
        if (r < I_G) { transpose_item(inp(c, 28) + (size_t)e * D * DE, D, DE, gu, RowGU{0}, scr, r, c.lane); continue; } r -= I_G;
        if (r < I_G) { transpose_item(inp(c, 29) + (size_t)e * D * DE, D, DE, gu, RowGU{128}, scr, r, c.lane); continue; } r -= I_G;
        transpose_item(inp(c, 30) + (size_t)e * DE * D, DE, D, dn, RowId{}, scr, r, c.lane);
    }
}
__device__ __forceinline__ v4u pack8(const f32x4 a, const f32x4 b) { v4u w; w.x = pg8::cvt_pk_bf16(a[0], a[1]); w.y = pg8::cvt_pk_bf16(a[2], a[3]); w.z = pg8::cvt_pk_bf16(b[0], b[1]); w.w = pg8::cvt_pk_bf16(b[2], b[3]); return w; }
struct EpiProj {
    static constexpr bool PERM = true, AFTER_DRAIN = false;
    unsigned char* ws;
    __device__ __forceinline__ void operator()(const f32x4 (&acc)[2][2][4][2], const pg8::Unit& un, int wr, int wc, int fr, int fq) const {
        const int colt = un.pn * 256, reg = colt >> 9;
        const size_t off = WS_XM + (size_t)(reg & 1) * (WS_Z - WS_XM) + (size_t)(reg >> 1) * (WS_U - WS_XM);
        bf16* base = (bf16*)(ws + off);
        const int lc0 = (colt & 511) + wc * 32 + 8 * fq, row0 = un.pm * 256 + wr * 64 + fr;
#pragma unroll
        for (int ai = 0; ai < 2; ++ai)
#pragma unroll
            for (int m = 0; m < 4; ++m) { bf16* rowp = base + (size_t)(row0 + ai * 128 + m * 16) * DM + lc0;
#pragma unroll
                for (int bj = 0; bj < 2; ++bj) *(v4u*)(rowp + bj * 128) = pack8(acc[ai][bj][m][0], acc[ai][bj][m][1]); }
    }
};
struct EpiY {
    static constexpr bool PERM = false, AFTER_DRAIN = false;
    float* Y;
    __device__ __forceinline__ void operator()(const f32x4 (&acc)[2][2][4][2], const pg8::Unit& un, int wr, int wc, int fr, int fq) const {
        const int row0 = un.pm * 256 + wr * 64 + fr, col0 = un.pn * 256 + wc * 32 + 4 * fq;
#pragma unroll
        for (int ai = 0; ai < 2; ++ai)
#pragma unroll
            for (int m = 0; m < 4; ++m) { float* rowp = Y + (size_t)(row0 + ai * 128 + m * 16) * D + col0;
#pragma unroll
                for (int bj = 0; bj < 2; ++bj)
#pragma unroll
                    for (int n = 0; n < 2; ++n) *(f32x4*)(rowp + bj * 128 + n * 16) = acc[ai][bj][m][n]; }
    }
};
struct EpiSwiGLU {
    static constexpr bool PERM = true, AFTER_DRAIN = false;
    bf16* act; const float* roww; const volatile LAS int* ts;
    __device__ __forceinline__ void operator()(const f32x4 (&acc)[2][2][4][2], const pg8::Unit& un, int wr, int wc, int fr, int fq) const {
        const int e = un.pn >> 2, row0 = un.pm * 256 + wr * 64 + fr, col0 = (un.pn & 3) * 128 + wc * 32 + 8 * fq, slot0 = (un.pm - ts[e]) * 256 + wr * 64 + fr, cnt = ts[17 + e];
#pragma unroll
        for (int ai = 0; ai < 2; ++ai)
#pragma unroll
            for (int m = 0; m < 4; ++m) { const int row = row0 + ai * 128 + m * 16, slot = slot0 + ai * 128 + m * 16; const float w = slot < cnt ? roww[(size_t)e * T + slot] : 0.f;
                f32x4 o[2];
#pragma unroll
                for (int n = 0; n < 2; ++n)
#pragma unroll
                    for (int i = 0; i < 4; ++i) { const float g = acc[ai][0][m][n][i], uu = acc[ai][1][m][n][i]; o[n][i] = siluf(g) * uu * w; }
                *(v4u*)(act + (size_t)row * DE + col0) = pack8(o[0], o[1]); }
    }
};
struct EpiDown {
    static constexpr bool PERM = true, AFTER_DRAIN = false;
    bf16* yrow;
    __device__ __forceinline__ void operator()(const f32x4 (&acc)[2][2][4][2], const pg8::Unit& un, int wr, int wc, int fr, int fq) const {
        const int row0 = un.pm * 256 + wr * 64 + fr, col0 = (un.pn & 3) * 256 + wc * 32 + 8 * fq;
#pragma unroll
        for (int ai = 0; ai < 2; ++ai)
#pragma unroll
            for (int m = 0; m < 4; ++m) { bf16* rowp = yrow + (size_t)(row0 + ai * 128 + m * 16) * D + col0;
#pragma unroll
                for (int bj = 0; bj < 2; ++bj) *(v4u*)(rowp + bj * 128) = pack8(acc[ai][bj][m][0], acc[ai][bj][m][1]); }
    }
};
struct MoeOrder {
    int G, c; const volatile LAS int* ts; const int* rowtok;
    __device__ __forceinline__ bool next(int i, pg8::Unit& u) const {
        const int L = i * G + c; if (L >= ts[16] * 4) return false;
        const int mt = L >> 2; int e = 0;
#pragma unroll
        for (int j = 1; j < 16; ++j) e += (mt >= ts[j]) ? 1 : 0;
        u.pm = mt; u.pn = e * 4 + (L & 3); return true;
    }
    __device__ __forceinline__ void a_offsets(const pg8::Unit& u, int R0, int Cb, int K, unsigned (&o)[2][2]) const {
        const int e = u.pn >> 2, base = (u.pm - ts[e]) * 256 + R0, cnt = ts[17 + e];
#pragma unroll
        for (int h = 0; h < 2; ++h)
#pragma unroll
            for (int i = 0; i < 2; ++i) { const int slot = base + 128 * h + 64 * i; const int tok = slot < cnt ? rowtok[(size_t)e * T + slot] : 0; o[h][i] = (unsigned)tok * (unsigned)(K * 2) + (unsigned)Cb; }
    }
    __device__ __forceinline__ void a_ready(const pg8::Unit&) const {}
    __device__ __forceinline__ void done(const pg8::Unit&) const {}
};
__device__ __forceinline__ int vcu_of(const Ctx& c) { return (c.G % 8 == 0) ? (c.bid % 8) * (c.G / 8) + c.bid / 8 : c.bid; }
__device__ __forceinline__ void moe_tile_table(const Ctx& c, volatile LAS int* ts) {
    if (c.tid == 0) {
        const unsigned* cnt = (const unsigned*)(c.ws + WS_CTL) + CW_CNT; int acc = 0;
        for (int e = 0; e < 16; ++e) { const unsigned n = __hip_atomic_load(cnt + e, __ATOMIC_RELAXED, __HIP_MEMORY_SCOPE_AGENT); ts[e] = acc; ts[17 + e] = (int)n; acc += (int)((n + 255u) >> 8); }
        ts[16] = acc;
    }
    __syncthreads();
}

__device__ __forceinline__ void g1_gemm1(const Ctx& c) {
    pg8::Gemm g{(const bf16*)(c.ws + WS_H), (const bf16*)(c.ws + WS_WIN_T), NT, DIN, D};
    pg8::StaticOrder S; S.init(NT, DIN, c.G, c.bid);
    EpiProj E{c.ws};
    pg8::gemm_phase<EpiProj, pg8::StaticOrder, PG8_ALIGN, PG8_SP2>((LAS unsigned char*)c.lds, g, S, E);
}
__device__ __forceinline__ void g2_outproj(const Ctx& c) {
    pg8::Gemm g{(const bf16*)(c.ws + WS_H), (const bf16*)(c.ws + WS_WOUT_T), T, D, D};
    pg8::StaticOrder S; S.init(T, D, c.G, c.bid);
    EpiY E{(float*)(c.ws + WS_Y)};
    pg8::gemm_phase<EpiY, pg8::StaticOrder, PG8_ALIGN, PG8_SP2>((LAS unsigned char*)c.lds, g, S, E);
}
__device__ __forceinline__ void g3_moe_up(const Ctx& c, volatile LAS int* ts) {
    moe_tile_table(c, ts);
    pg8::Gemm g{(const bf16*)(c.ws + WS_H), (const bf16*)(c.ws + WS_WGU_T), 0, 0, D};
    MoeOrder S{c.G, vcu_of(c), ts, (const int*)(c.ws + WS_ROWTOK)};
    EpiSwiGLU E{(bf16*)(c.ws + WS_ACTS), (const float*)(c.ws + WS_ROWW), ts};
    pg8::gemm_phase_g<EpiSwiGLU, MoeOrder>((LAS unsigned char*)c.lds, g, S, E);
}
__device__ __forceinline__ void g4_moe_down(const Ctx& c, volatile LAS int* ts) {
    moe_tile_table(c, ts);
    pg8::Gemm g{(const bf16*)(c.ws + WS_ACTS), (const bf16*)(c.ws + WS_WD_T), 0, 0, DE};
    MoeOrder S{c.G, vcu_of(c), ts, (const int*)(c.ws + WS_ROWTOK)};
    EpiDown E{(bf16*)(c.ws + WS_YROW)};
    pg8::gemm_phase<EpiDown, MoeOrder, PG8_ALIGN, PG8_SP2>((LAS unsigned char*)c.lds, g, S, E);
}

__device__ __forceinline__ void p10b_token(const Ctx& c) {
    const float* x = inp(c, 0); const float* g_post = inp(c, 7); const float* g_ffn = inp(c, 8);
    const float* wrg = inp(c, 24); const float* brg = inp(c, 25); const float* wre = inp(c, 26); const float* bre = inp(c, 27);
    const float* mod = (const float*)(c.ws + WS_MOD);
    const float* posR = (const float*)(c.ws + WS_POSR); const float* posC = (const float*)(c.ws + WS_POSC);
    const float* Y = (const float*)(c.ws + WS_Y); bf16* H2 = (bf16*)(c.ws + WS_H); int* RE = (int*)(c.ws + WS_RE); int* RS = (int*)(c.ws + WS_RS);
    unsigned* CNT = (unsigned*)(c.ws + WS_CTL) + CW_CNT;
    constexpr int WRS = 1028;
    LAS float* WRt = (LAS float*)c.lds;
    int* hist = (int*)(c.lds + 20 * WRS); int* gbase = hist + 16; int* tinfo = hist + 32;
    for (int idx = c.tid; idx < 1024 * 20; idx += NTHREADS) {
        const int col = idx / 20, o = idx % 20;
        WRt[o * WRS + col] = o < 4 ? wrg[col * 4 + o] : wre[col * 16 + (o - 4)];
    }
    if (c.tid < 32) hist[c.tid] = 0;
    __syncthreads();
    int li = 0;
    constexpr int RB = 2;
    for (int rb = c.gw; rb < T; rb += RB * c.NGW) {
      asm volatile("" ::: "memory");
      f32x4 xva[RB][4], yva[RB][4];
#pragma unroll
      for (int b = 0; b < RB; ++b) {
          const int r = rb + b * c.NGW;
          const int rr = r < T ? r : rb;
#pragma unroll
          for (int j = 0; j < 4; ++j) {
              const int col = 256 * j + 4 * c.lane;
              const float* pp = col < 512 ? posR + (rr >> 6) * 512 + col : posC + (rr & 63) * 512 + (col - 512);
              xva[b][j] = *(const f32x4*)(x + (size_t)rr * D + col) + *(const f32x4*)pp;
              yva[b][j] = *(const f32x4*)(Y + (size_t)rr * D + col);
          }
      }
#pragma unroll
      for (int b = 0; b < RB; ++b) {
        const int r = rb + b * c.NGW; if (r >= T) continue;
        f32x4 xv[4], yv[4]; float ss = 0.f;
#pragma unroll
        for (int j = 0; j < 4; ++j) {
            xv[j] = xva[b][j]; yv[j] = yva[b][j];
            ss += yv[j].x * yv[j].x + yv[j].y * yv[j].y + yv[j].z * yv[j].z + yv[j].w * yv[j].w;
        }
        const float rinv = rsqrtf(wave_sum(ss) * (1.f / D) + EPS);
        float s2 = 0.f;
#pragma unroll
        for (int j = 0; j < 4; ++j) {
            const int col = 256 * j + 4 * c.lane;
            const f32x4 gg = *(const f32x4*)(g_post + col), g1 = *(const f32x4*)(mod + 2048 + col);
            xv[j] = xv[j] + g1 * (yv[j] * rinv * gg);
            *(f32x4*)(c.out + (size_t)r * D + col) = xv[j];
            s2 += xv[j].x * xv[j].x + xv[j].y * xv[j].y + xv[j].z * xv[j].z + xv[j].w * xv[j].w;
        }
        const float rinv2 = rsqrtf(wave_sum(s2) * (1.f / D) + EPS);
        float lg[20];
#pragma unroll
        for (int i = 0; i < 20; ++i) lg[i] = 0.f;
#pragma unroll
        for (int j = 0; j < 4; ++j) {
            const int col = 256 * j + 4 * c.lane;
            const f32x4 gg = *(const f32x4*)(g_ffn + col), sh = *(const f32x4*)(mod + 3072 + col), sc = *(const f32x4*)(mod + 4096 + col);
            const f32x4 hv = xv[j] * rinv2 * gg * (sc + 1.f) + sh;
            uint2 w; w.x = pk2(hv.x, hv.y); w.y = pk2(hv.z, hv.w);
            *(uint2*)(H2 + (size_t)r * D + col) = w;
#pragma unroll
            for (int o = 0; o < 20; ++o) { const f32x4 w4 = *(const LAS f32x4*)(WRt + o * WRS + col); lg[o] += hv.x * w4.x + hv.y * w4.y + hv.z * w4.z + hv.w * w4.w; }
        }
#pragma unroll
        for (int i = 0; i < 20; ++i) lg[i] = wave_sum(lg[i]);
        if (c.lane == 0) {
            float gl[4];
#pragma unroll
            for (int i = 0; i < 4; ++i) gl[i] = lg[i] + brg[i];
            int gs = 0; float gm = gl[0];
#pragma unroll
            for (int i = 1; i < 4; ++i) if (gl[i] > gm) { gm = gl[i]; gs = i; }
            float den = 0.f;
#pragma unroll
            for (int i = 0; i < 4; ++i) den += __expf(gl[i] - gm);
            const float psel = 1.f / den;
            float el[4];
#pragma unroll
            for (int i = 0; i < 4; ++i) {
                float v = 0.f;
#pragma unroll
                for (int g2 = 0; g2 < 4; ++g2) v = (g2 == gs) ? lg[4 + g2 * 4 + i] + bre[g2 * 4 + i] : v;
                el[i] = v;
            }
            int i1 = 0; float em1 = el[0];
#pragma unroll
            for (int i = 1; i < 4; ++i) if (el[i] > em1) { em1 = el[i]; i1 = i; }
            int i2 = -1; float em2 = -INFINITY;
#pragma unroll
            for (int i = 0; i < 4; ++i) if (i != i1 && el[i] > em2) { em2 = el[i]; i2 = i; }
            const float e2 = __expf(em2 - em1), w1 = psel / (1.f + e2), w2 = psel * e2 / (1.f + e2);
            const int ea = gs * 4 + i1, eb = gs * 4 + i2;
            RE[2 * r] = ea; RE[2 * r + 1] = eb;
            int* ti = tinfo + (c.wave * 8 + li) * 8;
            ti[0] = ea; ti[1] = eb; ti[2] = atomicAdd(hist + ea, 1); ti[3] = atomicAdd(hist + eb, 1); ti[4] = __float_as_int(w1); ti[5] = __float_as_int(w2);
        }
        ++li;
      }
    }
    __syncthreads();
    if (c.tid < 16) gbase[c.tid] = (int)__hip_atomic_fetch_add(CNT + c.tid, (unsigned)hist[c.tid], __ATOMIC_RELAXED, __HIP_MEMORY_SCOPE_AGENT);
    __syncthreads();
    if (c.lane < li) {
        const int r = c.gw + c.lane * c.NGW; const int* ti = tinfo + (c.wave * 8 + c.lane) * 8;
        const int s0 = gbase[ti[0]] + ti[2], s1 = gbase[ti[1]] + ti[3];
        RS[2 * r] = s0; RS[2 * r + 1] = s1;
        int* ROWTOK = (int*)(c.ws + WS_ROWTOK); float* ROWW = (float*)(c.ws + WS_ROWW);
        ROWTOK[(size_t)ti[0] * T + s0] = r; ROWTOK[(size_t)ti[1] * T + s1] = r; ROWW[(size_t)ti[0] * T + s0] = __int_as_float(ti[4]); ROWW[(size_t)ti[1] * T + s1] = __int_as_float(ti[5]);
    }
    __syncthreads();
}
__device__ __forceinline__ void p10c_scatter(const Ctx& c) {
    const bf16* H2 = (const bf16*)(c.ws + WS_H); bf16* AS = (bf16*)(c.ws + WS_ASORT);
    const int* RE = (const int*)(c.ws + WS_RE); const float* RW = (const float*)(c.ws + WS_RW); int* RS = (int*)(c.ws + WS_RS); float* ROWW = (float*)(c.ws + WS_ROWW);
    const unsigned* CNT = (const unsigned*)(c.ws + WS_CTL) + CW_CNT;
    for (int r = c.gw; r < T; r += c.NGW) {
        asm volatile("" ::: "memory");
        const int e0 = RE[2 * r], e1 = RE[2 * r + 1]; int b0 = 0, b1 = 0;
        for (int e = 0; e < 16; ++e) { const int tl = (int)((CNT[e] + 255u) >> 8) * 256; b0 += e < e0 ? tl : 0; b1 += e < e1 ? tl : 0; }
        const int r0 = b0 + RS[2 * r], r1 = b1 + RS[2 * r + 1];
        const v4u* src = (const v4u*)(H2 + (size_t)r * D);
        const v4u a = src[c.lane], b = src[c.lane + 64];
        v4u* d0 = (v4u*)(AS + (size_t)r0 * D); v4u* d1 = (v4u*)(AS + (size_t)r1 * D);
        d0[c.lane] = a; d0[c.lane + 64] = b; d1[c.lane] = a; d1[c.lane + 64] = b;
        if (c.lane == 0) { ROWW[r0] = RW[2 * r]; ROWW[r1] = RW[2 * r + 1]; RS[2 * r] = r0; RS[2 * r + 1] = r1; }
    }
}
__device__ __forceinline__ void p12b_final(const Ctx& c) {
    const float* g_post = inp(c, 9); const float* mod = (const float*)(c.ws + WS_MOD); const bf16* YR = (const bf16*)(c.ws + WS_YROW); const int* RS = (const int*)(c.ws + WS_RS);
    const int* RE = (const int*)(c.ws + WS_RE); const unsigned* CNT = (const unsigned*)(c.ws + WS_CTL) + CW_CNT;
    int tb = 0;
    { int acc = 0;
#pragma unroll
      for (int e = 0; e < 16; ++e) { tb = (c.lane == e) ? acc : tb; acc += (int)((CNT[e] + 255u) >> 8) * 256; } }
    constexpr int RB = 4;
    for (int rb = c.gw; rb < T; rb += RB * c.NGW) {
        asm volatile("" ::: "memory");
        uint2 ya[RB][4], yb[RB][4]; f32x4 xo[RB][4];
#pragma unroll
        for (int b = 0; b < RB; ++b) {
            const int r = rb + b * c.NGW < T ? rb + b * c.NGW : rb;
            const int e0 = RE[2 * r], e1 = RE[2 * r + 1];
            const int r0 = __shfl(tb, e0) + RS[2 * r], r1 = __shfl(tb, e1) + RS[2 * r + 1];
#pragma unroll
            for (int j = 0; j < 4; ++j) {
                const int col = 256 * j + 4 * c.lane;
                ya[b][j] = *(const uint2*)(YR + (size_t)r0 * D + col); yb[b][j] = *(const uint2*)(YR + (size_t)r1 * D + col);
                xo[b][j] = *(const f32x4*)(c.out + (size_t)r * D + col);
            }
        }
#pragma unroll
        for (int b = 0; b < RB; ++b) {
            const int r = rb + b * c.NGW; if (r >= T) continue;
            f32x4 yv[4]; float ss = 0.f;
#pragma unroll
            for (int j = 0; j < 4; ++j) {
                const uint2 a = ya[b][j], bb = yb[b][j];
                yv[j] = (f32x4){lo16(a.x) + lo16(bb.x), hi16(a.x) + hi16(bb.x), lo16(a.y) + lo16(bb.y), hi16(a.y) + hi16(bb.y)};
                ss += yv[j].x * yv[j].x + yv[j].y * yv[j].y + yv[j].z * yv[j].z + yv[j].w * yv[j].w;
            }
            const float rinv = rsqrtf(wave_sum(ss) * (1.f / D) + EPS);
#pragma unroll
            for (int j = 0; j < 4; ++j) {
                const int col = 256 * j + 4 * c.lane;
                const f32x4 gg = *(const f32x4*)(g_post + col), g2 = *(const f32x4*)(mod + 5120 + col);
                *(f32x4*)(c.out + (size_t)r * D + col) = xo[b][j] + g2 * (yv[j] * rinv * gg);
            }
        }
    }
}

typedef unsigned v2u __attribute__((ext_vector_type(2)));
typedef short s16x4 __attribute__((ext_vector_type(4)));
typedef short h8 __attribute__((ext_vector_type(8)));
constexpr int TSB = 288;
constexpr int TILE_B = 128 * TSB;
#define MFMA16(a, b, c) __builtin_amdgcn_mfma_f32_16x16x32_bf16((a), (b), (c), 0, 0, 0)
__device__ __forceinline__ h8 frag_row(const LAS unsigned char* tile, int stride_b, int row0, int k0, int lane) {
    return *(const LAS h8*)(tile + (row0 + (lane & 15)) * stride_b + (k0 + 8 * (lane >> 4)) * 2);
}
__device__ __forceinline__ h8 frag_tr(const LAS unsigned char* tile, int stride_b, int k0, int n0, int lane) {
    const int g = lane >> 4, q = (lane & 15) >> 2, p = lane & 3;
    const LAS unsigned char* a = tile + (k0 + 8 * g + q) * stride_b + (n0 + 4 * p) * 2;
    const s16x4 lo = __builtin_amdgcn_ds_read_tr16_b64_v4i16((LAS s16x4*)a);
    const s16x4 hi = __builtin_amdgcn_ds_read_tr16_b64_v4i16((LAS s16x4*)(a + 4 * stride_b));
    return __builtin_shufflevector(lo, hi, 0, 1, 2, 3, 4, 5, 6, 7);
}
__device__ __forceinline__ void lds_atomic_add(LAS float* p, float v) { __hip_atomic_fetch_add(p, v, __ATOMIC_RELAXED, __HIP_MEMORY_SCOPE_WORKGROUP); }


__device__ __forceinline__ void p4m_summaries(const Ctx& c) {
    const bf16* Kb = (const bf16*)(c.ws + WS_K); const bf16* Vb = (const bf16*)(c.ws + WS_V);
    const float* IG = (const float*)(c.ws + WS_IG); const float* LF = (const float*)(c.ws + WS_LF);
    float* LT = (float*)(c.ws + WS_L); float* NL = (float*)(c.ws + WS_NL); float* AMAX = (float*)(c.ws + WS_AMAX); float* BTOT = (float*)(c.ws + WS_BTOT);
    LAS unsigned char* L = (LAS unsigned char*)c.lds; LAS unsigned char* Ks = L; LAS unsigned char* Vs = L + TILE_B;
    LAS float* lfs = (LAS float*)(L + 2 * TILE_B); LAS float* as = lfs + 128; LAS float* red = as + 128;
    const int lane = c.lane, rt = c.wave >> 1, cg = c.wave & 1, fr = lane & 15, fg = lane >> 4;
    for (int it = c.bid; it < 2 * NH * NCH; it += c.G) {
        const int d = it / (NH * NCH), h = (it / NCH) % NH, j = it % NCH, r0 = chunk_row0(d, j);
        const float* lf = LF + (size_t)(d * 4 + h) * NT + r0; const float* ig = IG + (size_t)(d * 4 + h) * NT + r0;
        {
            const float lfv = c.tid < 128 ? lf[c.tid] : 0.f, igv = c.tid < 128 ? ig[c.tid] : 0.f;
            const float b = scan128<false>(lfv, d != 0, lfs, c.tid, c.lane, c.wave);
            if (c.tid == (d == 0 ? 127 : 0)) red[0] = b;
            __syncthreads();
            if (c.tid < 128) as[c.tid] = red[0] - b + igv;
        }
        __syncthreads();
        if (c.tid < 64) { float m = fmaxf(as[c.tid], as[c.tid + 64]);
#pragma unroll
            for (int o = 1; o < 64; o <<= 1) m = fmaxf(m, __shfl_xor(m, o));
            if (c.tid == 0) red[1] = m; }
        __syncthreads();
        const float amax = red[1], btot = red[0];
        for (int e = c.tid; e < 128 * 16; e += NTHREADS) {
            const int l = e >> 4, ch = e & 15; const float w = __expf(as[l] - amax);
            float f[8];
            unpack8(*(const v4u*)(Kb + (size_t)(r0 + l) * DM + h * DH + ch * 8), f);
            v4u o; o.x = pk2(f[0] * w, f[1] * w); o.y = pk2(f[2] * w, f[3] * w); o.z = pk2(f[4] * w, f[5] * w); o.w = pk2(f[6] * w, f[7] * w);
            *(LAS v4u*)(Ks + l * TSB + ch * 16) = o;
            *(LAS v4u*)(Vs + l * TSB + ch * 16) = *(const v4u*)(Vb + (size_t)(r0 + l) * DM + h * DH + ch * 8);
        }
        __syncthreads();
        f32x4 acc[2][4];
#pragma unroll
        for (int mt = 0; mt < 2; ++mt)
#pragma unroll
            for (int nt = 0; nt < 4; ++nt) acc[mt][nt] = (f32x4){0.f, 0.f, 0.f, 0.f};
#pragma unroll
        for (int ks = 0; ks < 4; ++ks) {
            h8 a[2], b[4];
#pragma unroll
            for (int mt = 0; mt < 2; ++mt) a[mt] = frag_tr(Vs, TSB, 32 * ks, 32 * rt + 16 * mt, lane);
#pragma unroll
            for (int nt = 0; nt < 4; ++nt) b[nt] = frag_tr(Ks, TSB, 32 * ks, 64 * cg + 16 * nt, lane);
#pragma unroll
            for (int mt = 0; mt < 2; ++mt)
#pragma unroll
                for (int nt = 0; nt < 4; ++nt) acc[mt][nt] = MFMA16(a[mt], b[nt], acc[mt][nt]);
        }
        float* dst = LT + (size_t)((d * 4 + h) * NCH + j) * 16384;
#pragma unroll
        for (int mt = 0; mt < 2; ++mt)
#pragma unroll
            for (int nt = 0; nt < 4; ++nt)
#pragma unroll
                for (int r = 0; r < 4; ++r) dst[(32 * rt + 16 * mt + 4 * fg + r) * 128 + 64 * cg + 16 * nt + fr] = acc[mt][nt][r];
        if (c.tid < 128) {
            float sacc = 0.f;
            for (int l = 0; l < 128; ++l) sacc += bf2f(*(const LAS bf16*)(Ks + l * TSB + c.tid * 2));
            NL[(size_t)((d * 4 + h) * NCH + j) * 128 + c.tid] = sacc;
            if (c.tid == 0) { AMAX[(d * 4 + h) * NCH + j] = amax; BTOT[(d * 4 + h) * NCH + j] = btot; }
        }
        __syncthreads();
    }
}

__device__ __forceinline__ void p8m_mlstm_out(const Ctx& c) {
    const bf16* Q = (const bf16*)(c.ws + WS_Q); const bf16* Kb = (const bf16*)(c.ws + WS_K); const bf16* Vb = (const bf16*)(c.ws + WS_V);
    const bf16* ACT = (const bf16*)(c.ws + WS_ACT); const bf16* Z = (const bf16*)(c.ws + WS_Z);
    const float* IG = (const float*)(c.ws + WS_IG); const float* LF = (const float*)(c.ws + WS_LF);
    const bf16* C0 = (const bf16*)(c.ws + WS_C0); const float* N0 = (const float*)(c.ws + WS_N0); const float* M0 = (const float*)(c.ws + WS_M0);
    const float* norm_w = inp(c, 20); const float* skip = inp(c, 21);
    bf16* A2 = (bf16*)(c.ws + WS_H);
    LAS unsigned char* L = (LAS unsigned char*)c.lds;
    LAS unsigned char* Qs = L; LAS unsigned char* Ks = L + TILE_B; LAS unsigned char* Vs = L + 2 * TILE_B; LAS unsigned char* Ss = L + 3 * TILE_B;
    LAS float* gs = (LAS float*)(L + 4 * TILE_B); LAS float* Ms = gs + 128; LAS float* wis = Ms + 128; LAS float* emt = wis + 128; LAS float* nqs = emt + 128; LAS float* qns = nqs + 128;
    LAS float* rsum = qns + 128; LAS float* rsq = rsum + 128; LAS float* lfs = rsq + 128; LAS float* nqp = lfs + 160;
    const int lane0 = c.lane, rt = c.wave >> 1, cg = c.wave & 1, fr0 = lane0 & 15, fg0 = lane0 >> 4;
    for (int it = c.bid; it < NH * NCL; it += c.G) {
        const int h = it / NCL, ck = it % NCL, r0 = ck * CH;
        for (int e = c.tid; e < 128 * 16; e += NTHREADS) {
            const int l = e >> 4, ch = e & 15; const size_t go = (size_t)(r0 + l) * DM + h * DH + ch * 8;
            *(LAS v4u*)(Qs + l * TSB + ch * 16) = *(const v4u*)(Q + go);
            *(LAS v4u*)(Ks + l * TSB + ch * 16) = *(const v4u*)(Kb + go);
            *(LAS v4u*)(Vs + l * TSB + ch * 16) = *(const v4u*)(Vb + go);
        }
        if (c.tid < 128) { rsum[c.tid] = 0.f; rsq[c.tid] = 0.f; }
        f32x4 hsum[2][4];
#pragma unroll
        for (int mt = 0; mt < 2; ++mt)
#pragma unroll
            for (int nt = 0; nt < 4; ++nt) hsum[mt][nt] = (f32x4){0.f, 0.f, 0.f, 0.f};
#pragma unroll 1
        for (int d = 0; d < 2; ++d) {
            const int sidx = (d * 4 + h) * NCL + (d == 0 ? ck : NCL - 1 - ck);
            const float m0 = M0[sidx];
            int fr = fr0, fg = fg0, lane = lane0;
            asm volatile("" : "+v"(fr), "+v"(fg), "+v"(lane));
            float lfv = 0.f, igv = 0.f;
            if (c.tid < 128) { lfv = LF[(size_t)(d * 4 + h) * NT + r0 + c.tid]; igv = IG[(size_t)(d * 4 + h) * NT + r0 + c.tid]; lfs[c.tid] = N0[(size_t)sidx * 128 + c.tid]; }
            const float bt = scan128<false>(lfv, d != 0, rsq + 128 + 128, c.tid, c.lane, c.wave);
            const float gval = igv - bt;
            const float cm = scan128<true>(c.tid < 128 ? gval : -INFINITY, d != 0, rsq + 128 + 128, c.tid, c.lane, c.wave);
            if (c.tid < 128) {
                gs[c.tid] = gval;
                const float M = fmaxf(m0, cm);
                Ms[c.tid] = M; wis[c.tid] = __expf(m0 - M); emt[c.tid] = __expf(-(bt + M)); nqs[c.tid] = 0.f;
                float qn = 0.f;
#pragma unroll 4
                for (int k8 = 0; k8 < 16; ++k8) {
                    float qf[8]; unpack8(*(const LAS v4u*)(Qs + c.tid * TSB + k8 * 16), qf);
#pragma unroll
                    for (int u = 0; u < 8; ++u) qn += qf[u] * lfs[k8 * 8 + u];
                }
                qns[c.tid] = qn;
            }
            __syncthreads();
            {
                f32x4 acc[2][4];
#pragma unroll
                for (int mt = 0; mt < 2; ++mt)
#pragma unroll
                    for (int nt = 0; nt < 4; ++nt) acc[mt][nt] = (f32x4){0.f, 0.f, 0.f, 0.f};
#pragma unroll 1
                for (int ks = 0; ks < 4; ++ks) {
                    h8 a[2], b[4];
#pragma unroll
                    for (int mt = 0; mt < 2; ++mt) a[mt] = frag_row(Ks, TSB, 32 * rt + 16 * mt, 32 * ks, lane);
#pragma unroll
                    for (int nt = 0; nt < 4; ++nt) b[nt] = frag_row(Qs, TSB, 64 * cg + 16 * nt, 32 * ks, lane);
#pragma unroll
                    for (int mt = 0; mt < 2; ++mt)
#pragma unroll
                        for (int nt = 0; nt < 4; ++nt) acc[mt][nt] = MFMA16(a[mt], b[nt], acc[mt][nt]);
                }
#pragma unroll
                for (int nt = 0; nt < 4; ++nt) {
                    const int t = 64 * cg + 16 * nt + fr; const float Mt = Ms[t]; float csum = 0.f;
#pragma unroll
                    for (int mt = 0; mt < 2; ++mt) {
                        const int s0 = 32 * rt + 16 * mt + 4 * fg; float v[4];
#pragma unroll
                        for (int r = 0; r < 4; ++r) {
                            const int s = s0 + r; const bool ok = d == 0 ? (s <= t) : (s >= t);
                            v[r] = ok ? acc[mt][nt][r] * __expf(gs[s] - Mt) : 0.f; csum += v[r];
                        }
                        v2u w; w.x = pk2(v[0], v[1]); w.y = pk2(v[2], v[3]);
                        *(LAS v2u*)(Ss + t * TSB + s0 * 2) = w;
                    }
                    csum += __shfl_xor(csum, 16); csum += __shfl_xor(csum, 32);
                    if (fg == 0) nqp[rt * 128 + t] = csum;
                }
            }
            __syncthreads();
            {
                f32x4 a1[2][4], a2[2][4];
#pragma unroll
                for (int mt = 0; mt < 2; ++mt)
#pragma unroll
                    for (int nt = 0; nt < 4; ++nt) { a1[mt][nt] = (f32x4){0.f, 0.f, 0.f, 0.f}; a2[mt][nt] = (f32x4){0.f, 0.f, 0.f, 0.f}; }
                h8 bc[4][4];
                {
                    const bf16* c0 = C0 + (size_t)sidx * 16384;
#pragma unroll
                    for (int ks = 0; ks < 4; ++ks)
#pragma unroll
                        for (int nt = 0; nt < 4; ++nt) bc[ks][nt] = *(const h8*)(c0 + (size_t)(64 * cg + 16 * nt + fr) * 128 + 32 * ks + 8 * fg);
                }
#pragma unroll
                for (int ks = 0; ks < 4; ++ks) {
                    h8 as_[2], aq[2], bv[4];
#pragma unroll
                    for (int mt = 0; mt < 2; ++mt) { as_[mt] = frag_row(Ss, TSB, 32 * rt + 16 * mt, 32 * ks, lane); aq[mt] = frag_row(Qs, TSB, 32 * rt + 16 * mt, 32 * ks, lane); }
#pragma unroll
                    for (int nt = 0; nt < 4; ++nt) bv[nt] = frag_tr(Vs, TSB, 32 * ks, 64 * cg + 16 * nt, lane);
#pragma unroll
                    for (int mt = 0; mt < 2; ++mt)
#pragma unroll
                        for (int nt = 0; nt < 4; ++nt) { a1[mt][nt] = MFMA16(as_[mt], bv[nt], a1[mt][nt]); a2[mt][nt] = MFMA16(aq[mt], bc[ks][nt], a2[mt][nt]); }
                }
#pragma unroll
                for (int mt = 0; mt < 2; ++mt)
#pragma unroll
                    for (int r = 0; r < 4; ++r) {
                        const int t = 32 * rt + 16 * mt + 4 * fg + r; const float wi = wis[t];
                        const float nq = (nqp[t] + nqp[128 + t]) + (nqp[256 + t] + nqp[384 + t]);
                        const float rden = 1.f / fmaxf(fabsf(nq + wi * qns[t]), emt[t]);
#pragma unroll
                        for (int nt = 0; nt < 4; ++nt) hsum[mt][nt][r] += (a1[mt][nt][r] + wi * a2[mt][nt][r]) * rden;
                    }
            }
            __syncthreads();
        }
        const int fr = fr0, fg = fg0;
#pragma unroll
        for (int mt = 0; mt < 2; ++mt)
#pragma unroll
            for (int r = 0; r < 4; ++r) {
                const int t = 32 * rt + 16 * mt + 4 * fg + r; float s1 = 0.f, s2 = 0.f;
#pragma unroll
                for (int nt = 0; nt < 4; ++nt) { const float x = hsum[mt][nt][r]; s1 += x; s2 += x * x; *(LAS bf16*)(Ss + t * TSB + (64 * cg + 16 * nt + fr) * 2) = (bf16)f2bf(x); }
#pragma unroll
                for (int o = 1; o < 16; o <<= 1) { s1 += __shfl_xor(s1, o); s2 += __shfl_xor(s2, o); }
                if (fr == 0) { lds_atomic_add(rsum + t, s1); lds_atomic_add(rsq + t, s2); }
            }
        __syncthreads();
        for (int e = c.tid; e < 128 * 16; e += NTHREADS) {
            const int t = e >> 4, ch = e & 15, col0 = h * DH + ch * 8; const size_t row = (size_t)(r0 + t);
            const float mu = rsum[t] * (1.f / 128.f), var = fmaxf(rsq[t] * (1.f / 128.f) - mu * mu, 0.f), rstd = rsqrtf(var + EPS);
            float hf[8], af[8], zf[8], o[8];
            unpack8(*(const LAS v4u*)(Ss + t * TSB + ch * 16), hf); unpack8(*(const v4u*)(ACT + row * DM + col0), af); unpack8(*(const v4u*)(Z + row * DM + col0), zf);
#pragma unroll
            for (int u = 0; u < 8; ++u) { const float hn = (hf[u] - mu) * rstd * norm_w[col0 + u]; o[u] = (hn + skip[col0 + u] * af[u]) * siluf(zf[u]); }
            v4u w; w.x = pk2(o[0], o[1]); w.y = pk2(o[2], o[3]); w.z = pk2(o[4], o[5]); w.w = pk2(o[6], o[7]);
            *(v4u*)(A2 + row * D + col0) = w;
        }
        __syncthreads();
    }
}


__device__ __forceinline__ void p6m_fourier_a(const Ctx& c) {
    const bf16* U = (const bf16*)(c.ws + WS_U); bf16* FB = (bf16*)c.out;
    LAS unsigned char* L = (LAS unsigned char*)c.lds; LAS unsigned char* Ws = L; LAS unsigned char* Us = L + 256 * TSB;
    constexpr int USB = 544;
    const int lane = c.lane, rt = c.wave >> 1, cg = c.wave & 1, fr = lane & 15, fg = lane >> 4;
    for (int e = c.tid; e < 256 * 128; e += NTHREADS) {
        const int row = e >> 7, t1 = e & 127, k1 = 16 * (row >> 5) + (row & 15), ri = (row >> 4) & 1;
        const float ph = (float)((k1 * t1) & 127) * (1.f / 64.f);
        *(LAS bf16*)(Ws + row * TSB + t1 * 2) = (bf16)f2bf(ri ? -sinpif(ph) : cospif(ph));
    }
    __syncthreads();
    for (int it = c.bid; it < 256; it += c.G) {
        const int t2 = it >> 1, nh = it & 1;
        for (int e = c.tid; e < 128 * 32; e += NTHREADS) {
            const int t1 = e >> 5, ch = e & 31;
            *(LAS v4u*)(Us + t1 * USB + ch * 16) = *(const v4u*)(U + (size_t)(128 * t1 + t2) * DM + 256 * nh + ch * 8);
        }
        __syncthreads();
#pragma unroll 1
        for (int np = 0; np < 2; ++np) {
            f32x4 acc[4][4];
#pragma unroll
            for (int mt = 0; mt < 4; ++mt)
#pragma unroll
                for (int nt = 0; nt < 4; ++nt) acc[mt][nt] = (f32x4){0.f, 0.f, 0.f, 0.f};
            const int n0 = 128 * cg + 64 * np;
#pragma unroll 1
            for (int ks = 0; ks < 4; ++ks) {
                h8 a[4], b[4];
#pragma unroll
                for (int mt = 0; mt < 4; ++mt) a[mt] = frag_row(Ws, TSB, 64 * rt + 16 * mt, 32 * ks, lane);
#pragma unroll
                for (int nt = 0; nt < 4; ++nt) b[nt] = frag_tr(Us, USB, 32 * ks, n0 + 16 * nt, lane);
#pragma unroll
                for (int mt = 0; mt < 4; ++mt)
#pragma unroll
                    for (int nt = 0; nt < 4; ++nt) acc[mt][nt] = MFMA16(a[mt], b[nt], acc[mt][nt]);
            }
#pragma unroll
            for (int pi = 0; pi < 2; ++pi)
#pragma unroll
                for (int r = 0; r < 4; ++r) {
                    const int k1 = 16 * (2 * rt + pi) + 4 * fg + r;
                    const float rev = (float)(k1 * t2) * (1.f / 16384.f); const float tc = __builtin_amdgcn_cosf(rev), ts = __builtin_amdgcn_sinf(rev);
                    bf16* dr = FB + ((size_t)(k1 * 128 + t2) * 2) * 512 + 256 * nh + n0 + fr; bf16* di = dr + 512;
#pragma unroll
                    for (int nt = 0; nt < 4; ++nt) {
                        const float ar = acc[2 * pi][nt][r], ai = acc[2 * pi + 1][nt][r];
                        dr[16 * nt] = (bf16)f2bf(ar * tc + ai * ts); di[16 * nt] = (bf16)f2bf(ai * tc - ar * ts);
                    }
                }
        }
        __syncthreads();
    }
}

__device__ __forceinline__ void p7m_fourier_c(const Ctx& c) {
    const bf16* FB = (const bf16*)c.out; const bf16* Gt = (const bf16*)(c.ws + WS_G); bf16* A2 = (bf16*)(c.ws + WS_H);
    LAS unsigned char* L = (LAS unsigned char*)c.lds; LAS unsigned char* Cs = L; LAS unsigned char* Sn = L + TILE_B; LAS unsigned char* BrS = L + 2 * TILE_B; LAS unsigned char* BiS = L + 3 * TILE_B;
    const int lane = c.lane, rt = c.wave >> 1, cg = c.wave & 1, fr = lane & 15, fg = lane >> 4;
    for (int e = c.tid; e < 128 * 128; e += NTHREADS) {
        const int k2 = e >> 7, t2 = e & 127; const float ph = (float)((k2 * t2) & 127) * (1.f / 64.f);
        *(LAS bf16*)(Cs + k2 * TSB + t2 * 2) = (bf16)f2bf(cospif(ph)); *(LAS bf16*)(Sn + k2 * TSB + t2 * 2) = (bf16)f2bf(sinpif(ph));
    }
    __syncthreads();
    for (int it = c.bid; it < 128 * 4; it += c.G) {
        const int k1 = it >> 2, g = it & 3;
        for (int e = c.tid; e < 128 * 32; e += NTHREADS) {
            const int t2 = e >> 5, ri = (e >> 4) & 1, ch = e & 15;
            *(LAS v4u*)((ri ? BiS : BrS) + t2 * TSB + ch * 16) = *(const v4u*)(FB + ((size_t)(k1 * 128 + t2) * 2 + ri) * 512 + g * 128 + ch * 8);
        }
        __syncthreads();
        {
            f32x4 xr[2][4], xi[2][4];
#pragma unroll
            for (int mt = 0; mt < 2; ++mt)
#pragma unroll
                for (int nt = 0; nt < 4; ++nt) { xr[mt][nt] = (f32x4){0.f, 0.f, 0.f, 0.f}; xi[mt][nt] = (f32x4){0.f, 0.f, 0.f, 0.f}; }
#pragma unroll 1
            for (int ks = 0; ks < 4; ++ks) {
                h8 ar[2], ai[2], an[2], bc[4], bs[4];
#pragma unroll
                for (int mt = 0; mt < 2; ++mt) {
                    ar[mt] = frag_tr(BrS, TSB, 32 * ks, 32 * rt + 16 * mt, lane); ai[mt] = frag_tr(BiS, TSB, 32 * ks, 32 * rt + 16 * mt, lane);
                    an[mt] = ar[mt] ^ (short)0x8000;
                }
#pragma unroll
                for (int nt = 0; nt < 4; ++nt) { bc[nt] = frag_row(Cs, TSB, 64 * cg + 16 * nt, 32 * ks, lane); bs[nt] = frag_row(Sn, TSB, 64 * cg + 16 * nt, 32 * ks, lane); }
#pragma unroll
                for (int mt = 0; mt < 2; ++mt)
#pragma unroll
                    for (int nt = 0; nt < 4; ++nt) {
                        xr[mt][nt] = MFMA16(ar[mt], bc[nt], xr[mt][nt]); xr[mt][nt] = MFMA16(ai[mt], bs[nt], xr[mt][nt]);
                        xi[mt][nt] = MFMA16(ai[mt], bc[nt], xi[mt][nt]); xi[mt][nt] = MFMA16(an[mt], bs[nt], xi[mt][nt]);
                    }
            }
            __syncthreads();
#pragma unroll
            for (int mt = 0; mt < 2; ++mt)
#pragma unroll
                for (int nt = 0; nt < 4; ++nt) {
                    const int k2 = 64 * cg + 16 * nt + fr, c0 = 32 * rt + 16 * mt + 4 * fg;
                    v2u w; w.x = pk2(xr[mt][nt][0], xr[mt][nt][1]); w.y = pk2(xr[mt][nt][2], xr[mt][nt][3]); *(LAS v2u*)(BrS + k2 * TSB + c0 * 2) = w;
                    w.x = pk2(xi[mt][nt][0], xi[mt][nt][1]); w.y = pk2(xi[mt][nt][2], xi[mt][nt][3]); *(LAS v2u*)(BiS + k2 * TSB + c0 * 2) = w;
                }
        }
        __syncthreads();
        {
            f32x4 acc[2][4];
#pragma unroll
            for (int mt = 0; mt < 2; ++mt)
#pragma unroll
                for (int nt = 0; nt < 4; ++nt) acc[mt][nt] = (f32x4){0.f, 0.f, 0.f, 0.f};
            const bf16* gt = Gt + (size_t)g * 128 * 256;
#pragma unroll 2
            for (int ks = 0; ks < 8; ++ks) {
                h8 a[2], b[4];
                const LAS unsigned char* xs = ks < 4 ? BrS : BiS;
#pragma unroll
                for (int nt = 0; nt < 4; ++nt) b[nt] = *(const h8*)(gt + (size_t)(64 * cg + 16 * nt + fr) * 256 + 32 * ks + 8 * fg);
#pragma unroll
                for (int mt = 0; mt < 2; ++mt) a[mt] = frag_row(xs, TSB, 32 * rt + 16 * mt, 32 * (ks & 3), lane);
#pragma unroll
                for (int mt = 0; mt < 2; ++mt)
#pragma unroll
                    for (int nt = 0; nt < 4; ++nt) acc[mt][nt] = MFMA16(a[mt], b[nt], acc[mt][nt]);
            }
#pragma unroll
            for (int mt = 0; mt < 2; ++mt)
#pragma unroll
                for (int r = 0; r < 4; ++r) {
                    const int k2 = 32 * rt + 16 * mt + 4 * fg + r; bf16* dst = A2 + (size_t)(k1 + 128 * k2) * D + 512 + g * 128 + 64 * cg + fr;
#pragma unroll
                    for (int nt = 0; nt < 4; ++nt) dst[16 * nt] = (bf16)f2bf(acc[mt][nt][r]);
                }
        }
        __syncthreads();
    }
}

#define XB_TMO      128
#define XB_XCNT(j)  (256  + 64 * (j))
#define XB_XSUB(j)  (1280 + 64 * (j))
#define XB_XGEN(j)  (2304 + 64 * (j))
#define XB_TOP      3328
#define XB_TOPGEN   3392
#define XCD_BAR_WORDS 3456
#define XB_SPIN_CAP (1u << 18)
__device__ __forceinline__ unsigned xb_ld(unsigned* p)              { return __hip_atomic_load(p, __ATOMIC_RELAXED, __HIP_MEMORY_SCOPE_AGENT); }
__device__ __forceinline__ unsigned xb_add(unsigned* p, unsigned v) { return __hip_atomic_fetch_add(p, v, __ATOMIC_RELAXED, __HIP_MEMORY_SCOPE_AGENT); }
__device__ __forceinline__ unsigned xb_xcc_id() { return (unsigned)__builtin_amdgcn_s_getreg((3 << 11) | 20) & 0xFu; }
#define XB_SPIN(cond, bar) do { unsigned _sp = 0; while (cond) { __builtin_amdgcn_s_sleep(1); \
    if ((++_sp & 255u) == 0u) { if (xb_ld(&(bar)[XB_TMO])) break; if (_sp > XB_SPIN_CAP) { atomicAdd(&(bar)[XB_TMO], 1u); break; } } } } while (0)
struct XcdBarrier { unsigned* bar; unsigned x; volatile LAS unsigned* st; };
__device__ __forceinline__ XcdBarrier xcd_barrier_post(unsigned* bar, volatile LAS unsigned* st) {
    XcdBarrier b; b.bar = bar; b.x = xb_xcc_id(); b.st = st;
    if (threadIdx.x == 0) (void)xb_add(&bar[XB_XCNT(b.x)], 1u);
    return b;
}
__device__ __forceinline__ void xcd_barrier_complete(unsigned* bar, unsigned x, unsigned& nloc, unsigned& nx) {
    const unsigned G = gridDim.x * gridDim.y * gridDim.z;
    unsigned sum, cnt, mine, sp = 0u;
    for (;;) {
        sum = 0u; cnt = 0u; mine = 0u;
#pragma unroll
        for (unsigned j = 0; j < 16; ++j) { const unsigned c = xb_ld(&bar[XB_XCNT(j)]); sum += c; cnt += (c > 0u) ? 1u : 0u; mine = (j == x) ? c : mine; }
        if (sum == G) break;
        __builtin_amdgcn_s_sleep(1);
        if ((++sp & 255u) == 0u) { if (xb_ld(&bar[XB_TMO])) break; if (sp > XB_SPIN_CAP) { atomicAdd(&bar[XB_TMO], 1u); break; } }
    }
    nloc = mine > 0u ? mine : 1u; nx = cnt > 0u ? cnt : 1u;
}
__device__ __forceinline__ void xcd_barrier(const XcdBarrier& b) {
    asm volatile("s_waitcnt vmcnt(0)" ::: "memory");
    __syncthreads();
    if (threadIdx.x == 0) {
        unsigned* bar = b.bar;
        __builtin_amdgcn_s_waitcnt(0);
        unsigned nloc = b.st[0], nx = b.st[1];
        if (nloc == 0u) { xcd_barrier_complete(bar, b.x, nloc, nx); b.st[0] = nloc; b.st[1] = nx; }
        const unsigned old = xb_add(&bar[XB_XSUB(b.x)], 1u);
        const unsigned gen = old / nloc;
        if (old + 1u == (gen + 1u) * nloc) {
            __builtin_amdgcn_fence(__ATOMIC_RELEASE, "agent");
            asm volatile("s_waitcnt vmcnt(0)" ::: "memory");
            const unsigned og = xb_add(&bar[XB_TOP], 1u);
            const unsigned tg = og / nx;
            if (og + 1u == (tg + 1u) * nx) xb_add(&bar[XB_TOPGEN], 1u);
            else XB_SPIN(xb_ld(&bar[XB_TOPGEN]) == tg, bar);
            __builtin_amdgcn_fence(__ATOMIC_ACQUIRE, "agent");
            xb_add(&bar[XB_XGEN(b.x)], 1u);
            asm volatile("s_waitcnt vmcnt(0)" ::: "memory");
        } else {
            XB_SPIN(xb_ld(&bar[XB_XGEN(b.x)]) == gen, bar);
            __builtin_amdgcn_fence(__ATOMIC_ACQUIRE, "agent");
            asm volatile("s_waitcnt vmcnt(0)" ::: "memory");
        }
    }
    __syncthreads();
}

#ifndef MK_CG_SYNC
#define MK_CG_SYNC 0
#endif
constexpr int MISC_OFF = LDS_BYTES - 256;
constexpr int TAB_OFF = LDS_BYTES - 1024;
__global__ void __launch_bounds__(NTHREADS, 2) fwd_kernel(Args a) {
    extern __shared__ __attribute__((aligned(16))) unsigned char lds_raw[];
    Ctx c;
    c.tid = threadIdx.x; c.lane = c.tid & 63; c.wave = __builtin_amdgcn_readfirstlane(c.tid >> 6);
    c.G = gridDim.x; c.bid = blockIdx.x; c.gw = c.bid * NWAVES + c.wave; c.NGW = c.G * NWAVES; c.gtid = c.bid * NTHREADS + c.tid; c.NTHR = c.G * NTHREADS;
    c.lds = (float*)lds_raw;
    {
        volatile LAS unsigned* tabw = (volatile LAS unsigned*)((LAS unsigned char*)lds_raw + TAB_OFF);
        if (c.tid == 0) {
#define PUT(i, p) do { tabw[2 * (i)] = (unsigned)(size_t)(p); tabw[2 * (i) + 1] = (unsigned)((size_t)(p) >> 32); } while (0)
            PUT(0, a.in[0]); PUT(1, a.in[1]); PUT(2, a.in[2]); PUT(3, a.in[3]); PUT(4, a.in[4]); PUT(5, a.in[5]); PUT(6, a.in[6]); PUT(7, a.in[7]);
            PUT(8, a.in[8]); PUT(9, a.in[9]); PUT(10, a.in[10]); PUT(11, a.in[11]); PUT(12, a.in[12]); PUT(13, a.in[13]); PUT(14, a.in[14]); PUT(15, a.in[15]);
            PUT(16, a.in[16]); PUT(17, a.in[17]); PUT(18, a.in[18]); PUT(19, a.in[19]); PUT(20, a.in[20]); PUT(21, a.in[21]); PUT(22, a.in[22]); PUT(23, a.in[23]);
            PUT(24, a.in[24]); PUT(25, a.in[25]); PUT(26, a.in[26]); PUT(27, a.in[27]); PUT(28, a.in[28]); PUT(29, a.in[29]); PUT(30, a.in[30]); PUT(31, a.ws); PUT(32, a.out);
#undef PUT
        }
        c.tab = tabw; c.ws = a.ws; c.out = a.out;
    }
    __syncthreads();
#if MK_CG_SYNC
    cooperative_groups::grid_group grid = cooperative_groups::this_grid();
#define GRID_BAR() do { grid.sync(); } while (0)
#else
    volatile LAS unsigned* misc = (volatile LAS unsigned*)((LAS unsigned char*)lds_raw + MISC_OFF);
    if (c.tid < 64) misc[c.tid] = 0u;
    __syncthreads();
    const XcdBarrier bar = xcd_barrier_post((unsigned*)(a.ws + WS_CTL) + 4096, misc + 8);
#define GRID_BAR() do { xcd_barrier(bar); } while (0)
#endif
    volatile LAS int* ts = (volatile LAS int*)((LAS unsigned char*)lds_raw + MISC_OFF) + 16;
#ifndef DUP_MASK
#define DUP_MASK 0
#endif
#define DUP(bit, stmt) do { if (DUP_MASK & (1 << (bit))) { GRID_BAR(); stmt; } } while (0)
    p0_prologue(fresh(c)); conv_small_weights(fresh(c));   GRID_BAR();
    p1_hrows(fresh(c));               GRID_BAR();
    DUP(1, p0_prologue(fresh(c)); conv_small_weights(fresh(c)); GRID_BAR(); p1_hrows(fresh(c)); GRID_BAR());
    g1_gemm1(fresh(c));               GRID_BAR();
    DUP(0, g1_gemm1(fresh(c)); GRID_BAR());
    p3_features(fresh(c)); p6m_fourier_a(fresh(c));  GRID_BAR();
    DUP(6, p3_features(fresh(c)); GRID_BAR());
    DUP(4, p6m_fourier_a(fresh(c)); GRID_BAR());
    p4m_summaries(fresh(c));          GRID_BAR();
    DUP(3, p4m_summaries(fresh(c)); GRID_BAR());
    p5_scan(fresh(c)); p7m_fourier_c(fresh(c));      GRID_BAR();
    DUP(2, p5_scan(fresh(c)); GRID_BAR());
    DUP(4, p7m_fourier_c(fresh(c)); GRID_BAR());
    p8m_mlstm_out(fresh(c)); conv_moe_weights(fresh(c));   GRID_BAR();
    DUP(7, p8m_mlstm_out(fresh(c)); GRID_BAR());
    DUP(5, conv_moe_weights(fresh(c)); GRID_BAR());
    g2_outproj(fresh(c));             GRID_BAR();
    DUP(0, g2_outproj(fresh(c)); GRID_BAR());
    p10b_token(fresh(c));             GRID_BAR();
    g3_moe_up(fresh(c), ts);          GRID_BAR();
    DUP(0, g3_moe_up(fresh(c), ts); GRID_BAR());
    g4_moe_down(fresh(c), ts);        GRID_BAR();
    DUP(0, g4_moe_down(fresh(c), ts); GRID_BAR());
    DUP(8, GRID_BAR(); GRID_BAR(); GRID_BAR(); GRID_BAR(); GRID_BAR(); GRID_BAR(); GRID_BAR());
    p12b_final(fresh(c));
}

extern "C" void kernel_launch(void* const* d_in, const int* in_sizes, int n_in, void* d_out, int out_size, void* d_ws, size_t ws_size, hipStream_t stream) {
    static int grid = 0;
    if (grid == 0) {
        if (n_in != 31 || out_size != T * D || ws_size < 256 * MiB) { fprintf(stderr, "kernel_launch: unexpected shapes n_in %d out %d ws %zu\n", n_in, out_size, ws_size); grid = -1; return; }
        int dev = 0, cus = 0, per_cu = 0;
        (void)hipGetDevice(&dev); (void)hipDeviceGetAttribute(&cus, hipDeviceAttributeMultiprocessorCount, dev);
        if (hipFuncSetAttribute((const void*)fwd_kernel, hipFuncAttributeMaxDynamicSharedMemorySize, LDS_BYTES) != hipSuccess) { fprintf(stderr, "kernel_launch: hipFuncSetAttribute failed\n"); grid = -1; return; }
        if (hipOccupancyMaxActiveBlocksPerMultiprocessor(&per_cu, (const void*)fwd_kernel, NTHREADS, LDS_BYTES) != hipSuccess || per_cu < 1) { fprintf(stderr, "kernel_launch: occupancy query says %d blocks per CU\n", per_cu); (void)hipGetLastError(); per_cu = 1; }
        grid = (cus > 0 ? cus : 256);
        fprintf(stderr, "kernel_launch: cus %d occupancy %d grid %d\n", cus, per_cu, grid);
    }
    if (grid < 0) return;
    (void)hipMemsetAsync((char*)d_ws + WS_CTL, 0, 65536, stream);
    Args a{};
    for (int i = 0; i < 31; ++i) a.in[i] = (const float*)d_in[i];
    a.out = (float*)d_out; a.ws = (unsigned char*)d_ws; a.ph_lo = 0; a.ph_hi = 0;
    void* kargs[] = {&a};
    hipError_t e = hipLaunchCooperativeKernel((const void*)fwd_kernel, dim3(grid), dim3(NTHREADS), kargs, LDS_BYTES, stream);
    if (e != hipSuccess) fprintf(stderr, "kernel_launch: cooperative launch failed: %s (grid %d)\n", hipGetErrorString(e), grid);
}
```

```cpp
#include <hip/hip_runtime.h>
#include <hip/hip_cooperative_groups.h>
#include <cstdio>

typedef unsigned short bf16;
typedef unsigned v4u __attribute__((ext_vector_type(4)));
typedef float f32x4 __attribute__((ext_vector_type(4)));

constexpr int D = 1024, T = 16384, TC = 256, NT = T + TC;
constexpr int DM = 512, NH = 4, DH = 128, CH = 128, NCL = T / CH, NCC = TC / CH, NCH = NCL + NCC;
constexpr int DIN = 1536, NE = 16, DE = 512;
constexpr float EPS = 1e-6f;
constexpr int NTHREADS = 512, NWAVES = 8;
constexpr int LDS_BYTES = 163840;

constexpr size_t MiB = 1u << 20;
constexpr size_t WS_CTL = 0;
constexpr size_t WS_MOD = 1 * MiB;
constexpr size_t WS_MODC = 1 * MiB + 32768;
constexpr size_t WS_POSR = 1 * MiB + 65536;
constexpr size_t WS_POSC = WS_POSR + 256 * 512 * 4;
constexpr size_t WS_G = 2 * MiB;
constexpr size_t WS_DFTW = 2 * MiB + 512 * 1024;
constexpr size_t WS_P3WB = 2 * MiB + 768 * 1024;
constexpr size_t WS_IG = 3 * MiB;
constexpr size_t WS_LF = 4 * MiB;
constexpr size_t WS_AMAX = 5 * MiB;
constexpr size_t WS_BTOT = 5 * MiB + 8192;
constexpr size_t WS_M0 = 5 * MiB + 16384;
constexpr size_t WS_NL = 5 * MiB + 65536;
constexpr size_t WS_N0 = 6 * MiB;
constexpr size_t WS_RE = 7 * MiB;
constexpr size_t WS_RW = 7 * MiB + 256 * 1024;
constexpr size_t WS_H = 13 * MiB;
constexpr size_t WS_XM = 46 * MiB;
constexpr size_t WS_U = WS_XM + (size_t)NT * 1024;
constexpr size_t WS_Z = 79 * MiB;
constexpr size_t WS_C0 = 46 * MiB;
constexpr size_t WS_Q = 96 * MiB, WS_K = WS_Q + (size_t)NT * 1024, WS_V = WS_K + (size_t)NT * 1024, WS_ACT = WS_V + (size_t)NT * 1024;
constexpr size_t WS_L = 163 * MiB;
constexpr size_t WS_Y = 96 * MiB;
static_assert(WS_U + (size_t)NT * 1024 <= WS_Z && WS_Z + (size_t)NT * 1024 <= WS_Q && WS_ACT + (size_t)NT * 1024 <= WS_L && WS_L + 65 * MiB <= 256 * MiB, "ws map");
static_assert(WS_C0 + 32 * MiB <= WS_Z && WS_Y + 64 * MiB <= WS_L && WS_H + (size_t)NT * 2048 <= WS_XM, "ws map 2");
constexpr size_t WS_WIN_T = 8 * MiB;
constexpr size_t WS_WOUT_T = 11 * MiB;
constexpr size_t WS_WGU_T = 168 * MiB;
constexpr size_t WS_WD_T = 228 * MiB;
constexpr size_t WS_ASORT = 96 * MiB;
constexpr size_t WS_YROW = 96 * MiB;
constexpr size_t WS_ACTS = 46 * MiB;
constexpr size_t WS_RS = 7 * MiB + 512 * 1024;
constexpr size_t WS_ROWW = 216 * MiB;
constexpr size_t WS_ROWTOK = 217 * MiB;
constexpr int CW_CNT = 8192;
static_assert(WS_ASORT + 72 * MiB <= WS_WGU_T && WS_WGU_T + 32 * MiB <= WS_ROWW && WS_WD_T + 16 * MiB <= 256 * MiB && WS_ACTS + 36 * MiB <= WS_ASORT, "ws map 3");

#define LAS __attribute__((address_space(3)))
struct Args { const float* in[31]; float* out; unsigned char* ws; int ph_lo, ph_hi; };

__device__ __forceinline__ float bf2f(unsigned b) { return __uint_as_float(b << 16); }
__device__ __forceinline__ unsigned f2bf(float f) { unsigned u = __float_as_uint(f); return (u + 0x7fffu + ((u >> 16) & 1u)) >> 16; }
__device__ __forceinline__ unsigned pk2(float lo, float hi) { return f2bf(lo) | (f2bf(hi) << 16); }
__device__ __forceinline__ float lo16(unsigned w) { return __uint_as_float(w << 16); }
__device__ __forceinline__ float hi16(unsigned w) { return __uint_as_float(w & 0xffff0000u); }
__device__ __forceinline__ float wave_sum(float v) {
#pragma unroll
    for (int o = 1; o < 64; o <<= 1) v += __shfl_xor(v, o);
    return v;
}
__device__ __forceinline__ float siluf(float x) { return x / (1.f + __expf(-x)); }
__device__ __forceinline__ float logsigf(float x) { return fminf(x, 0.f) - log1pf(__expf(-fabsf(x))); }
__device__ __forceinline__ void unpack8(const v4u w, float (&f)[8]) {
    f[0] = lo16(w.x); f[1] = hi16(w.x); f[2] = lo16(w.y); f[3] = hi16(w.y); f[4] = lo16(w.z); f[5] = hi16(w.z); f[6] = lo16(w.w); f[7] = hi16(w.w);
}
template <bool MAXOP>
__device__ __forceinline__ float scan128(float v, bool rev, LAS float* tmp, int tid, int lane, int wave) {
    float x = v;
#pragma unroll
    for (int o = 1; o < 64; o <<= 1) {
        const float y = rev ? __shfl_down(x, o) : __shfl_up(x, o);
        const bool ok = rev ? (lane + o < 64) : (lane >= o);
        if (ok) x = MAXOP ? fmaxf(x, y) : x + y;
    }
    if (wave < 2 && lane == (rev ? 0 : 63)) tmp[wave] = x;
    __syncthreads();
    if (tid < 128) {
        if (!rev && wave == 1) x = MAXOP ? fmaxf(x, tmp[0]) : x + tmp[0];
        if (rev && wave == 0) x = MAXOP ? fmaxf(x, tmp[1]) : x + tmp[1];
    }
    __syncthreads();
    return x;
}
__device__ __forceinline__ int chunk_row0(int d, int j) {
    if (d == 0) return j < NCC ? T + j * CH : (j - NCC) * CH;
    return j < NCC ? T + (NCC - 1 - j) * CH : (NCL - 1 - (j - NCC)) * CH;
}

struct Ctx {
    int tid, lane, wave, gw, NGW, gtid, NTHR, G, bid;
    unsigned char* ws; float* out; const volatile LAS unsigned* tab;
    float* lds;
};

__device__ __forceinline__ const void* tab_ptr(const volatile LAS unsigned* tab, int i) {
    unsigned lo = tab[2 * i], hi = tab[2 * i + 1];
    lo = __builtin_amdgcn_readfirstlane(lo); hi = __builtin_amdgcn_readfirstlane(hi);
    typedef const __attribute__((address_space(1))) void* gcvp;
    return (const void*)(gcvp)(((size_t)hi << 32) | lo);
}
__device__ __forceinline__ const float* inp(const Ctx& c, int i) { return (const float*)tab_ptr(c.tab, i); }
__device__ __forceinline__ Ctx fresh(const Ctx& c0) {
    Ctx c = c0;
    int t = threadIdx.x; asm volatile("" : "+v"(t));
    c.tid = t; c.lane = t & 63; c.wave = __builtin_amdgcn_readfirstlane(t >> 6);
    c.gw = c.bid * NWAVES + c.wave; c.gtid = c.bid * NTHREADS + t;
    c.ws = (unsigned char*)tab_ptr(c0.tab, 31); c.out = (float*)tab_ptr(c0.tab, 32);
    return c;
}
template <int K>
__device__ __forceinline__ void gemm_8x64(const bf16* a0, const bf16* a1, const bf16* a2, const bf16* a3, const bf16* a4, const bf16* a5, const bf16* a6, const bf16* a7,
                                          const float* B, int ldb, int col, float (&acc)[8]) {
    for (int k0 = 0; k0 < K; k0 += 8) {
        float a[8][8];
        unpack8(*(const v4u*)(a0 + k0), a[0]); unpack8(*(const v4u*)(a1 + k0), a[1]); unpack8(*(const v4u*)(a2 + k0), a[2]); unpack8(*(const v4u*)(a3 + k0), a[3]);
        unpack8(*(const v4u*)(a4 + k0), a[4]); unpack8(*(const v4u*)(a5 + k0), a[5]); unpack8(*(const v4u*)(a6 + k0), a[6]); unpack8(*(const v4u*)(a7 + k0), a[7]);
#pragma unroll
        for (int kk = 0; kk < 8; ++kk) {
            const float b = B[(size_t)(k0 + kk) * ldb + col];
#pragma unroll
            for (int r = 0; r < 8; ++r) acc[r] += a[r][kk] * b;
        }
    }
}

typedef unsigned v2u __attribute__((ext_vector_type(2)));
typedef short s16x4 __attribute__((ext_vector_type(4)));
typedef short h8 __attribute__((ext_vector_type(8)));
constexpr int TSB = 288;
constexpr int TILE_B = 128 * TSB;
#define MFMA16(a, b, c) __builtin_amdgcn_mfma_f32_16x16x32_bf16((a), (b), (c), 0, 0, 0)
__device__ __forceinline__ h8 frag_row(const LAS unsigned char* tile, int stride_b, int row0, int k0, int lane) {
    return *(const LAS h8*)(tile + (row0 + (lane & 15)) * stride_b + (k0 + 8 * (lane >> 4)) * 2);
}
__device__ __forceinline__ h8 frag_tr(const LAS unsigned char* tile, int stride_b, int k0, int n0, int lane) {
    const int g = lane >> 4, q = (lane & 15) >> 2, p = lane & 3;
    const LAS unsigned char* a = tile + (k0 + 8 * g + q) * stride_b + (n0 + 4 * p) * 2;
    const s16x4 lo = __builtin_amdgcn_ds_read_tr16_b64_v4i16((LAS s16x4*)a);
    const s16x4 hi = __builtin_amdgcn_ds_read_tr16_b64_v4i16((LAS s16x4*)(a + 4 * stride_b));
    return __builtin_shufflevector(lo, hi, 0, 1, 2, 3, 4, 5, 6, 7);
}
__device__ __forceinline__ void lds_atomic_add(LAS float* p, float v) { __hip_atomic_fetch_add(p, v, __ATOMIC_RELAXED, __HIP_MEMORY_SCOPE_WORKGROUP); }


__device__ __forceinline__ void p0_prologue(const Ctx& c) {
    const float* cvec = inp(c, 1); const float* ccvec = inp(c, 3); const float* w_ada = inp(c, 4); const float* b_ada = inp(c, 5);
    float* mod = (float*)(c.ws + WS_MOD); float* modc = (float*)(c.ws + WS_MODC);
    for (int it = c.bid; it < 96; it += c.G) {
        const int col = it * 64 + c.lane; float al = 0.f, ac = 0.f;
#pragma unroll 16
        for (int k = c.wave * 128; k < c.wave * 128 + 128; ++k) {
            const float w = w_ada[(size_t)k * 6144 + col];
            al += siluf(cvec[k]) * w; ac += siluf(ccvec[k]) * w;
        }
        c.lds[(c.wave * 64 + c.lane) * 2] = al; c.lds[(c.wave * 64 + c.lane) * 2 + 1] = ac;
        __syncthreads();
        if (c.wave == 0) {
            float sl = 0.f, sc = 0.f;
            for (int w = 0; w < 8; ++w) { sl += c.lds[(w * 64 + c.lane) * 2]; sc += c.lds[(w * 64 + c.lane) * 2 + 1]; }
            mod[col] = sl + b_ada[col];
            if (col < 2048) modc[col] = sc + b_ada[col];
        }
        __syncthreads();
    }
    float* posR = (float*)(c.ws + WS_POSR);
    for (int i = c.gtid; i < 320 * 512; i += c.NTHR) {
        const int r = i >> 9, j = i & 511, p = r < 256 ? r : r - 256, fi = j & 255;
        const float freq = 1.0f / powf(10000.0f, (float)fi / 256.0f);
        const float ang = (float)p * freq;
        posR[i] = j < 256 ? sinf(ang) : cosf(ang);
    }
    const float* wf = inp(c, 22); bf16* Gt = (bf16*)(c.ws + WS_G);
    const float scale = 1.0f / sqrtf(16384.0f * 128.0f);
    LAS float* tab = (LAS float*)c.lds + 2048;
    if (c.tid < 128) { tab[c.tid] = cospif((float)c.tid * (1.f / 64.f)); tab[128 + c.tid] = sinpif((float)c.tid * (1.f / 64.f)); }
    __syncthreads();
    for (int i = c.gtid; i < 4 * 128 * 256; i += c.NTHR) {
        const int g = i >> 15, d = (i >> 8) & 127, row = i & 255, cc = row & 127; float s = 0.f;
        const LAS float* tb = tab + (row < 128 ? 0 : 128); const float* wp = wf + (size_t)g * 128 * 128 + d;
#pragma unroll 8
        for (int c2 = 0; c2 < 128; ++c2) s += tb[(cc * c2) & 127] * wp[c2 * 128];
        Gt[i] = (bf16)f2bf(s * scale);
    }
    bf16* dw = (bf16*)(c.ws + WS_DFTW);
    for (int e = c.gtid; e < 256 * 128 + 2 * 128 * 128; e += c.NTHR) {
        if (e < 256 * 128) {
            const int row = e >> 7, t1 = e & 127, k1 = 16 * (row >> 5) + (row & 15), ri = (row >> 4) & 1;
            dw[e] = (bf16)f2bf(ri ? -tab[128 + ((k1 * t1) & 127)] : tab[(k1 * t1) & 127]);
        } else {
            const int e2 = e - 256 * 128, which = e2 >> 14, k2 = (e2 >> 7) & 127, t2 = e2 & 127;
            dw[e] = (bf16)f2bf(tab[which * 128 + ((k2 * t2) & 127)]);
        }
    }
    {
        bf16* wbt = (bf16*)(c.ws + WS_P3WB); float* pwt = (float*)(c.ws + WS_P3WB + 16 * 1544 * 2);
        const float* wf_ = inp(c, 16); const float* wb_ = inp(c, 18);
        for (int idx = c.gtid; idx < 2 * 1536 * 8; idx += c.NTHR) {
            const int d = idx / (1536 * 8), r = idx % (1536 * 8), k = r >> 3, j = r & 7;
            wbt[(d * 8 + j) * 1544 + k] = (bf16)f2bf((d ? wb_ : wf_)[r] * (k < 512 ? 11.313708498984761f : 1.f));
        }
        const float* conv_w = inp(c, 11); const float* conv_b = inp(c, 12); const float* wq = inp(c, 13); const float* wk = inp(c, 14); const float* wv = inp(c, 15);
        for (int idx = c.gtid; idx < 64 * 128; idx += c.NTHR) {
            const int ln = idx >> 7, k = idx & 127; float v;
            if (k < 32) v = wq[ln * 32 + k]; else if (k < 64) v = wk[ln * 32 + k - 32]; else if (k < 96) v = wv[ln * 32 + k - 64];
            else if (k < 120) v = conv_w[((k - 96) >> 3) * DM + 8 * ln + ((k - 96) & 7)]; else v = conv_b[8 * ln + k - 120];
            pwt[((k >> 2) * 64 + ln) * 4 + (k & 3)] = v;
        }
    }
}

struct P1Ptrs { const float* x; const float* ctx; const float* g; const float* mod; const float* modc; const float* posR; const float* posC; bf16* H; };
__device__ __forceinline__ void p1_load(const P1Ptrs& p, int rb, int ngw, int lane, f32x4 (&v)[4][4]) {
#pragma unroll
    for (int b = 0; b < 4; ++b) {
        const int r = rb + b * ngw; const bool ok = r < NT, lat = r < T;
        const float* src = lat ? p.x + (size_t)r * D : p.ctx + (size_t)(ok ? r - T : 0) * D;
#pragma unroll
        for (int j = 0; j < 4; ++j) {
            const int col = 256 * j + 4 * lane;
            v[b][j] = *(const f32x4*)(src + col);
            if (lat) { const float* pp = col < 512 ? p.posR + (r >> 6) * 512 + col : p.posC + (r & 63) * 512 + (col - 512); v[b][j] += *(const f32x4*)pp; }
        }
    }
}
__device__ __forceinline__ void p1_compute(const P1Ptrs& p, int rb, int ngw, int lane, const f32x4 (&v)[4][4]) {
    float ss[4];
#pragma unroll
    for (int b = 0; b < 4; ++b) { ss[b] = 0.f;
#pragma unroll
        for (int j = 0; j < 4; ++j) ss[b] += v[b][j].x * v[b][j].x + v[b][j].y * v[b][j].y + v[b][j].z * v[b][j].z + v[b][j].w * v[b][j].w; }
#pragma unroll
    for (int o = 1; o < 64; o <<= 1)
#pragma unroll
        for (int b = 0; b < 4; ++b) ss[b] += __shfl_xor(ss[b], o);
#pragma unroll
    for (int b = 0; b < 4; ++b) {
        const int r = rb + b * ngw; if (r >= NT) continue;
        const float* md = r < T ? p.mod : p.modc;
        const float rinv = rsqrtf(ss[b] * (1.f / D) + EPS);
#pragma unroll
        for (int j = 0; j < 4; ++j) {
            const int col = 256 * j + 4 * lane;
            const f32x4 gg = *(const f32x4*)(p.g + col), sh = *(const f32x4*)(md + col), sc = *(const f32x4*)(md + 1024 + col);
            const f32x4 o = v[b][j] * rinv * gg * (sc + 1.f) + sh;
            uint2 w; w.x = pk2(o.x, o.y); w.y = pk2(o.z, o.w);
            *(uint2*)(p.H + (size_t)r * D + col) = w;
        }
    }
}
__device__ __forceinline__ void p1_hrows(const Ctx& c) {
    const P1Ptrs p{inp(c, 0), inp(c, 2), inp(c, 6), (const float*)(c.ws + WS_MOD), (const float*)(c.ws + WS_MODC), (const float*)(c.ws + WS_POSR), (const float*)(c.ws + WS_POSC), (bf16*)(c.ws + WS_H)};
    const int step = 4 * c.NGW;
    f32x4 va[4][4], vb[4][4];
    int rb = c.gw;
    if (rb >= NT) return;
    p1_load(p, rb, c.NGW, c.lane, va);
    for (;;) {
        int rn = rb + step; bool hn = rn < NT;
        if (hn) p1_load(p, rn, c.NGW, c.lane, vb);
        p1_compute(p, rb, c.NGW, c.lane, va);
        if (!hn) break;
        rb = rn; rn = rb + step; hn = rn < NT;
        if (hn) p1_load(p, rn, c.NGW, c.lane, va);
        p1_compute(p, rb, c.NGW, c.lane, vb);
        if (!hn) break;
        rb = rn;
    }
}

__device__ __forceinline__ void p3_features(const Ctx& c) {
    const bf16* XM = (const bf16*)(c.ws + WS_XM);
    bf16* Q = (bf16*)(c.ws + WS_Q); bf16* Kb = (bf16*)(c.ws + WS_K); bf16* Vb = (bf16*)(c.ws + WS_V); bf16* ACT = (bf16*)(c.ws + WS_ACT);
    float* IG = (float*)(c.ws + WS_IG); float* LF = (float*)(c.ws + WS_LF);
    constexpr int GS = 1544 * 2;
    LAS unsigned char* L = (LAS unsigned char*)c.lds;
    LAS unsigned char* Wb = L; LAS unsigned char* As = L + 16 * GS; LAS float* PW = (LAS float*)(L + 32 * GS); LAS float* part = PW + 64 * 128;
    {
        const unsigned char* src = c.ws + WS_P3WB;
        for (int e = c.tid; e < (16 * GS + 64 * 128 * 4) / 16; e += NTHREADS) {
            const int off = e * 16;
            if (off < 16 * GS) *(LAS v4u*)(Wb + off) = *(const v4u*)(src + off);
            else *(LAS v4u*)((LAS unsigned char*)PW + (off - 16 * GS)) = *(const v4u*)(src + off);
        }
    }
    __syncthreads();
    const float* bif_f = inp(c, 17); const float* bif_b = inp(c, 19);
    const int ch0 = 8 * c.lane, fr = c.lane & 15, fg = c.lane >> 4;
    constexpr int RPB = (NT + 255) / 256;
    const int rows_pb = (NT + c.G - 1) / c.G, rbase = c.bid * rows_pb, rend = rbase + rows_pb < NT ? rbase + rows_pb : NT;
#define PWV(k4) (*(const LAS f32x4*)(PW + ((k4) * 64 + c.lane) * 4))
    for (int g0 = rbase; g0 < rend; g0 += 16) {
#pragma unroll
        for (int s2 = 0; s2 < 2; ++s2) {
            const int rl = 2 * c.wave + s2, r = g0 + rl;
            if (r < rend) {
                const bool lat = r < T;
                const bool hasp = lat ? (r > 0) : (r > T), hasn = lat ? (r < T - 1) : (r < NT - 1);
                float xc[8], xp[8], xn[8];
                unpack8(*(const v4u*)(XM + (size_t)r * DM + ch0), xc);
                if (hasp) unpack8(*(const v4u*)(XM + (size_t)(r - 1) * DM + ch0), xp); else { for (int i = 0; i < 8; ++i) xp[i] = 0.f; }
                if (hasn) unpack8(*(const v4u*)(XM + (size_t)(r + 1) * DM + ch0), xn); else { for (int i = 0; i < 8; ++i) xn[i] = 0.f; }
                float act[8], q[8], k[8], v[8];
                {
                    const f32x4 w0a = PWV(24), w0b = PWV(25), w1a = PWV(26), w1b = PWV(27), w2a = PWV(28), w2b = PWV(29), cba = PWV(30), cbb = PWV(31);
#pragma unroll
                    for (int i = 0; i < 4; ++i) {
                        act[i] = siluf(w0a[i] * xp[i] + w1a[i] * xc[i] + w2a[i] * xn[i] + cba[i]);
                        act[4 + i] = siluf(w0b[i] * xp[4 + i] + w1b[i] * xc[4 + i] + w2b[i] * xn[4 + i] + cbb[i]);
                    }
                }
#pragma unroll
                for (int b = 0; b < 2; ++b) {
#pragma unroll
                    for (int o = 0; o < 4; ++o) { q[4 * b + o] = 0.f; k[4 * b + o] = 0.f; v[4 * b + o] = 0.f; }
#pragma unroll
                    for (int i = 0; i < 4; ++i) {
                        const f32x4 wq4 = PWV(b * 4 + i), wk4 = PWV(8 + b * 4 + i), wv4 = PWV(16 + b * 4 + i);
#pragma unroll
                        for (int o = 0; o < 4; ++o) { q[4 * b + o] += act[4 * b + i] * wq4[o]; k[4 * b + o] += act[4 * b + i] * wk4[o]; v[4 * b + o] += xc[4 * b + i] * wv4[o]; }
                    }
                }
                const float qs = 0.08838834764831845f;
                v4u wq_, wk_, wv_, wa_;
                wq_.x = pk2(q[0] * qs, q[1] * qs); wq_.y = pk2(q[2] * qs, q[3] * qs); wq_.z = pk2(q[4] * qs, q[5] * qs); wq_.w = pk2(q[6] * qs, q[7] * qs);
                wk_.x = pk2(k[0], k[1]); wk_.y = pk2(k[2], k[3]); wk_.z = pk2(k[4], k[5]); wk_.w = pk2(k[6], k[7]);
                wv_.x = pk2(v[0], v[1]); wv_.y = pk2(v[2], v[3]); wv_.z = pk2(v[4], v[5]); wv_.w = pk2(v[6], v[7]);
                wa_.x = pk2(act[0], act[1]); wa_.y = pk2(act[2], act[3]); wa_.z = pk2(act[4], act[5]); wa_.w = pk2(act[6], act[7]);
                *(v4u*)(Q + (size_t)r * DM + ch0) = wq_; *(v4u*)(Kb + (size_t)r * DM + ch0) = wk_; *(v4u*)(Vb + (size_t)r * DM + ch0) = wv_; *(v4u*)(ACT + (size_t)r * DM + ch0) = wa_;
                LAS unsigned char* arow = As + rl * GS + ch0 * 2;
                *(LAS v4u*)(arow) = wq_; *(LAS v4u*)(arow + 1024) = wk_; *(LAS v4u*)(arow + 2048) = wv_;
            }
        }
        __syncthreads();
        {
            f32x4 acc = {0.f, 0.f, 0.f, 0.f};
#pragma unroll
            for (int ks = 0; ks < 6; ++ks) {
                const int k0 = 32 * (6 * c.wave + ks);
                acc = MFMA16(frag_row(As, GS, 0, k0, c.lane), frag_row(Wb, GS, 0, k0, c.lane), acc);
            }
#pragma unroll
            for (int r4 = 0; r4 < 4; ++r4) part[(c.wave * 16 + 4 * fg + r4) * 16 + fr] = acc[r4];
        }
        __syncthreads();
        if (c.tid < 256) {
            const int rl = c.tid >> 4, n = c.tid & 15, r = g0 + rl;
            if (r < rend) {
                float gsum = 0.f;
#pragma unroll
                for (int w = 0; w < 8; ++w) gsum += part[(w * 16 + rl) * 16 + n];
                const int d = n >> 3, j = n & 7;
                const float val = gsum + (d ? bif_b : bif_f)[j];
                if (j < 4) IG[(size_t)(d * 4 + j) * NT + r] = val; else LF[(size_t)(d * 4 + (j - 4)) * NT + r] = logsigf(val);
            }
        }
        __syncthreads();
    }
#undef PWV
}

__device__ __forceinline__ void p5_scan(const Ctx& c) {
    const float* LT = (const float*)(c.ws + WS_L); const float* NL = (const float*)(c.ws + WS_NL);
    const float* AMAX = (const float*)(c.ws + WS_AMAX); const float* BTOT = (const float*)(c.ws + WS_BTOT);
    bf16* C0 = (bf16*)(c.ws + WS_C0); float* N0 = (float*)(c.ws + WS_N0); float* M0 = (float*)(c.ws + WS_M0);
    constexpr int PER = 8192 + 64, NPAIR = 8 * PER, JB = 26;
    LAS float* ams = (LAS float*)c.lds; LAS float* bts = ams + 8 * NCH;
    for (int i = c.tid; i < 8 * NCH; i += NTHREADS) { ams[i] = AMAX[i]; bts[i] = BTOT[i]; }
    __syncthreads();
    const int per_blk = (NPAIR + c.G - 1) / c.G;
    for (int t = c.tid; t < per_blk; t += NTHREADS) {
        const int e = c.bid * per_blk + t; if (e >= NPAIR) break;
        const int dh = e / PER, rem = e % PER; const bool isC = rem < 8192; const int idx = isC ? 2 * rem : 2 * (rem - 8192);
        const float* src = isC ? LT + (size_t)dh * NCH * 16384 + idx : NL + (size_t)dh * NCH * 128 + idx; const size_t sstep = isC ? 16384 : 128;
        float m = 0.f, v0 = 0.f, v1 = 0.f;
#pragma unroll 1
        for (int jb = 0; jb < NCH; jb += JB) {
            float2 lv[JB];
#pragma unroll
            for (int u = 0; u < JB; ++u) lv[u] = *(const float2*)(src + (size_t)(jb + u) * sstep);
#pragma unroll
            for (int u = 0; u < JB; ++u) {
                const int j = jb + u;
                if (j >= NCC) {
                    if (isC) *(unsigned*)(C0 + ((size_t)(dh * NCL + (j - NCC))) * 16384 + idx) = pk2(v0, v1);
                    else *(float2*)(N0 + (size_t)(dh * NCL + (j - NCC)) * 128 + idx) = make_float2(v0, v1);
                    if (rem == 0) M0[dh * NCL + (j - NCC)] = m;
                }
                const float bt = bts[dh * NCH + j], am = ams[dh * NCH + j];
                const float mn = fmaxf(bt + m, am), dec = __expf(bt + m - mn), sc = __expf(am - mn);
                v0 = dec * v0 + sc * lv[u].x; v1 = dec * v1 + sc * lv[u].y; m = mn;
            }
        }
    }
    __syncthreads();
}

namespace pg8 {
#define PG8_LAS __attribute__((address_space(3)))
typedef unsigned short bf16_t;
typedef short bf16x8 __attribute__((ext_vector_type(8)));
typedef float f32x4 __attribute__((ext_vector_type(4)));
typedef unsigned u32x4 __attribute__((ext_vector_type(4)));
constexpr int BM = 256, BK = 64, HALF = 128, HTB = HALF * BK * 2  , STAGE_BYTES = 8 * HTB, NXCD = 8, WGM = 8;

__host__ __device__ __forceinline__ int lds_byte(int r, int c) { const int st = (r >> 4) * 2 + (c >> 5), rr = r & 15, cc = c & 31, ob = rr * 64 + cc * 2; return st * 1024 + (ob ^ (((ob >> 9) & 1) << 5)); }
__host__ __device__ __forceinline__ void stage_rc(int b, int& R, int& C) { const int st = b / 1024, sb = b % 1024, swz = sb ^ (((sb >> 9) & 1) << 5); R = (st >> 1) * 16 + swz / 64; C = (st & 1) * 32 + (swz % 64) / 2; }
__host__ __device__ __forceinline__ int perm32(int rho) { const int n = rho >> 4, i = rho & 15; return 8 * (i >> 2) + 4 * n + (i & 3); }

struct Unit { int pm, pn; };
struct Gemm { const bf16_t* A; const bf16_t* Bt; int M, N, K; };

struct StaticOrder {
    int nM, nN, nwg, G, c;
    __host__ __device__ void init(int M, int N, int G_, int c_) { nM = M / BM; nN = N / BM; nwg = nM * nN; G = G_; c = c_; }
    __host__ __device__ bool next(int i, Unit& u) const {
        const long L = (long)i * G + c; if (L >= nwg) return false;
        int wgid = (int)L; { const int q = nwg / NXCD, r = nwg % NXCD, xcd = wgid % NXCD, off = wgid / NXCD; wgid = (xcd < r ? xcd * (q + 1) : r * (q + 1) + (xcd - r) * q) + off; }
        const int nig = WGM * nN, gid = wgid / nig, fm = gid * WGM, gsz = (nM - fm) < WGM ? (nM - fm) : WGM;
        u.pm = fm + ((wgid % nig) % gsz); u.pn = (wgid % nig) / gsz; return true;
    }
    __device__ __forceinline__ void a_ready(const Unit&) const {}
    __device__ __forceinline__ void done(const Unit&) const {}
};
__device__ __forceinline__ unsigned cvt_pk_bf16(float lo, float hi) { unsigned r; asm volatile("v_cvt_pk_bf16_f32 %0, %1, %2" : "=v"(r) : "v"(lo), "v"(hi)); return r; }
template <class Epi, class Sched, bool ALIGN_EPI = false, bool SP2 = false>
__device__ __forceinline__ void gemm_phase(PG8_LAS unsigned char* lds, const Gemm g, const Sched& S, const Epi& E) {
    int tid_ = threadIdx.x; asm volatile("" : "+v"(tid_));
    const int tid = tid_, wid = __builtin_amdgcn_readfirstlane(tid >> 6), lane = tid & 63, wr = wid >> 2, wc = wid & 3, fr = lane & 15, fq = lane >> 4;
    const int K = g.K, nt = K / BK;
    unsigned voffA[2], voffB[2];
#pragma unroll
    for (int i = 0; i < 2; ++i) { int R, C; stage_rc(tid * 16 + i * 8192, R, C); const int Rb = Epi::PERM ? ((R & ~31) + perm32(R & 31)) : R;
        voffA[i] = (unsigned)(R * K + C) * 2u; voffB[i] = (unsigned)(Rb * K + C) * 2u; }
    const size_t kstep = (size_t)(BK * 2);
    const size_t hstep = (size_t)HALF * K * 2;
    const size_t tstep = 2 * hstep;
    const unsigned ldsw = (unsigned)wid * 1024u;
    const int aoff = lds_byte(wr * 64 + fr, fq * 8), boff = lds_byte(wc * 32 + fr, fq * 8);
#define PG8_SA(b, h) (((b) * 2 + (h)) * HTB)
#define PG8_SB(b, h) ((4 + (b) * 2 + (h)) * HTB)
#define PG8_STAGE(bufoff, gbase, voff) do { _Pragma("unroll") for (int _i = 0; _i < 2; ++_i) \
        __builtin_amdgcn_global_load_lds((const unsigned*)((const char*)(gbase) + (voff)[_i]), (PG8_LAS unsigned*)(lds + (bufoff) + ldsw + _i * 8192), 16, 0, 0); } while (0)
#define PG8_LDA(dst, b, h) do { _Pragma("unroll") for (int m = 0; m < 4; ++m) _Pragma("unroll") for (int k = 0; k < 2; ++k) dst[m][k] = *(const PG8_LAS bf16x8*)(lds + PG8_SA(b, h) + aoff + m * 2048 + k * 1024); } while (0)
#define PG8_LDB(dst, b, h) do { _Pragma("unroll") for (int n = 0; n < 2; ++n) _Pragma("unroll") for (int k = 0; k < 2; ++k) dst[n][k] = *(const PG8_LAS bf16x8*)(lds + PG8_SB(b, h) + boff + n * 2048 + k * 1024); } while (0)
#define PG8_MMA(ai, bj, At, Bt) do { __builtin_amdgcn_s_setprio(1); _Pragma("unroll") for (int m = 0; m < 4; ++m) _Pragma("unroll") for (int n = 0; n < 2; ++n) _Pragma("unroll") for (int k = 0; k < 2; ++k) \
        acc[ai][bj][m][n] = __builtin_amdgcn_mfma_f32_16x16x32_bf16(Bt[n][k], At[m][k], acc[ai][bj][m][n], 0, 0, 0); __builtin_amdgcn_s_setprio(0); } while (0)
#define PG8_WAIT_V(n) asm volatile("s_waitcnt vmcnt(" #n ")" ::: "memory")
#define PG8_WAIT_L(n) asm volatile("s_waitcnt lgkmcnt(" #n ")" ::: "memory")
#define PG8_BAR __builtin_amdgcn_s_barrier()
#define PG8_SCHED __builtin_amdgcn_sched_barrier(0)
    Unit cur, nxt; int ui = 0;
    if (!S.next(0, cur)) return;
    f32x4 acc[2][2][4][2];
#pragma unroll
    for (int a = 0; a < 2; ++a)
#pragma unroll
        for (int b = 0; b < 2; ++b)
#pragma unroll
            for (int m = 0; m < 4; ++m)
#pragma unroll
                for (int n = 0; n < 2; ++n) acc[a][b][m][n] = (f32x4){0.f, 0.f, 0.f, 0.f};
    bf16x8 At[4][2], B0[2][2], B1[2][2];
    const char* cA = (const char*)g.A + (size_t)cur.pm * tstep; const char* cB = (const char*)g.Bt + (size_t)cur.pn * tstep;
    S.a_ready(cur);
    if constexpr (SP2) {
        PG8_STAGE(PG8_SB(0, 0), cB, voffB); PG8_STAGE(PG8_SB(0, 1), cB + hstep, voffB); PG8_STAGE(PG8_SA(0, 0), cA, voffA); PG8_STAGE(PG8_SA(0, 1), cA + hstep, voffA);
        if (wr == 1) PG8_BAR;
        PG8_WAIT_V(2); PG8_BAR;
        PG8_STAGE(PG8_SB(1, 0), cB + kstep, voffB); PG8_STAGE(PG8_SA(1, 0), cA + kstep, voffA); PG8_STAGE(PG8_SB(1, 1), cB + hstep + kstep, voffB);
        PG8_WAIT_V(6); PG8_BAR;
    } else {
        PG8_STAGE(PG8_SB(0, 0), cB, voffB); PG8_STAGE(PG8_SA(0, 0), cA, voffA); PG8_STAGE(PG8_SB(0, 1), cB + hstep, voffB); PG8_STAGE(PG8_SA(0, 1), cA + hstep, voffA);
        if (wr == 1) PG8_BAR;
        PG8_WAIT_V(4); PG8_BAR;
        PG8_STAGE(PG8_SB(1, 0), cB + kstep, voffB); PG8_STAGE(PG8_SA(1, 0), cA + kstep, voffA); PG8_STAGE(PG8_SB(1, 1), cB + hstep + kstep, voffB);
        PG8_WAIT_V(6); PG8_BAR;
    }
    for (;;) {
        const bool has_next = S.next(ui + 1, nxt);
        const char* nA = has_next ? (const char*)g.A + (size_t)nxt.pm * tstep : cA; const char* nB = has_next ? (const char*)g.Bt + (size_t)nxt.pn * tstep : cB;
        for (int t = 0; t < nt; t += 2) {
            const bool last = (t == nt - 2);
            const char* a1 = cA + (size_t)(t + 1) * kstep;
            const char* a2 = last ? nA : cA + (size_t)(t + 2) * kstep; const char* b2 = last ? nB : cB + (size_t)(t + 2) * kstep;
            const char* a3 = a2 + kstep; const char* b3 = b2 + kstep;
            if (last && has_next) S.a_ready(nxt);
            if constexpr (SP2) {
            PG8_LDB(B0, 0, 0); PG8_LDB(B1, 0, 1); PG8_SCHED; PG8_LDA(At, 0, 0); PG8_STAGE(PG8_SA(1, 1), a1 + hstep, voffA);
            PG8_WAIT_V(8); PG8_WAIT_L(0); PG8_BAR; PG8_MMA(0, 0, At, B0); PG8_MMA(0, 1, At, B1); PG8_BAR; PG8_SCHED;
            PG8_LDA(At, 0, 1); PG8_STAGE(PG8_SB(0, 0), b2, voffB); PG8_STAGE(PG8_SB(0, 1), b2 + hstep, voffB); PG8_STAGE(PG8_SA(0, 0), a2, voffA);
            PG8_WAIT_V(8); PG8_WAIT_L(0); PG8_BAR; PG8_MMA(1, 0, At, B0); PG8_MMA(1, 1, At, B1); PG8_BAR; PG8_SCHED;
            PG8_LDB(B0, 1, 0); PG8_LDB(B1, 1, 1); PG8_SCHED; PG8_LDA(At, 1, 0); PG8_STAGE(PG8_SA(0, 1), a2 + hstep, voffA);
            PG8_WAIT_V(8); PG8_WAIT_L(0); PG8_BAR; PG8_MMA(0, 0, At, B0); PG8_MMA(0, 1, At, B1); PG8_BAR; PG8_SCHED;
            PG8_LDA(At, 1, 1); PG8_STAGE(PG8_SB(1, 0), b3, voffB); PG8_STAGE(PG8_SB(1, 1), b3 + hstep, voffB); PG8_STAGE(PG8_SA(1, 0), a3, voffA);
            PG8_WAIT_V(8); PG8_WAIT_L(0); PG8_BAR; PG8_MMA(1, 0, At, B0); PG8_MMA(1, 1, At, B1); PG8_BAR; PG8_SCHED;
            } else {
            PG8_LDB(B0, 0, 0); PG8_SCHED; PG8_LDA(At, 0, 0); PG8_STAGE(PG8_SA(1, 1), a1 + hstep, voffA);
            PG8_WAIT_L(8); PG8_BAR; PG8_WAIT_L(0); PG8_MMA(0, 0, At, B0); PG8_BAR; PG8_SCHED;
            PG8_LDB(B1, 0, 1); PG8_STAGE(PG8_SB(0, 0), b2, voffB);
            PG8_BAR; PG8_WAIT_L(0); PG8_MMA(0, 1, At, B1); PG8_BAR;
            PG8_LDA(At, 0, 1); PG8_STAGE(PG8_SA(0, 0), a2, voffA);
            PG8_BAR; PG8_WAIT_L(0); PG8_MMA(1, 0, At, B0); PG8_BAR; PG8_SCHED;
            PG8_STAGE(PG8_SB(0, 1), b2 + hstep, voffB);
            PG8_WAIT_V(6); PG8_BAR; PG8_MMA(1, 1, At, B1); PG8_BAR;
            PG8_LDB(B0, 1, 0); PG8_SCHED; PG8_LDA(At, 1, 0); PG8_STAGE(PG8_SA(0, 1), a2 + hstep, voffA);
            PG8_WAIT_L(8); PG8_BAR; PG8_WAIT_L(0); PG8_MMA(0, 0, At, B0); PG8_BAR; PG8_SCHED;
            PG8_LDB(B1, 1, 1); PG8_STAGE(PG8_SB(1, 0), b3, voffB);
            PG8_BAR; PG8_WAIT_L(0); PG8_MMA(0, 1, At, B1); PG8_BAR;
            PG8_LDA(At, 1, 1); PG8_STAGE(PG8_SA(1, 0), a3, voffA);
            PG8_BAR; PG8_WAIT_L(0); PG8_MMA(1, 0, At, B0); PG8_BAR; PG8_SCHED;
            PG8_STAGE(PG8_SB(1, 1), b3 + hstep, voffB);
            PG8_WAIT_V(6); PG8_BAR; PG8_MMA(1, 1, At, B1); PG8_BAR;
            }
        }
        if constexpr (ALIGN_EPI) { if (wr == 0) PG8_BAR; }
        if constexpr (!Epi::AFTER_DRAIN) { E(acc, cur, wr, wc, fr, fq); S.done(cur); }
        if (!has_next) break;
#pragma unroll
        for (int a = 0; a < 2; ++a)
#pragma unroll
            for (int b = 0; b < 2; ++b)
#pragma unroll
                for (int m = 0; m < 4; ++m)
#pragma unroll
                    for (int n = 0; n < 2; ++n) acc[a][b][m][n] = (f32x4){0.f, 0.f, 0.f, 0.f};
        cur = nxt; cA = nA; cB = nB; ++ui;
        if constexpr (ALIGN_EPI) { if (wr == 1) PG8_BAR; }
    }
    PG8_WAIT_V(0);
    if constexpr (!ALIGN_EPI) { if (wr == 0) PG8_BAR; }
    PG8_BAR;
    if constexpr (Epi::AFTER_DRAIN) { E.fused(acc, cur, wr, wc, fr, fq, lds, wid, lane); S.done(cur); }
#undef PG8_SA
#undef PG8_SB
#undef PG8_STAGE
#undef PG8_LDA
#undef PG8_LDB
#undef PG8_MMA
#undef PG8_WAIT_V
#undef PG8_WAIT_L
#undef PG8_BAR
#undef PG8_SCHED
}
template <class Epi, class Sched>
__device__ __forceinline__ void gemm_phase_g(PG8_LAS unsigned char* lds, const Gemm g, const Sched& S, const Epi& E) {
    int tid_ = threadIdx.x; asm volatile("" : "+v"(tid_));
    const int tid = tid_, wid = __builtin_amdgcn_readfirstlane(tid >> 6), lane = tid & 63, wr = wid >> 2, wc = wid & 3, fr = lane & 15, fq = lane >> 4;
    const int K = g.K, nt = K / BK;
    unsigned voffA[2], voffB[2];
#pragma unroll
    for (int i = 0; i < 2; ++i) { int R, C; stage_rc(tid * 16 + i * 8192, R, C); const int Rb = Epi::PERM ? ((R & ~31) + perm32(R & 31)) : R;
        voffA[i] = (unsigned)(R * K + C) * 2u; voffB[i] = (unsigned)(Rb * K + C) * 2u; }
    const size_t kstep = (size_t)(BK * 2);
    const size_t hstep = (size_t)HALF * K * 2;
    const size_t tstep = 2 * hstep;
    const unsigned ldsw = (unsigned)wid * 1024u;
    const int aoff = lds_byte(wr * 64 + fr, fq * 8), boff = lds_byte(wc * 32 + fr, fq * 8);
#define PG8_SA(b, h) (((b) * 2 + (h)) * HTB)
#define PG8_SB(b, h) ((4 + (b) * 2 + (h)) * HTB)
#define PG8_STAGE(bufoff, gbase, voff) do { _Pragma("unroll") for (int _i = 0; _i < 2; ++_i) \
        __builtin_amdgcn_global_load_lds((const unsigned*)((const char*)(gbase) + (voff)[_i]), (PG8_LAS unsigned*)(lds + (bufoff) + ldsw + _i * 8192), 16, 0, 0); } while (0)
#define PG8_STAGE_A(bufoff, kt, o) do { _Pragma("unroll") for (int _i = 0; _i < 2; ++_i) \
        __builtin_amdgcn_global_load_lds((const unsigned*)((const char*)g.A + (size_t)(kt) * kstep + (o)[_i]), (PG8_LAS unsigned*)(lds + (bufoff) + ldsw + _i * 8192), 16, 0, 0); } while (0)
#define PG8_LDA(dst, b, h) do { _Pragma("unroll") for (int m = 0; m < 4; ++m) _Pragma("unroll") for (int k = 0; k < 2; ++k) dst[m][k] = *(const PG8_LAS bf16x8*)(lds + PG8_SA(b, h) + aoff + m * 2048 + k * 1024); } while (0)
#define PG8_LDB(dst, b, h) do { _Pragma("unroll") for (int n = 0; n < 2; ++n) _Pragma("unroll") for (int k = 0; k < 2; ++k) dst[n][k] = *(const PG8_LAS bf16x8*)(lds + PG8_SB(b, h) + boff + n * 2048 + k * 1024); } while (0)
#define PG8_MMA(ai, bj, At, Bt) do { __builtin_amdgcn_s_setprio(1); _Pragma("unroll") for (int m = 0; m < 4; ++m) _Pragma("unroll") for (int n = 0; n < 2; ++n) _Pragma("unroll") for (int k = 0; k < 2; ++k) \
        acc[ai][bj][m][n] = __builtin_amdgcn_mfma_f32_16x16x32_bf16(Bt[n][k], At[m][k], acc[ai][bj][m][n], 0, 0, 0); __builtin_amdgcn_s_setprio(0); } while (0)
#define PG8_WAIT_V(n) asm volatile("s_waitcnt vmcnt(" #n ")" ::: "memory")
#define PG8_WAIT_L(n) asm volatile("s_waitcnt lgkmcnt(" #n ")" ::: "memory")
#define PG8_BAR __builtin_amdgcn_s_barrier()
#define PG8_SCHED __builtin_amdgcn_sched_barrier(0)
    Unit cur, nxt; int ui = 0;
    if (!S.next(0, cur)) return;
    f32x4 acc[2][2][4][2];
#pragma unroll
    for (int a = 0; a < 2; ++a)
#pragma unroll
        for (int b = 0; b < 2; ++b)
#pragma unroll
            for (int m = 0; m < 4; ++m)
#pragma unroll
                for (int n = 0; n < 2; ++n) acc[a][b][m][n] = (f32x4){0.f, 0.f, 0.f, 0.f};
    bf16x8 At[4][2], B0[2][2], B1[2][2];
    const char* cB = (const char*)g.Bt + (size_t)cur.pn * tstep;
    S.a_ready(cur);
    int R0_, C0_; stage_rc(tid * 16, R0_, C0_);
    unsigned oc[2][2], on[2][2];
    S.a_offsets(cur, R0_, C0_ * 2, K, oc);
    if constexpr (true) {
        PG8_STAGE(PG8_SB(0, 0), cB, voffB); PG8_STAGE(PG8_SB(0, 1), cB + hstep, voffB); PG8_STAGE_A(PG8_SA(0, 0), 0, oc[0]); PG8_STAGE_A(PG8_SA(0, 1), 0, oc[1]);
        if (wr == 1) PG8_BAR;
        PG8_WAIT_V(2); PG8_BAR;
        PG8_STAGE(PG8_SB(1, 0), cB + kstep, voffB); PG8_STAGE_A(PG8_SA(1, 0), 1, oc[0]); PG8_STAGE(PG8_SB(1, 1), cB + hstep + kstep, voffB);
        PG8_WAIT_V(6); PG8_BAR;
    }
    for (;;) {
        const bool has_next = S.next(ui + 1, nxt);
        const char* nB = has_next ? (const char*)g.Bt + (size_t)nxt.pn * tstep : cB;
        if (has_next) S.a_offsets(nxt, R0_, C0_ * 2, K, on); else { on[0][0] = oc[0][0]; on[0][1] = oc[0][1]; on[1][0] = oc[1][0]; on[1][1] = oc[1][1]; }
        for (int t = 0; t < nt; t += 2) {
            const bool last = (t == nt - 2);
            const char* b2 = last ? nB : cB + (size_t)(t + 2) * kstep;
            const char* b3 = b2 + kstep;
            const int kt2 = last ? 0 : t + 2;
            unsigned o2[2][2];
            o2[0][0] = last ? on[0][0] : oc[0][0]; o2[0][1] = last ? on[0][1] : oc[0][1]; o2[1][0] = last ? on[1][0] : oc[1][0]; o2[1][1] = last ? on[1][1] : oc[1][1];
            if (last && has_next) S.a_ready(nxt);
            if constexpr (true) {
            PG8_LDB(B0, 0, 0); PG8_LDB(B1, 0, 1); PG8_SCHED; PG8_LDA(At, 0, 0); PG8_STAGE_A(PG8_SA(1, 1), t + 1, oc[1]);
            PG8_WAIT_V(8); PG8_WAIT_L(0); PG8_BAR; PG8_MMA(0, 0, At, B0); PG8_MMA(0, 1, At, B1); PG8_BAR; PG8_SCHED;
            PG8_LDA(At, 0, 1); PG8_STAGE(PG8_SB(0, 0), b2, voffB); PG8_STAGE(PG8_SB(0, 1), b2 + hstep, voffB); PG8_STAGE_A(PG8_SA(0, 0), kt2, o2[0]);
            PG8_WAIT_V(8); PG8_WAIT_L(0); PG8_BAR; PG8_MMA(1, 0, At, B0); PG8_MMA(1, 1, At, B1); PG8_BAR; PG8_SCHED;
            PG8_LDB(B0, 1, 0); PG8_LDB(B1, 1, 1); PG8_SCHED; PG8_LDA(At, 1, 0); PG8_STAGE_A(PG8_SA(0, 1), kt2, o2[1]);
            PG8_WAIT_V(8); PG8_WAIT_L(0); PG8_BAR; PG8_MMA(0, 0, At, B0); PG8_MMA(0, 1, At, B1); PG8_BAR; PG8_SCHED;
            PG8_LDA(At, 1, 1); PG8_STAGE(PG8_SB(1, 0), b3, voffB); PG8_STAGE(PG8_SB(1, 1), b3 + hstep, voffB); PG8_STAGE_A(PG8_SA(1, 0), kt2 + 1, o2[0]);
            PG8_WAIT_V(8); PG8_WAIT_L(0); PG8_BAR; PG8_MMA(1, 0, At, B0); PG8_MMA(1, 1, At, B1); PG8_BAR; PG8_SCHED;
            }
        }
        if constexpr (true) { if (wr == 0) PG8_BAR; }
        if constexpr (!Epi::AFTER_DRAIN) { E(acc, cur, wr, wc, fr, fq); S.done(cur); }
        if (!has_next) break;
#pragma unroll
        for (int a = 0; a < 2; ++a)
#pragma unroll
            for (int b = 0; b < 2; ++b)
#pragma unroll
                for (int m = 0; m < 4; ++m)
#pragma unroll
                    for (int n = 0; n < 2; ++n) acc[a][b][m][n] = (f32x4){0.f, 0.f, 0.f, 0.f};
        cur = nxt; cB = nB; ++ui; oc[0][0] = on[0][0]; oc[0][1] = on[0][1]; oc[1][0] = on[1][0]; oc[1][1] = on[1][1];
        if constexpr (true) { if (wr == 1) PG8_BAR; }
    }
    PG8_WAIT_V(0);
    if constexpr (false) { if (wr == 0) PG8_BAR; }
    PG8_BAR;
    if constexpr (Epi::AFTER_DRAIN) { E.fused(acc, cur, wr, wc, fr, fq, lds, wid, lane); S.done(cur); }
#undef PG8_SA
#undef PG8_SB
#undef PG8_STAGE
#undef PG8_STAGE_A
#undef PG8_LDA
#undef PG8_LDB
#undef PG8_MMA
#undef PG8_WAIT_V
#undef PG8_WAIT_L
#undef PG8_BAR
#undef PG8_SCHED
}
}

#define PG8_SP2 true
#define PG8_ALIGN true
template <class RowMap>
__device__ __forceinline__ void transpose_item(const float* W, int K, int N, bf16* WT, const RowMap& rm, LAS float* scr, int item, int lane) {
    const int nblk = N / 32, kb = item / nblk, nb = item % nblk, k0 = 64 * kb, n0 = 32 * nb;
    {
        f32x4 v[8];
#pragma unroll
        for (int i = 0; i < 8; ++i) v[i] = *(const f32x4*)(W + (size_t)(k0 + 8 * i + (lane >> 3)) * N + n0 + 4 * (lane & 7));
#pragma unroll
        for (int i = 0; i < 8; ++i) { LAS float* d = scr + (8 * i + (lane >> 3)) * 33 + 4 * (lane & 7); d[0] = v[i][0]; d[1] = v[i][1]; d[2] = v[i][2]; d[3] = v[i][3]; }
    }
    asm volatile("s_waitcnt lgkmcnt(0)" ::: "memory");
    const int c = lane & 7;
#pragma unroll
    for (int j = 0; j < 4; ++j) { const int n = (lane >> 3) + 8 * j; const LAS float* sp = scr + (8 * c) * 33 + n;
        v4u o; o.x = pk2(sp[0 * 33], sp[1 * 33]); o.y = pk2(sp[2 * 33], sp[3 * 33]); o.z = pk2(sp[4 * 33], sp[5 * 33]); o.w = pk2(sp[6 * 33], sp[7 * 33]);
        *(v4u*)(WT + (size_t)rm(n0 + n) * K + k0 + 8 * c) = o; }
    asm volatile("s_waitcnt lgkmcnt(0)" ::: "memory");
}
struct RowId { __device__ __forceinline__ int operator()(int n) const { return n; } };
struct RowGU { int off; __device__ __forceinline__ int operator()(int n) const { return 256 * (n >> 7) + (n & 127) + off; } };
__device__ __forceinline__ void conv_small_weights(const Ctx& c) {
    LAS float* scr = (LAS float*)c.lds + c.wave * 4096;
    constexpr int I_IN = (D / 64) * (DIN / 32), I_OUT = (D / 64) * (D / 32);
    for (int it = c.gw; it < I_IN + I_OUT; it += c.NGW) {
        if (it < I_IN) transpose_item(inp(c, 10), D, DIN, (bf16*)(c.ws + WS_WIN_T), RowId{}, scr, it, c.lane);
        else transpose_item(inp(c, 23), D, D, (bf16*)(c.ws + WS_WOUT_T), RowId{}, scr, it - I_IN, c.lane);
    }
}
__device__ __forceinline__ void conv_moe_gu(const Ctx& c) {
    LAS float* scr = (LAS float*)c.lds + c.wave * 4096;
    constexpr int I_G = (D / 64) * (DE / 32), PER_E = 2 * I_G;
    for (int it = c.gw; it < NE * PER_E; it += c.NGW) {
        const int e = it / PER_E; const int r = it % PER_E;
        bf16* gu = (bf16*)(c.ws + WS_WGU_T) + (size_t)e * 1024 * 1024;
        if (r < I_G) transpose_item(inp(c, 28) + (size_t)e * D * DE, D, DE, gu, RowGU{0}, scr, r, c.lane);
        else transpose_item(inp(c, 29) + (size_t)e * D * DE, D, DE, gu, RowGU{128}, scr, r - I_G, c.lane);
    }
}
__device__ __forceinline__ void conv_moe_down(const Ctx& c, int w0, int nw) {
    LAS float* scr = (LAS float*)c.lds + c.wave * 4096;
    constexpr int I_D = (DE / 64) * (D / 32);
    for (int it = c.gw - w0; it < NE * I_D; it += nw) {
        const int e = it / I_D, r = it % I_D;
        transpose_item(inp(c, 30) + (size_t)e * DE * D, DE, D, (bf16*)(c.ws + WS_WD_T) + (size_t)e * 1024 * 512, RowId{}, scr, r, c.lane);
    }
}
__device__ __forceinline__ v4u pack8(const f32x4 a, const f32x4 b) { v4u w; w.x = pg8::cvt_pk_bf16(a[0], a[1]); w.y = pg8::cvt_pk_bf16(a[2], a[3]); w.z = pg8::cvt_pk_bf16(b[0], b[1]); w.w = pg8::cvt_pk_bf16(b[2], b[3]); return w; }
struct EpiProj {
    static constexpr bool PERM = true, AFTER_DRAIN = false;
    unsigned char* ws;
    __device__ __forceinline__ void operator()(const f32x4 (&acc)[2][2][4][2], const pg8::Unit& un, int wr, int wc, int fr, int fq) const {
        const int colt = un.pn * 256, reg = colt >> 9;
        const size_t off = WS_XM + (size_t)(reg & 1) * (WS_Z - WS_XM) + (size_t)(reg >> 1) * (WS_U - WS_XM);
        bf16* base = (bf16*)(ws + off);
        const int lc0 = (colt & 511) + wc * 32 + 8 * fq, row0 = un.pm * 256 + wr * 64 + fr;
#pragma unroll
        for (int ai = 0; ai < 2; ++ai)
#pragma unroll
            for (int m = 0; m < 4; ++m) { bf16* rowp = base + (size_t)(row0 + ai * 128 + m * 16) * DM + lc0;
#pragma unroll
                for (int bj = 0; bj < 2; ++bj) *(v4u*)(rowp + bj * 128) = pack8(acc[ai][bj][m][0], acc[ai][bj][m][1]); }
    }
};
struct EpiY {
    static constexpr bool PERM = true, AFTER_DRAIN = false;
    bf16* Y;
    __device__ __forceinline__ void operator()(const f32x4 (&acc)[2][2][4][2], const pg8::Unit& un, int wr, int wc, int fr, int fq) const {
        const int row0 = un.pm * 256 + wr * 64 + fr, col0 = un.pn * 256 + wc * 32 + 8 * fq;
#pragma unroll
        for (int ai = 0; ai < 2; ++ai)
#pragma unroll
            for (int m = 0; m < 4; ++m) { bf16* rowp = Y + (size_t)(row0 + ai * 128 + m * 16) * D + col0;
#pragma unroll
                for (int bj = 0; bj < 2; ++bj) *(v4u*)(rowp + bj * 128) = pack8(acc[ai][bj][m][0], acc[ai][bj][m][1]); }
    }
};
struct EpiSwiGLU {
    static constexpr bool PERM = true, AFTER_DRAIN = false;
    bf16* act; const float* roww; const volatile LAS int* ts;
    __device__ __forceinline__ void operator()(const f32x4 (&acc)[2][2][4][2], const pg8::Unit& un, int wr, int wc, int fr, int fq) const {
        const int e = un.pn >> 2, row0 = un.pm * 256 + wr * 64 + fr, col0 = (un.pn & 3) * 128 + wc * 32 + 8 * fq, slot0 = (un.pm - ts[e]) * 256 + wr * 64 + fr, cnt = ts[17 + e];
#pragma unroll
        for (int ai = 0; ai < 2; ++ai)
#pragma unroll
            for (int m = 0; m < 4; ++m) { const int row = row0 + ai * 128 + m * 16, slot = slot0 + ai * 128 + m * 16; const float w = slot < cnt ? roww[(size_t)e * T + slot] : 0.f;
                f32x4 o[2];
#pragma unroll
                for (int n = 0; n < 2; ++n)
#pragma unroll
                    for (int i = 0; i < 4; ++i) { const float g = acc[ai][0][m][n][i], uu = acc[ai][1][m][n][i]; o[n][i] = siluf(g) * uu * w; }
                *(v4u*)(act + (size_t)row * DE + col0) = pack8(o[0], o[1]); }
    }
};
struct EpiDown {
    static constexpr bool PERM = true, AFTER_DRAIN = false;
    bf16* yrow;
    __device__ __forceinline__ void operator()(const f32x4 (&acc)[2][2][4][2], const pg8::Unit& un, int wr, int wc, int fr, int fq) const {
        const int row0 = un.pm * 256 + wr * 64 + fr, col0 = (un.pn & 3) * 256 + wc * 32 + 8 * fq;
#pragma unroll
        for (int ai = 0; ai < 2; ++ai)
#pragma unroll
            for (int m = 0; m < 4; ++m) { bf16* rowp = yrow + (size_t)(row0 + ai * 128 + m * 16) * D + col0;
#pragma unroll
                for (int bj = 0; bj < 2; ++bj) *(v4u*)(rowp + bj * 128) = pack8(acc[ai][bj][m][0], acc[ai][bj][m][1]); }
    }
};
struct MoeOrder {
    int G, c; const volatile LAS int* ts; const int* rowtok;
    __device__ __forceinline__ bool next(int i, pg8::Unit& u) const {
        const int L = i * G + c; if (L >= ts[16] * 4) return false;
        const int mt = L >> 2; int e = 0;
#pragma unroll
        for (int j = 1; j < 16; ++j) e += (mt >= ts[j]) ? 1 : 0;
        u.pm = mt; u.pn = e * 4 + (L & 3); return true;
    }
    __device__ __forceinline__ void a_offsets(const pg8::Unit& u, int R0, int Cb, int K, unsigned (&o)[2][2]) const {
        const int e = u.pn >> 2, base = (u.pm - ts[e]) * 256 + R0, cnt = ts[17 + e];
#pragma unroll
        for (int h = 0; h < 2; ++h)
#pragma unroll
            for (int i = 0; i < 2; ++i) { const int slot = base + 128 * h + 64 * i; const int tok = slot < cnt ? rowtok[(size_t)e * T + slot] : 0; o[h][i] = (unsigned)tok * (unsigned)(K * 2) + (unsigned)Cb; }
    }
    __device__ __forceinline__ void a_ready(const pg8::Unit&) const {}
    __device__ __forceinline__ void done(const pg8::Unit&) const {}
};
__device__ __forceinline__ int vcu_of(const Ctx& c) { return (c.G % 8 == 0) ? (c.bid % 8) * (c.G / 8) + c.bid / 8 : c.bid; }
__device__ __forceinline__ void moe_tile_table(const Ctx& c, volatile LAS int* ts) {
    if (c.tid < 64) {
        const unsigned* cnt = (const unsigned*)(c.ws + WS_CTL) + CW_CNT;
        const int e = c.lane & 15;
        const int n = (int)__hip_atomic_load(cnt + e, __ATOMIC_RELAXED, __HIP_MEMORY_SCOPE_AGENT);
        const int tl = (n + 255) >> 8; int pre = tl;
#pragma unroll
        for (int o = 1; o < 16; o <<= 1) { const int y = __shfl_up(pre, o); if (e >= o) pre += y; }
        if (c.lane < 16) { ts[e] = pre - tl; ts[17 + e] = n; if (e == 15) ts[16] = pre; }
    }
    __syncthreads();
}

__device__ __forceinline__ void g1_gemm1(const Ctx& c) {
    pg8::Gemm g{(const bf16*)(c.ws + WS_H), (const bf16*)(c.ws + WS_WIN_T), NT, DIN, D};
    pg8::StaticOrder S; S.init(NT, DIN, c.G, c.bid);
    EpiProj E{c.ws};
    pg8::gemm_phase<EpiProj, pg8::StaticOrder, PG8_ALIGN, PG8_SP2>((LAS unsigned char*)c.lds, g, S, E);
}
__device__ __forceinline__ void g2_outproj(const Ctx& c) {
    pg8::Gemm g{(const bf16*)(c.ws + WS_H), (const bf16*)(c.ws + WS_WOUT_T), T, D, D};
    pg8::StaticOrder S; S.init(T, D, c.G, c.bid);
    EpiY E{(bf16*)(c.ws + WS_Y)};
    pg8::gemm_phase<EpiY, pg8::StaticOrder, PG8_ALIGN, PG8_SP2>((LAS unsigned char*)c.lds, g, S, E);
}
__device__ __forceinline__ void g3_moe_up(const Ctx& c, volatile LAS int* ts) {
    moe_tile_table(c, ts);
    pg8::Gemm g{(const bf16*)(c.ws + WS_H), (const bf16*)(c.ws + WS_WGU_T), 0, 0, D};
    MoeOrder S{c.G, vcu_of(c), ts, (const int*)(c.ws + WS_ROWTOK)};
    EpiSwiGLU E{(bf16*)(c.ws + WS_ACTS), (const float*)(c.ws + WS_ROWW), ts};
    pg8::gemm_phase_g<EpiSwiGLU, MoeOrder>((LAS unsigned char*)c.lds, g, S, E);
}
__device__ __forceinline__ void g4_moe_down(const Ctx& c, volatile LAS int* ts) {
    moe_tile_table(c, ts);
    pg8::Gemm g{(const bf16*)(c.ws + WS_ACTS), (const bf16*)(c.ws + WS_WD_T), 0, 0, DE};
    MoeOrder S{c.G, vcu_of(c), ts, (const int*)(c.ws + WS_ROWTOK)};
    EpiDown E{(bf16*)(c.ws + WS_YROW)};
    pg8::gemm_phase<EpiDown, MoeOrder, PG8_ALIGN, PG8_SP2>((LAS unsigned char*)c.lds, g, S, E);
}

__device__ __forceinline__ void p10b_token(const Ctx& c) {
    const float* x = inp(c, 0); const float* g_post = inp(c, 7); const float* g_ffn = inp(c, 8);
    const float* wrg = inp(c, 24); const float* brg = inp(c, 25); const float* wre = inp(c, 26); const float* bre = inp(c, 27);
    const float* mod = (const float*)(c.ws + WS_MOD);
    const float* posR = (const float*)(c.ws + WS_POSR); const float* posC = (const float*)(c.ws + WS_POSC);
    const bf16* Y = (const bf16*)(c.ws + WS_Y); bf16* H2 = (bf16*)(c.ws + WS_H); int* RE = (int*)(c.ws + WS_RE); int* RS = (int*)(c.ws + WS_RS);
    unsigned* CNT = (unsigned*)(c.ws + WS_CTL) + CW_CNT;
    constexpr int WRS = 1028;
    LAS float* WRt = (LAS float*)c.lds;
    LAS int* hist = (LAS int*)(WRt + 20 * WRS); LAS int* gbase = hist + 16; LAS int* tinfo = hist + 32;
    LAS float* lgs = (LAS float*)(tinfo + 64 * 8);
    LAS float* bias = lgs + 64 * 20;
    for (int idx = c.tid; idx < 1024 * 20; idx += NTHREADS) {
        const int col = idx / 20, o = idx % 20;
        WRt[o * WRS + col] = o < 4 ? wrg[col * 4 + o] : wre[col * 16 + (o - 4)];
    }
    if (c.tid < 32) hist[c.tid] = 0;
    if (c.tid < 20) bias[c.tid] = c.tid < 4 ? brg[c.tid] : bre[c.tid - 4];
    __syncthreads();
    constexpr int RB = 1;
    const int nrows = (T - c.gw + c.NGW - 1) / c.NGW;
#pragma unroll 1
    for (int b0 = 0; b0 < nrows; b0 += RB) {
        asm volatile("" ::: "memory");
        f32x4 xv[RB][4], yv[RB][4];
#pragma unroll
        for (int q = 0; q < RB; ++q) {
            const int r = c.gw + (b0 + q < nrows ? b0 + q : b0) * c.NGW;
#pragma unroll
            for (int j = 0; j < 4; ++j) {
                const int col = 256 * j + 4 * c.lane;
                const float* pp = col < 512 ? posR + (r >> 6) * 512 + col : posC + (r & 63) * 512 + (col - 512);
                xv[q][j] = *(const f32x4*)(x + (size_t)r * D + col) + *(const f32x4*)pp;
                { const uint2 yw = *(const uint2*)(Y + (size_t)r * D + col); yv[q][j] = (f32x4){lo16(yw.x), hi16(yw.x), lo16(yw.y), hi16(yw.y)}; }
            }
        }
        float ss[RB];
#pragma unroll
        for (int q = 0; q < RB; ++q) { ss[q] = 0.f;
#pragma unroll
            for (int j = 0; j < 4; ++j) ss[q] += yv[q][j].x * yv[q][j].x + yv[q][j].y * yv[q][j].y + yv[q][j].z * yv[q][j].z + yv[q][j].w * yv[q][j].w; }
#pragma unroll
        for (int o = 1; o < 64; o <<= 1)
#pragma unroll
            for (int q = 0; q < RB; ++q) ss[q] += __shfl_xor(ss[q], o);
        float s2[RB];
#pragma unroll
        for (int q = 0; q < RB; ++q) {
            const int r = c.gw + (b0 + q) * c.NGW; const bool live = b0 + q < nrows;
            const float rinv = rsqrtf(ss[q] * (1.f / D) + EPS); s2[q] = 0.f;
#pragma unroll
            for (int j = 0; j < 4; ++j) {
                const int col = 256 * j + 4 * c.lane;
                const f32x4 gg = *(const f32x4*)(g_post + col), g1 = *(const f32x4*)(mod + 2048 + col);
                xv[q][j] = xv[q][j] + g1 * (yv[q][j] * rinv * gg);
                if (live) *(f32x4*)(c.out + (size_t)r * D + col) = xv[q][j];
                s2[q] += xv[q][j].x * xv[q][j].x + xv[q][j].y * xv[q][j].y + xv[q][j].z * xv[q][j].z + xv[q][j].w * xv[q][j].w;
            }
        }
#pragma unroll
        for (int o = 1; o < 64; o <<= 1)
#pragma unroll
            for (int q = 0; q < RB; ++q) s2[q] += __shfl_xor(s2[q], o);
        float lg[RB][20];
#pragma unroll
        for (int q = 0; q < RB; ++q)
#pragma unroll
            for (int o = 0; o < 20; ++o) lg[q][o] = 0.f;
#pragma unroll
        for (int j = 0; j < 4; ++j) {
            const int col = 256 * j + 4 * c.lane;
            const f32x4 gg = *(const f32x4*)(g_ffn + col), sh = *(const f32x4*)(mod + 3072 + col), sc = *(const f32x4*)(mod + 4096 + col);
            f32x4 hv[RB];
#pragma unroll
            for (int q = 0; q < RB; ++q) {
                const int r = c.gw + (b0 + q) * c.NGW;
                hv[q] = xv[q][j] * rsqrtf(s2[q] * (1.f / D) + EPS) * gg * (sc + 1.f) + sh;
                uint2 w; w.x = pk2(hv[q].x, hv[q].y); w.y = pk2(hv[q].z, hv[q].w);
                if (b0 + q < nrows) *(uint2*)(H2 + (size_t)r * D + col) = w;
            }
#pragma unroll
            for (int oc = 0; oc < 20; oc += 5) {
#pragma unroll
                for (int o = oc; o < oc + 5; ++o) { const f32x4 w4 = *(const LAS f32x4*)(WRt + o * WRS + col);
#pragma unroll
                    for (int q = 0; q < RB; ++q) lg[q][o] += hv[q].x * w4.x + hv[q].y * w4.y + hv[q].z * w4.z + hv[q].w * w4.w; }
                asm volatile("" ::: "memory");
            }
        }
#pragma unroll
        for (int o = 1; o < 64; o <<= 1)
#pragma unroll
            for (int q = 0; q < RB; ++q)
#pragma unroll
                for (int i = 0; i < 20; ++i) lg[q][i] += __shfl_xor(lg[q][i], o);
        if (c.lane == 0) {
#pragma unroll
            for (int q = 0; q < RB; ++q)
#pragma unroll
                for (int i = 0; i < 20; ++i) lgs[(c.wave * 8 + b0 + q) * 20 + i] = lg[q][i];
        }
    }
    if (c.lane < nrows) {
        const int r = c.gw + c.lane * c.NGW; const LAS float* lp = lgs + (c.wave * 8 + c.lane) * 20;
        float gl[4];
#pragma unroll
        for (int i = 0; i < 4; ++i) gl[i] = lp[i] + bias[i];
        int gs = 0; float gm = gl[0];
#pragma unroll
        for (int i = 1; i < 4; ++i) if (gl[i] > gm) { gm = gl[i]; gs = i; }
        float den = 0.f;
#pragma unroll
        for (int i = 0; i < 4; ++i) den += __expf(gl[i] - gm);
        const float psel = 1.f / den;
        float el[4];
#pragma unroll
        for (int i = 0; i < 4; ++i) el[i] = lp[4 + gs * 4 + i] + bias[4 + gs * 4 + i];
        int i1 = 0; float em1 = el[0];
#pragma unroll
        for (int i = 1; i < 4; ++i) if (el[i] > em1) { em1 = el[i]; i1 = i; }
        int i2 = -1; float em2 = -INFINITY;
#pragma unroll
        for (int i = 0; i < 4; ++i) if (i != i1 && el[i] > em2) { em2 = el[i]; i2 = i; }
        const float e2 = __expf(em2 - em1), w1 = psel / (1.f + e2), w2 = psel * e2 / (1.f + e2);
        const int ea = gs * 4 + i1, eb = gs * 4 + i2;
        RE[2 * r] = ea; RE[2 * r + 1] = eb;
        LAS int* ti = tinfo + (c.wave * 8 + c.lane) * 8;
        ti[0] = ea; ti[1] = eb; ti[2] = atomicAdd((int*)(hist + ea), 1); ti[3] = atomicAdd((int*)(hist + eb), 1); ti[4] = __float_as_int(w1); ti[5] = __float_as_int(w2);
    }
    __syncthreads();
    if (c.tid < 16) gbase[c.tid] = (int)__hip_atomic_fetch_add(CNT + c.tid, (unsigned)hist[c.tid], __ATOMIC_RELAXED, __HIP_MEMORY_SCOPE_AGENT);
    __syncthreads();
    if (c.lane < nrows) {
        const int r = c.gw + c.lane * c.NGW; const LAS int* ti = tinfo + (c.wave * 8 + c.lane) * 8;
        const int s0 = gbase[ti[0]] + ti[2], s1 = gbase[ti[1]] + ti[3];
        RS[2 * r] = s0; RS[2 * r + 1] = s1;
        int* ROWTOK = (int*)(c.ws + WS_ROWTOK); float* ROWW = (float*)(c.ws + WS_ROWW);
        ROWTOK[(size_t)ti[0] * T + s0] = r; ROWTOK[(size_t)ti[1] * T + s1] = r; ROWW[(size_t)ti[0] * T + s0] = __int_as_float(ti[4]); ROWW[(size_t)ti[1] * T + s1] = __int_as_float(ti[5]);
    }
    __syncthreads();
}
__device__ __forceinline__ void p10c_scatter(const Ctx& c) {
    const bf16* H2 = (const bf16*)(c.ws + WS_H); bf16* AS = (bf16*)(c.ws + WS_ASORT);
    const int* RE = (const int*)(c.ws + WS_RE); const float* RW = (const float*)(c.ws + WS_RW); int* RS = (int*)(c.ws + WS_RS); float* ROWW = (float*)(c.ws + WS_ROWW);
    const unsigned* CNT = (const unsigned*)(c.ws + WS_CTL) + CW_CNT;
    for (int r = c.gw; r < T; r += c.NGW) {
        asm volatile("" ::: "memory");
        const int e0 = RE[2 * r], e1 = RE[2 * r + 1]; int b0 = 0, b1 = 0;
        for (int e = 0; e < 16; ++e) { const int tl = (int)((CNT[e] + 255u) >> 8) * 256; b0 += e < e0 ? tl : 0; b1 += e < e1 ? tl : 0; }
        const int r0 = b0 + RS[2 * r], r1 = b1 + RS[2 * r + 1];
        const v4u* src = (const v4u*)(H2 + (size_t)r * D);
        const v4u a = src[c.lane], b = src[c.lane + 64];
        v4u* d0 = (v4u*)(AS + (size_t)r0 * D); v4u* d1 = (v4u*)(AS + (size_t)r1 * D);
        d0[c.lane] = a; d0[c.lane + 64] = b; d1[c.lane] = a; d1[c.lane + 64] = b;
        if (c.lane == 0) { ROWW[r0] = RW[2 * r]; ROWW[r1] = RW[2 * r + 1]; RS[2 * r] = r0; RS[2 * r + 1] = r1; }
    }
}
struct P12Ptrs { const float* g_post; const float* mod; const bf16* YR; const int* RS; const int* RE; float* out; };
__device__ __forceinline__ void p12_load(const P12Ptrs& p, int rb, int ngw, int lane, int tb, uint2 (&ya)[2][4], uint2 (&yb)[2][4], f32x4 (&xo)[2][4]) {
#pragma unroll
    for (int b = 0; b < 2; ++b) {
        const int r = rb + b * ngw < T ? rb + b * ngw : rb;
        const int e0 = p.RE[2 * r], e1 = p.RE[2 * r + 1];
        const int r0 = __shfl(tb, e0) + p.RS[2 * r], r1 = __shfl(tb, e1) + p.RS[2 * r + 1];
#pragma unroll
        for (int j = 0; j < 4; ++j) {
            const int col = 256 * j + 4 * lane;
            ya[b][j] = *(const uint2*)(p.YR + (size_t)r0 * D + col); yb[b][j] = *(const uint2*)(p.YR + (size_t)r1 * D + col);
            xo[b][j] = *(const f32x4*)(p.out + (size_t)r * D + col);
        }
    }
}
__device__ __forceinline__ void p12_compute(const P12Ptrs& p, int rb, int ngw, int lane, const uint2 (&ya)[2][4], const uint2 (&yb)[2][4], const f32x4 (&xo)[2][4]) {
    f32x4 yv[2][4]; float ss[2];
#pragma unroll
    for (int b = 0; b < 2; ++b) { ss[b] = 0.f;
#pragma unroll
        for (int j = 0; j < 4; ++j) {
            const uint2 a = ya[b][j], bb = yb[b][j];
            yv[b][j] = (f32x4){lo16(a.x) + lo16(bb.x), hi16(a.x) + hi16(bb.x), lo16(a.y) + lo16(bb.y), hi16(a.y) + hi16(bb.y)};
            ss[b] += yv[b][j].x * yv[b][j].x + yv[b][j].y * yv[b][j].y + yv[b][j].z * yv[b][j].z + yv[b][j].w * yv[b][j].w;
        } }
#pragma unroll
    for (int o = 1; o < 64; o <<= 1)
#pragma unroll
        for (int b = 0; b < 2; ++b) ss[b] += __shfl_xor(ss[b], o);
#pragma unroll
    for (int b = 0; b < 2; ++b) {
        const int r = rb + b * ngw; if (r >= T) continue;
        const float rinv = rsqrtf(ss[b] * (1.f / D) + EPS);
#pragma unroll
        for (int j = 0; j < 4; ++j) {
            const int col = 256 * j + 4 * lane;
            const f32x4 gg = *(const f32x4*)(p.g_post + col), g2 = *(const f32x4*)(p.mod + 5120 + col);
            *(f32x4*)(p.out + (size_t)r * D + col) = xo[b][j] + g2 * (yv[b][j] * rinv * gg);
        }
    }
}
__device__ __forceinline__ void p12b_final(const Ctx& c) {
    const P12Ptrs p{inp(c, 9), (const float*)(c.ws + WS_MOD), (const bf16*)(c.ws + WS_YROW), (const int*)(c.ws + WS_RS), (const int*)(c.ws + WS_RE), c.out};
    const unsigned* CNT = (const unsigned*)(c.ws + WS_CTL) + CW_CNT;
    int tb = 0;
    { int acc = 0;
#pragma unroll
      for (int e = 0; e < 16; ++e) { tb = (c.lane == e) ? acc : tb; acc += (int)((CNT[e] + 255u) >> 8) * 256; } }
    const int step = 2 * c.NGW;
    uint2 yaa[2][4], yba[2][4], yab[2][4], ybb[2][4]; f32x4 xa[2][4], xb[2][4];
    int rb = c.gw;
    if (rb >= T) return;
    p12_load(p, rb, c.NGW, c.lane, tb, yaa, yba, xa);
    for (;;) {
        int rn = rb + step; bool hn = rn < T;
        if (hn) p12_load(p, rn, c.NGW, c.lane, tb, yab, ybb, xb);
        p12_compute(p, rb, c.NGW, c.lane, yaa, yba, xa);
        if (!hn) break;
        rb = rn; rn = rb + step; hn = rn < T;
        if (hn) p12_load(p, rn, c.NGW, c.lane, tb, yaa, yba, xa);
        p12_compute(p, rb, c.NGW, c.lane, yab, ybb, xb);
        if (!hn) break;
        rb = rn;
    }
}

__device__ __forceinline__ void p4m_summaries(const Ctx& c) {
    const bf16* Kb = (const bf16*)(c.ws + WS_K); const bf16* Vb = (const bf16*)(c.ws + WS_V);
    const float* IG = (const float*)(c.ws + WS_IG); const float* LF = (const float*)(c.ws + WS_LF);
    float* LT = (float*)(c.ws + WS_L); float* NL = (float*)(c.ws + WS_NL); float* AMAX = (float*)(c.ws + WS_AMAX); float* BTOT = (float*)(c.ws + WS_BTOT);
    LAS unsigned char* L = (LAS unsigned char*)c.lds; LAS unsigned char* Ks = L; LAS unsigned char* Vs = L + TILE_B;
    LAS float* lfs = (LAS float*)(L + 2 * TILE_B); LAS float* as = lfs + 128; LAS float* red = as + 128;
    const int lane = c.lane, rt = c.wave >> 1, cg = c.wave & 1, fr = lane & 15, fg = lane >> 4;
    for (int it = c.bid; it < 2 * NH * NCH; it += c.G) {
        const int d = it / (NH * NCH), h = (it / NCH) % NH, j = it % NCH, r0 = chunk_row0(d, j);
        const float* lf = LF + (size_t)(d * 4 + h) * NT + r0; const float* ig = IG + (size_t)(d * 4 + h) * NT + r0;
        {
            const float lfv = c.tid < 128 ? lf[c.tid] : 0.f, igv = c.tid < 128 ? ig[c.tid] : 0.f;
            const float b = scan128<false>(lfv, d != 0, lfs, c.tid, c.lane, c.wave);
            if (c.tid == (d == 0 ? 127 : 0)) red[0] = b;
            __syncthreads();
            if (c.tid < 128) as[c.tid] = red[0] - b + igv;
        }
        __syncthreads();
        if (c.tid < 64) { float m = fmaxf(as[c.tid], as[c.tid + 64]);
#pragma unroll
            for (int o = 1; o < 64; o <<= 1) m = fmaxf(m, __shfl_xor(m, o));
            if (c.tid == 0) red[1] = m; }
        __syncthreads();
        const float amax = red[1], btot = red[0];
        for (int e = c.tid; e < 128 * 16; e += NTHREADS) {
            const int l = e >> 4, ch = e & 15; const float w = __expf(as[l] - amax);
            float f[8];
            unpack8(*(const v4u*)(Kb + (size_t)(r0 + l) * DM + h * DH + ch * 8), f);
            v4u o; o.x = pk2(f[0] * w, f[1] * w); o.y = pk2(f[2] * w, f[3] * w); o.z = pk2(f[4] * w, f[5] * w); o.w = pk2(f[6] * w, f[7] * w);
            *(LAS v4u*)(Ks + l * TSB + ch * 16) = o;
            *(LAS v4u*)(Vs + l * TSB + ch * 16) = *(const v4u*)(Vb + (size_t)(r0 + l) * DM + h * DH + ch * 8);
        }
        __syncthreads();
        f32x4 acc[2][4];
#pragma unroll
        for (int mt = 0; mt < 2; ++mt)
#pragma unroll
            for (int nt = 0; nt < 4; ++nt) acc[mt][nt] = (f32x4){0.f, 0.f, 0.f, 0.f};
#pragma unroll
        for (int ks = 0; ks < 4; ++ks) {
            h8 a[2], b[4];
#pragma unroll
            for (int mt = 0; mt < 2; ++mt) a[mt] = frag_tr(Vs, TSB, 32 * ks, 32 * rt + 16 * mt, lane);
#pragma unroll
            for (int nt = 0; nt < 4; ++nt) b[nt] = frag_tr(Ks, TSB, 32 * ks, 64 * cg + 16 * nt, lane);
#pragma unroll
            for (int mt = 0; mt < 2; ++mt)
#pragma unroll
                for (int nt = 0; nt < 4; ++nt) acc[mt][nt] = MFMA16(a[mt], b[nt], acc[mt][nt]);
        }
        float* dst = LT + (size_t)((d * 4 + h) * NCH + j) * 16384;
#pragma unroll
        for (int mt = 0; mt < 2; ++mt)
#pragma unroll
            for (int nt = 0; nt < 4; ++nt)
#pragma unroll
                for (int r = 0; r < 4; ++r) dst[(32 * rt + 16 * mt + 4 * fg + r) * 128 + 64 * cg + 16 * nt + fr] = acc[mt][nt][r];
        if (c.tid < 128) {
            float sacc = 0.f;
            for (int l = 0; l < 128; ++l) sacc += bf2f(*(const LAS bf16*)(Ks + l * TSB + c.tid * 2));
            NL[(size_t)((d * 4 + h) * NCH + j) * 128 + c.tid] = sacc;
            if (c.tid == 0) { AMAX[(d * 4 + h) * NCH + j] = amax; BTOT[(d * 4 + h) * NCH + j] = btot; }
        }
        __syncthreads();
    }
}

template <bool MAXOP>
__device__ __forceinline__ float scan256(float v, LAS float* tmp, int lane, int wave) {
    const bool rev = wave >= 2;
    float x = v;
#pragma unroll
    for (int o = 1; o < 64; o <<= 1) {
        const float y = rev ? __shfl_down(x, o) : __shfl_up(x, o);
        const bool ok = rev ? (lane + o < 64) : (lane >= o);
        if (ok) x = MAXOP ? fmaxf(x, y) : x + y;
    }
    if (wave < 4 && lane == (rev ? 0 : 63)) tmp[wave] = x;
    __syncthreads();
    if (wave == 1) x = MAXOP ? fmaxf(x, tmp[0]) : x + tmp[0];
    if (wave == 2) x = MAXOP ? fmaxf(x, tmp[3]) : x + tmp[3];
    __syncthreads();
    return x;
}
__device__ __forceinline__ void p8m_mlstm_out(const Ctx& c) {
    const bf16* Q = (const bf16*)(c.ws + WS_Q); const bf16* Kb = (const bf16*)(c.ws + WS_K); const bf16* Vb = (const bf16*)(c.ws + WS_V);
    const bf16* ACT = (const bf16*)(c.ws + WS_ACT); const bf16* Z = (const bf16*)(c.ws + WS_Z);
    const float* IG = (const float*)(c.ws + WS_IG); const float* LF = (const float*)(c.ws + WS_LF);
    const bf16* C0 = (const bf16*)(c.ws + WS_C0); const float* N0 = (const float*)(c.ws + WS_N0); const float* M0 = (const float*)(c.ws + WS_M0);
    const float* norm_w = inp(c, 20); const float* skip = inp(c, 21);
    bf16* A2 = (bf16*)(c.ws + WS_H);
    LAS unsigned char* L = (LAS unsigned char*)c.lds;
    LAS unsigned char* Qs = L; LAS unsigned char* Ks = L + TILE_B; LAS unsigned char* Vs = L + 2 * TILE_B; LAS unsigned char* Ss = L + 3 * TILE_B;
    LAS float* AR = (LAS float*)(L + 4 * TILE_B);
    LAS float* gs = AR; LAS float* Ms = AR + 256; LAS float* wis = AR + 512; LAS float* emt = AR + 768; LAS float* qns = AR + 1024; LAS float* n0s = AR + 1280;
    LAS float* nqp = AR + 1536;
    LAS float* cfs = AR + 2560; LAS float* cbs = AR + 2688; LAS float* rsum = AR + 2816; LAS float* rsq = AR + 2944; LAS float* tmp = AR + 3072;
    const int lane0 = c.lane, rt = c.wave >> 1, cg = c.wave & 1;
    v4u qr[4], kr[4], vr[4]; float lfv = 0.f, igv = 0.f, m0v = 0.f, n0v = 0.f;
#define P8_PREFETCH(IT) do { const int h_ = (IT) / NCL, ck_ = (IT) % NCL, r0_ = ck_ * CH; \
        _Pragma("unroll") for (int q = 0; q < 4; ++q) { const int e = c.tid + q * NTHREADS, l = e >> 4, ch = e & 15; const size_t go = (size_t)(r0_ + l) * DM + h_ * DH + ch * 8; \
            qr[q] = *(const v4u*)(Q + go); kr[q] = *(const v4u*)(Kb + go); vr[q] = *(const v4u*)(Vb + go); } \
        if (c.tid < 256) { const int dd = (c.tid >> 7) & 1, tt = c.tid & 127, sidx = dd ? (1 * 4 + h_) * NCL + (NCL - 1 - ck_) : (0 * 4 + h_) * NCL + ck_; \
            lfv = LF[(size_t)(dd * 4 + h_) * NT + r0_ + tt]; igv = IG[(size_t)(dd * 4 + h_) * NT + r0_ + tt]; m0v = M0[sidx]; n0v = N0[(size_t)sidx * 128 + tt]; } } while (0)
    if (c.bid < NH * NCL) P8_PREFETCH(c.bid);
    for (int it = c.bid; it < NH * NCL; it += c.G) {
        const int h = it / NCL, ck = it % NCL, r0 = ck * CH;
        int lane = lane0; asm volatile("" : "+v"(lane));
        const int fr = lane & 15, fg = lane >> 4;
#pragma unroll
        for (int q = 0; q < 4; ++q) {
            const int e = c.tid + q * NTHREADS, l = e >> 4, ch = e & 15;
            *(LAS v4u*)(Qs + l * TSB + ch * 16) = qr[q]; *(LAS v4u*)(Ks + l * TSB + ch * 16) = kr[q]; *(LAS v4u*)(Vs + l * TSB + ch * 16) = vr[q];
        }
        if (c.tid < 128) { rsum[c.tid] = 0.f; rsq[c.tid] = 0.f; }
        const int sidx_f = (0 * 4 + h) * NCL + ck, sidx_b = (1 * 4 + h) * NCL + (NCL - 1 - ck);
        {
            const int dd = (c.tid >> 7) & 1, tt = c.tid & 127;
            if (c.tid < 256) n0s[c.tid] = n0v;
            const float bt = scan256<false>(c.tid < 256 ? lfv : 0.f, tmp, lane, c.wave);
            const float gval = igv - bt;
            const float cm = scan256<true>(c.tid < 256 ? gval : -INFINITY, tmp, lane, c.wave);
            if (c.tid < 256) {
                const float M = fmaxf(m0v, cm);
                gs[c.tid] = gval; Ms[c.tid] = M; wis[c.tid] = __expf(m0v - M); emt[c.tid] = __expf(-(bt + M));
                float qn = 0.f;
#pragma unroll 4
                for (int k8 = 0; k8 < 16; ++k8) {
                    float qf[8]; unpack8(*(const LAS v4u*)(Qs + tt * TSB + k8 * 16), qf);
#pragma unroll
                    for (int u = 0; u < 8; ++u) qn += qf[u] * n0s[dd * 128 + k8 * 8 + u];
                }
                qns[c.tid] = qn;
            }
        }
        __syncthreads();
        f32x4 vf[2][4], vb[2][4];
        {
            f32x4 acc[2][4];
#pragma unroll
            for (int mt = 0; mt < 2; ++mt)
#pragma unroll
                for (int nt = 0; nt < 4; ++nt) acc[mt][nt] = (f32x4){0.f, 0.f, 0.f, 0.f};
#pragma unroll 1
            for (int ks = 0; ks < 4; ++ks) {
                h8 a[2], b[4];
#pragma unroll
                for (int mt = 0; mt < 2; ++mt) a[mt] = frag_row(Ks, TSB, 32 * rt + 16 * mt, 32 * ks, lane);
#pragma unroll
                for (int nt = 0; nt < 4; ++nt) b[nt] = frag_row(Qs, TSB, 64 * cg + 16 * nt, 32 * ks, lane);
#pragma unroll
                for (int mt = 0; mt < 2; ++mt)
#pragma unroll
                    for (int nt = 0; nt < 4; ++nt) acc[mt][nt] = MFMA16(a[mt], b[nt], acc[mt][nt]);
            }
#pragma unroll
            for (int nt = 0; nt < 4; ++nt) {
                const int t = 64 * cg + 16 * nt + fr; const float Mf = Ms[t], Mb = Ms[128 + t]; float csf = 0.f, csb = 0.f;
#pragma unroll
                for (int mt = 0; mt < 2; ++mt) {
                    const int s0 = 32 * rt + 16 * mt + 4 * fg;
#pragma unroll
                    for (int r = 0; r < 4; ++r) {
                        const int s = s0 + r; const float raw = acc[mt][nt][r];
                        const float wf = (s <= t) ? __expf(gs[s] - Mf) : 0.f, wb = (s >= t) ? __expf(gs[128 + s] - Mb) : 0.f;
                        vf[mt][nt][r] = raw * wf; vb[mt][nt][r] = raw * wb; csf += vf[mt][nt][r]; csb += vb[mt][nt][r];
                    }
                }
                csf += __shfl_xor(csf, 16); csf += __shfl_xor(csf, 32); csb += __shfl_xor(csb, 16); csb += __shfl_xor(csb, 32);
                if (fg == 0) { nqp[(0 * 4 + rt) * 128 + t] = csf; nqp[(1 * 4 + rt) * 128 + t] = csb; }
            }
        }
        __syncthreads();
        h8 bc[4][4];
        {
            const bf16* c0 = C0 + (size_t)sidx_f * 16384;
#pragma unroll
            for (int ks = 0; ks < 4; ++ks)
#pragma unroll
                for (int nt = 0; nt < 4; ++nt) bc[ks][nt] = *(const h8*)(c0 + (size_t)(64 * cg + 16 * nt + fr) * 128 + 32 * ks + 8 * fg);
        }
#pragma unroll
        for (int nt = 0; nt < 4; ++nt) {
            const int t = 64 * cg + 16 * nt + fr;
            const float wif = wis[t], wib = wis[128 + t];
            const float nqf = (nqp[t] + nqp[128 + t]) + (nqp[256 + t] + nqp[384 + t]) + wif * qns[t];
            const float nqb = (nqp[512 + t] + nqp[640 + t]) + (nqp[768 + t] + nqp[896 + t]) + wib * qns[128 + t];
            const float rdf = 1.f / fmaxf(fabsf(nqf), emt[t]), rdb = 1.f / fmaxf(fabsf(nqb), emt[128 + t]);
            if (rt == 0 && fg == 0) { cfs[t] = wif * rdf; cbs[t] = wib * rdb; }
#pragma unroll
            for (int mt = 0; mt < 2; ++mt) {
                const int s0 = 32 * rt + 16 * mt + 4 * fg; float p[4];
#pragma unroll
                for (int r = 0; r < 4; ++r) p[r] = vf[mt][nt][r] * rdf + vb[mt][nt][r] * rdb;
                v2u w; w.x = pk2(p[0], p[1]); w.y = pk2(p[2], p[3]);
                *(LAS v2u*)(Ss + t * TSB + s0 * 2) = w;
            }
        }
        __syncthreads();
        f32x4 hv[2][4];
        {
            f32x4 a1[2][4], a2[2][4];
#pragma unroll
            for (int mt = 0; mt < 2; ++mt)
#pragma unroll
                for (int nt = 0; nt < 4; ++nt) { a1[mt][nt] = (f32x4){0.f, 0.f, 0.f, 0.f}; a2[mt][nt] = (f32x4){0.f, 0.f, 0.f, 0.f}; }
#pragma unroll
            for (int ks = 0; ks < 4; ++ks) {
                h8 as_[2], aq[2], bv[4];
#pragma unroll
                for (int mt = 0; mt < 2; ++mt) { as_[mt] = frag_row(Ss, TSB, 32 * rt + 16 * mt, 32 * ks, lane); aq[mt] = frag_row(Qs, TSB, 32 * rt + 16 * mt, 32 * ks, lane); }
#pragma unroll
                for (int nt = 0; nt < 4; ++nt) bv[nt] = frag_tr(Vs, TSB, 32 * ks, 64 * cg + 16 * nt, lane);
#pragma unroll
                for (int mt = 0; mt < 2; ++mt)
#pragma unroll
                    for (int nt = 0; nt < 4; ++nt) { a1[mt][nt] = MFMA16(as_[mt], bv[nt], a1[mt][nt]); a2[mt][nt] = MFMA16(aq[mt], bc[ks][nt], a2[mt][nt]); }
            }
            {
                const bf16* c0 = C0 + (size_t)sidx_b * 16384;
#pragma unroll
                for (int ks = 0; ks < 4; ++ks)
#pragma unroll
                    for (int nt = 0; nt < 4; ++nt) bc[ks][nt] = *(const h8*)(c0 + (size_t)(64 * cg + 16 * nt + fr) * 128 + 32 * ks + 8 * fg);
            }
#pragma unroll
            for (int mt = 0; mt < 2; ++mt)
#pragma unroll
                for (int r = 0; r < 4; ++r) {
                    const float cf = cfs[32 * rt + 16 * mt + 4 * fg + r];
#pragma unroll
                    for (int nt = 0; nt < 4; ++nt) { hv[mt][nt][r] = a1[mt][nt][r] + cf * a2[mt][nt][r]; a2[mt][nt][r] = 0.f; }
                }
#pragma unroll
            for (int ks = 0; ks < 4; ++ks) {
                h8 aq[2];
#pragma unroll
                for (int mt = 0; mt < 2; ++mt) aq[mt] = frag_row(Qs, TSB, 32 * rt + 16 * mt, 32 * ks, lane);
#pragma unroll
                for (int mt = 0; mt < 2; ++mt)
#pragma unroll
                    for (int nt = 0; nt < 4; ++nt) a2[mt][nt] = MFMA16(aq[mt], bc[ks][nt], a2[mt][nt]);
            }
#pragma unroll
            for (int mt = 0; mt < 2; ++mt)
#pragma unroll
                for (int r = 0; r < 4; ++r) {
                    const float cb = cbs[32 * rt + 16 * mt + 4 * fg + r];
#pragma unroll
                    for (int nt = 0; nt < 4; ++nt) hv[mt][nt][r] += cb * a2[mt][nt][r];
                }
        }
        __syncthreads();
        { const int nit = it + c.G < NH * NCL ? it + c.G : it; P8_PREFETCH(nit); }
#pragma unroll
        for (int mt = 0; mt < 2; ++mt)
#pragma unroll
            for (int r = 0; r < 4; ++r) {
                const int t = 32 * rt + 16 * mt + 4 * fg + r; float s1 = 0.f, s2 = 0.f;
#pragma unroll
                for (int nt = 0; nt < 4; ++nt) { const float x = hv[mt][nt][r]; s1 += x; s2 += x * x; *(LAS bf16*)(Ss + t * TSB + (64 * cg + 16 * nt + fr) * 2) = (bf16)f2bf(x); }
#pragma unroll
                for (int o = 1; o < 16; o <<= 1) { s1 += __shfl_xor(s1, o); s2 += __shfl_xor(s2, o); }
                if (fr == 0) { lds_atomic_add(rsum + t, s1); lds_atomic_add(rsq + t, s2); }
            }
        __syncthreads();
        const f32x4 nw0 = *(const f32x4*)(norm_w + h * DH + (c.tid & 15) * 8), nw1 = *(const f32x4*)(norm_w + h * DH + (c.tid & 15) * 8 + 4);
        const f32x4 sk0 = *(const f32x4*)(skip + h * DH + (c.tid & 15) * 8), sk1 = *(const f32x4*)(skip + h * DH + (c.tid & 15) * 8 + 4);
        const float nwv[8] = {nw0[0], nw0[1], nw0[2], nw0[3], nw1[0], nw1[1], nw1[2], nw1[3]}, skv[8] = {sk0[0], sk0[1], sk0[2], sk0[3], sk1[0], sk1[1], sk1[2], sk1[3]};
#pragma unroll
        for (int q = 0; q < 4; ++q) {
            const int e = c.tid + q * NTHREADS;
            const int t = e >> 4, ch = e & 15, col0 = h * DH + ch * 8; const size_t row = (size_t)(r0 + t);
            const float mu = rsum[t] * (1.f / 128.f), var = fmaxf(rsq[t] * (1.f / 128.f) - mu * mu, 0.f), rstd = rsqrtf(var + EPS);
            float hf[8], af[8], zf[8], o[8];
            unpack8(*(const LAS v4u*)(Ss + t * TSB + ch * 16), hf); unpack8(*(const v4u*)(ACT + row * DM + col0), af); unpack8(*(const v4u*)(Z + row * DM + col0), zf);
#pragma unroll
            for (int u = 0; u < 8; ++u) { const float hn = (hf[u] - mu) * rstd * nwv[u]; o[u] = (hn + skv[u] * af[u]) * siluf(zf[u]); }
            v4u w; w.x = pk2(o[0], o[1]); w.y = pk2(o[2], o[3]); w.z = pk2(o[4], o[5]); w.w = pk2(o[6], o[7]);
            *(v4u*)(A2 + row * D + col0) = w;
        }
        __syncthreads();
    }
#undef P8_PREFETCH
}

__device__ __forceinline__ void p6m_fourier_a(const Ctx& c) {
    const bf16* U = (const bf16*)(c.ws + WS_U); bf16* FB = (bf16*)c.out;
    LAS unsigned char* L = (LAS unsigned char*)c.lds; LAS unsigned char* Ws = L; LAS unsigned char* Us = L + 256 * TSB;
    constexpr int USB = 544;
    const int lane = c.lane, rt = c.wave >> 1, cg = c.wave & 1, fr = lane & 15, fg = lane >> 4;
    {
        const bf16* dw = (const bf16*)(c.ws + WS_DFTW);
        for (int e = c.tid; e < 256 * 16; e += NTHREADS) { const int row = e >> 4, ch = e & 15; *(LAS v4u*)(Ws + row * TSB + ch * 16) = *(const v4u*)(dw + row * 128 + ch * 8); }
    }
    __syncthreads();
    for (int it = c.bid; it < 256; it += c.G) {
        const int t2 = it >> 1, nh = it & 1;
        for (int e = c.tid; e < 128 * 32; e += NTHREADS) {
            const int t1 = e >> 5, ch = e & 31;
            *(LAS v4u*)(Us + t1 * USB + ch * 16) = *(const v4u*)(U + (size_t)(128 * t1 + t2) * DM + 256 * nh + ch * 8);
        }
        __syncthreads();
#pragma unroll 1
        for (int np = 0; np < 2; ++np) {
            f32x4 acc[4][4];
#pragma unroll
            for (int mt = 0; mt < 4; ++mt)
#pragma unroll
                for (int nt = 0; nt < 4; ++nt) acc[mt][nt] = (f32x4){0.f, 0.f, 0.f, 0.f};
            const int n0 = 128 * cg + 64 * np;
#pragma unroll 1
            for (int ks = 0; ks < 4; ++ks) {
                h8 a[4], b[4];
#pragma unroll
                for (int mt = 0; mt < 4; ++mt) a[mt] = frag_row(Ws, TSB, 64 * rt + 16 * mt, 32 * ks, lane);
#pragma unroll
                for (int nt = 0; nt < 4; ++nt) b[nt] = frag_tr(Us, USB, 32 * ks, n0 + 16 * nt, lane);
#pragma unroll
                for (int mt = 0; mt < 4; ++mt)
#pragma unroll
                    for (int nt = 0; nt < 4; ++nt) acc[mt][nt] = MFMA16(a[mt], b[nt], acc[mt][nt]);
            }
#pragma unroll
            for (int pi = 0; pi < 2; ++pi)
#pragma unroll
                for (int r = 0; r < 4; ++r) {
                    const int k1 = 16 * (2 * rt + pi) + 4 * fg + r;
                    const float rev = (float)(k1 * t2) * (1.f / 16384.f); const float tc = __builtin_amdgcn_cosf(rev), ts = __builtin_amdgcn_sinf(rev);
                    bf16* dr = FB + ((size_t)(k1 * 128 + t2) * 2) * 512 + 256 * nh + n0 + fr; bf16* di = dr + 512;
#pragma unroll
                    for (int nt = 0; nt < 4; ++nt) {
                        const float ar = acc[2 * pi][nt][r], ai = acc[2 * pi + 1][nt][r];
                        dr[16 * nt] = (bf16)f2bf(ar * tc + ai * ts); di[16 * nt] = (bf16)f2bf(ai * tc - ar * ts);
                    }
                }
        }
        __syncthreads();
    }
}

__device__ __forceinline__ void p7m_fourier_c(const Ctx& c) {
    const bf16* FB = (const bf16*)c.out; const bf16* Gt = (const bf16*)(c.ws + WS_G); bf16* A2 = (bf16*)(c.ws + WS_H);
    LAS unsigned char* L = (LAS unsigned char*)c.lds; LAS unsigned char* Cs = L; LAS unsigned char* Sn = L + TILE_B; LAS unsigned char* BrS = L + 2 * TILE_B; LAS unsigned char* BiS = L + 3 * TILE_B;
    const int lane = c.lane, rt = c.wave >> 1, cg = c.wave & 1, fr = lane & 15, fg = lane >> 4;
    {
        const bf16* dw = (const bf16*)(c.ws + WS_DFTW) + 256 * 128;
        for (int e = c.tid; e < 2 * 128 * 16; e += NTHREADS) { const int which = e >> 11, row = (e >> 4) & 127, ch = e & 15; *(LAS v4u*)((which ? Sn : Cs) + row * TSB + ch * 16) = *(const v4u*)(dw + which * 16384 + row * 128 + ch * 8); }
    }
    __syncthreads();
    for (int it = c.bid; it < 128 * 4; it += c.G) {
        const int k1 = it >> 2, g = it & 3;
        for (int e = c.tid; e < 128 * 32; e += NTHREADS) {
            const int t2 = e >> 5, ri = (e >> 4) & 1, ch = e & 15;
            *(LAS v4u*)((ri ? BiS : BrS) + t2 * TSB + ch * 16) = *(const v4u*)(FB + ((size_t)(k1 * 128 + t2) * 2 + ri) * 512 + g * 128 + ch * 8);
        }
        __syncthreads();
        h8 gb[4][4];
        {
            f32x4 xr[2][4], xi[2][4];
#pragma unroll
            for (int mt = 0; mt < 2; ++mt)
#pragma unroll
                for (int nt = 0; nt < 4; ++nt) { xr[mt][nt] = (f32x4){0.f, 0.f, 0.f, 0.f}; xi[mt][nt] = (f32x4){0.f, 0.f, 0.f, 0.f}; }
#pragma unroll 1
            for (int ks = 0; ks < 4; ++ks) {
                h8 ar[2], ai[2], an[2], bc[4], bs[4];
#pragma unroll
                for (int mt = 0; mt < 2; ++mt) {
                    ar[mt] = frag_tr(BrS, TSB, 32 * ks, 32 * rt + 16 * mt, lane); ai[mt] = frag_tr(BiS, TSB, 32 * ks, 32 * rt + 16 * mt, lane);
                    an[mt] = ar[mt] ^ (short)0x8000;
                }
#pragma unroll
                for (int nt = 0; nt < 4; ++nt) { bc[nt] = frag_row(Cs, TSB, 64 * cg + 16 * nt, 32 * ks, lane); bs[nt] = frag_row(Sn, TSB, 64 * cg + 16 * nt, 32 * ks, lane); }
#pragma unroll
                for (int mt = 0; mt < 2; ++mt)
#pragma unroll
                    for (int nt = 0; nt < 4; ++nt) {
                        xr[mt][nt] = MFMA16(ar[mt], bc[nt], xr[mt][nt]); xr[mt][nt] = MFMA16(ai[mt], bs[nt], xr[mt][nt]);
                        xi[mt][nt] = MFMA16(ai[mt], bc[nt], xi[mt][nt]); xi[mt][nt] = MFMA16(an[mt], bs[nt], xi[mt][nt]);
                    }
            }
            const bf16* gt = Gt + (size_t)g * 128 * 256;
#pragma unroll
            for (int ks = 0; ks < 4; ++ks)
#pragma unroll
                for (int nt = 0; nt < 4; ++nt) gb[ks][nt] = *(const h8*)(gt + (size_t)(64 * cg + 16 * nt + fr) * 256 + 32 * ks + 8 * fg);
            __syncthreads();
#pragma unroll
            for (int mt = 0; mt < 2; ++mt)
#pragma unroll
                for (int nt = 0; nt < 4; ++nt) {
                    const int k2 = 64 * cg + 16 * nt + fr, c0 = 32 * rt + 16 * mt + 4 * fg;
                    v2u w; w.x = pk2(xr[mt][nt][0], xr[mt][nt][1]); w.y = pk2(xr[mt][nt][2], xr[mt][nt][3]); *(LAS v2u*)(BrS + k2 * TSB + c0 * 2) = w;
                    w.x = pk2(xi[mt][nt][0], xi[mt][nt][1]); w.y = pk2(xi[mt][nt][2], xi[mt][nt][3]); *(LAS v2u*)(BiS + k2 * TSB + c0 * 2) = w;
                }
        }
        __syncthreads();
        {
            f32x4 acc[2][4];
#pragma unroll
            for (int mt = 0; mt < 2; ++mt)
#pragma unroll
                for (int nt = 0; nt < 4; ++nt) acc[mt][nt] = (f32x4){0.f, 0.f, 0.f, 0.f};
            const bf16* gt = Gt + (size_t)g * 128 * 256;
            h8 gb2[4][4];
#pragma unroll
            for (int ks = 0; ks < 4; ++ks)
#pragma unroll
                for (int nt = 0; nt < 4; ++nt) gb2[ks][nt] = *(const h8*)(gt + (size_t)(64 * cg + 16 * nt + fr) * 256 + 32 * (ks + 4) + 8 * fg);
#pragma unroll
            for (int ks = 0; ks < 4; ++ks) {
                h8 a[2];
#pragma unroll
                for (int mt = 0; mt < 2; ++mt) a[mt] = frag_row(BrS, TSB, 32 * rt + 16 * mt, 32 * ks, lane);
#pragma unroll
                for (int mt = 0; mt < 2; ++mt)
#pragma unroll
                    for (int nt = 0; nt < 4; ++nt) acc[mt][nt] = MFMA16(a[mt], gb[ks][nt], acc[mt][nt]);
            }
#pragma unroll
            for (int ks = 0; ks < 4; ++ks) {
                h8 a[2];
#pragma unroll
                for (int mt = 0; mt < 2; ++mt) a[mt] = frag_row(BiS, TSB, 32 * rt + 16 * mt, 32 * ks, lane);
#pragma unroll
                for (int mt = 0; mt < 2; ++mt)
#pragma unroll
                    for (int nt = 0; nt < 4; ++nt) acc[mt][nt] = MFMA16(a[mt], gb2[ks][nt], acc[mt][nt]);
            }
            __syncthreads();
#pragma unroll
            for (int mt = 0; mt < 2; ++mt)
#pragma unroll
                for (int r = 0; r < 4; ++r) {
                    const int k2 = 32 * rt + 16 * mt + 4 * fg + r;
#pragma unroll
                    for (int nt = 0; nt < 4; ++nt) *(LAS bf16*)(BrS + k2 * TSB + (64 * cg + 16 * nt + fr) * 2) = (bf16)f2bf(acc[mt][nt][r]);
                }
        }
        __syncthreads();
        for (int e = c.tid; e < 128 * 16; e += NTHREADS) { const int k2 = e >> 4, ch = e & 15; *(v4u*)(A2 + (size_t)(k1 + 128 * k2) * D + 512 + g * 128 + ch * 8) = *(const LAS v4u*)(BrS + k2 * TSB + ch * 16); }
        __syncthreads();
    }
}

#define XB_TMO      128
#define XB_XCNT(j)  (256  + 64 * (j))
#define XB_XSUB(j)  (1280 + 64 * (j))
#define XB_XGEN(j)  (2304 + 64 * (j))
#define XB_TOP      3328
#define XB_TOPGEN   3392
#define XCD_BAR_WORDS 3456
#define XB_SPIN_CAP (1u << 18)
__device__ __forceinline__ unsigned xb_ld(unsigned* p)              { return __hip_atomic_load(p, __ATOMIC_RELAXED, __HIP_MEMORY_SCOPE_AGENT); }
__device__ __forceinline__ unsigned xb_add(unsigned* p, unsigned v) { return __hip_atomic_fetch_add(p, v, __ATOMIC_RELAXED, __HIP_MEMORY_SCOPE_AGENT); }
__device__ __forceinline__ unsigned xb_xcc_id() { return (unsigned)__builtin_amdgcn_s_getreg((3 << 11) | 20) & 0xFu; }
#define XB_SPIN(cond, bar) do { unsigned _sp = 0; while (cond) { __builtin_amdgcn_s_sleep(1); \
    if ((++_sp & 255u) == 0u) { if (xb_ld(&(bar)[XB_TMO])) break; if (_sp > XB_SPIN_CAP) { atomicAdd(&(bar)[XB_TMO], 1u); break; } } } } while (0)
struct XcdBarrier { unsigned* bar; unsigned x; volatile LAS unsigned* st; };
__device__ __forceinline__ XcdBarrier xcd_barrier_post(unsigned* bar, volatile LAS unsigned* st) {
    XcdBarrier b; b.bar = bar; b.x = xb_xcc_id(); b.st = st;
    if (threadIdx.x == 0) (void)xb_add(&bar[XB_XCNT(b.x)], 1u);
    return b;
}
__device__ __forceinline__ void xcd_barrier_complete(unsigned* bar, unsigned x, unsigned& nloc, unsigned& nx) {
    const unsigned G = gridDim.x * gridDim.y * gridDim.z;
    unsigned sum, cnt, mine, sp = 0u;
    for (;;) {
        sum = 0u; cnt = 0u; mine = 0u;
#pragma unroll
        for (unsigned j = 0; j < 16; ++j) { const unsigned c = xb_ld(&bar[XB_XCNT(j)]); sum += c; cnt += (c > 0u) ? 1u : 0u; mine = (j == x) ? c : mine; }
        if (sum == G) break;
        __builtin_amdgcn_s_sleep(1);
        if ((++sp & 255u) == 0u) { if (xb_ld(&bar[XB_TMO])) break; if (sp > XB_SPIN_CAP) { atomicAdd(&bar[XB_TMO], 1u); break; } }
    }
    nloc = mine > 0u ? mine : 1u; nx = cnt > 0u ? cnt : 1u;
}
__device__ __forceinline__ void xcd_barrier(const XcdBarrier& b) {
    asm volatile("s_waitcnt vmcnt(0)" ::: "memory");
    __syncthreads();
    if (threadIdx.x == 0) {
        unsigned* bar = b.bar;
        __builtin_amdgcn_s_waitcnt(0);
        unsigned nloc = b.st[0], nx = b.st[1];
        if (nloc == 0u) { xcd_barrier_complete(bar, b.x, nloc, nx); b.st[0] = nloc; b.st[1] = nx; }
        const unsigned old = xb_add(&bar[XB_XSUB(b.x)], 1u);
        const unsigned gen = old / nloc;
        if (old + 1u == (gen + 1u) * nloc) {
            __builtin_amdgcn_fence(__ATOMIC_RELEASE, "agent");
            asm volatile("s_waitcnt vmcnt(0)" ::: "memory");
            const unsigned og = xb_add(&bar[XB_TOP], 1u);
            const unsigned tg = og / nx;
            if (og + 1u == (tg + 1u) * nx) xb_add(&bar[XB_TOPGEN], 1u);
            else XB_SPIN(xb_ld(&bar[XB_TOPGEN]) == tg, bar);
            __builtin_amdgcn_fence(__ATOMIC_ACQUIRE, "agent");
            xb_add(&bar[XB_XGEN(b.x)], 1u);
            asm volatile("s_waitcnt vmcnt(0)" ::: "memory");
        } else {
            XB_SPIN(xb_ld(&bar[XB_XGEN(b.x)]) == gen, bar);
            __builtin_amdgcn_fence(__ATOMIC_ACQUIRE, "agent");
            asm volatile("s_waitcnt vmcnt(0)" ::: "memory");
        }
    }
    __syncthreads();
}

#ifndef MK_CG_SYNC
#define MK_CG_SYNC 0
#endif
constexpr int MISC_OFF = LDS_BYTES - 256;
constexpr int TAB_OFF = LDS_BYTES - 1024;
__global__ void __launch_bounds__(NTHREADS, 2) fwd_kernel(Args a) {
    extern __shared__ __attribute__((aligned(16))) unsigned char lds_raw[];
    Ctx c;
    c.tid = threadIdx.x; c.lane = c.tid & 63; c.wave = __builtin_amdgcn_readfirstlane(c.tid >> 6);
    c.G = gridDim.x; c.bid = blockIdx.x; c.gw = c.bid * NWAVES + c.wave; c.NGW = c.G * NWAVES; c.gtid = c.bid * NTHREADS + c.tid; c.NTHR = c.G * NTHREADS;
    c.lds = (float*)lds_raw;
    {
        volatile LAS unsigned* tabw = (volatile LAS unsigned*)((LAS unsigned char*)lds_raw + TAB_OFF);
        if (c.tid == 0) {
#define PUT(i, p) do { tabw[2 * (i)] = (unsigned)(size_t)(p); tabw[2 * (i) + 1] = (unsigned)((size_t)(p) >> 32); } while (0)
            PUT(0, a.in[0]); PUT(1, a.in[1]); PUT(2, a.in[2]); PUT(3, a.in[3]); PUT(4, a.in[4]); PUT(5, a.in[5]); PUT(6, a.in[6]); PUT(7, a.in[7]);
            PUT(8, a.in[8]); PUT(9, a.in[9]); PUT(10, a.in[10]); PUT(11, a.in[11]); PUT(12, a.in[12]); PUT(13, a.in[13]); PUT(14, a.in[14]); PUT(15, a.in[15]);
            PUT(16, a.in[16]); PUT(17, a.in[17]); PUT(18, a.in[18]); PUT(19, a.in[19]); PUT(20, a.in[20]); PUT(21, a.in[21]); PUT(22, a.in[22]); PUT(23, a.in[23]);
            PUT(24, a.in[24]); PUT(25, a.in[25]); PUT(26, a.in[26]); PUT(27, a.in[27]); PUT(28, a.in[28]); PUT(29, a.in[29]); PUT(30, a.in[30]); PUT(31, a.ws); PUT(32, a.out);
#undef PUT
        }
        c.tab = tabw; c.ws = a.ws; c.out = a.out;
    }
    __syncthreads();
#if MK_CG_SYNC
    cooperative_groups::grid_group grid = cooperative_groups::this_grid();
#define GRID_BAR_RAW() do { grid.sync(); } while (0)
#else
    volatile LAS unsigned* misc = (volatile LAS unsigned*)((LAS unsigned char*)lds_raw + MISC_OFF);
    if (c.tid < 64) misc[c.tid] = 0u;
    __syncthreads();
    const XcdBarrier bar = xcd_barrier_post((unsigned*)(a.ws + WS_CTL) + 4096, misc + 8);
#define GRID_BAR_RAW() do { xcd_barrier(bar); } while (0)
#endif
#ifndef PROBE_IV
#define PROBE_IV (-1)
#endif
    unsigned long long pr_last = 0; int pr_iv = 0;
    if (PROBE_IV >= 0) pr_last = __builtin_amdgcn_s_memrealtime();
#define GRID_BAR() do { GRID_BAR_RAW(); if (PROBE_IV >= 0) { if (blockIdx.x == 0 && threadIdx.x == 0) { const unsigned long long now = __builtin_amdgcn_s_memrealtime(); \
        if (pr_iv == PROBE_IV) { const unsigned long long until = now + 8ull * (now - pr_last); while (__builtin_amdgcn_s_memrealtime() < until) __builtin_amdgcn_s_sleep(32); } } \
        pr_last = __builtin_amdgcn_s_memrealtime(); ++pr_iv; } } while (0)
    volatile LAS int* ts = (volatile LAS int*)((LAS unsigned char*)lds_raw + MISC_OFF) + 16;
#ifndef DUP_MASK
#define DUP_MASK 0
#endif
#define DUP(bit, stmt) do { if (DUP_MASK & (1 << (bit))) { GRID_BAR(); stmt; } } while (0)
    p0_prologue(fresh(c)); conv_small_weights(fresh(c));   GRID_BAR();
    p1_hrows(fresh(c));               GRID_BAR();
    DUP(1, p0_prologue(fresh(c)); conv_small_weights(fresh(c)); GRID_BAR(); p1_hrows(fresh(c)); GRID_BAR());
    g1_gemm1(fresh(c));
    { constexpr int B2 = (NT / 256) * (DIN / 256) - 256;
      if ((int)blockIdx.x >= B2 && (int)gridDim.x == 256) conv_moe_down(fresh(c), B2 * NWAVES, (256 - B2) * NWAVES);
      else if ((int)gridDim.x != 256) conv_moe_down(fresh(c), 0, c.NGW); }
    GRID_BAR();
    DUP(0, g1_gemm1(fresh(c)); GRID_BAR());
    p3_features(fresh(c)); p6m_fourier_a(fresh(c));  GRID_BAR();
    DUP(6, p3_features(fresh(c)); GRID_BAR());
    DUP(4, p6m_fourier_a(fresh(c)); GRID_BAR());
    p4m_summaries(fresh(c));          GRID_BAR();
    DUP(3, p4m_summaries(fresh(c)); GRID_BAR());
    p5_scan(fresh(c)); p7m_fourier_c(fresh(c));      GRID_BAR();
    DUP(2, p5_scan(fresh(c)); GRID_BAR());
    DUP(4, p7m_fourier_c(fresh(c)); GRID_BAR());
    p8m_mlstm_out(fresh(c)); conv_moe_gu(fresh(c));   GRID_BAR();
    DUP(7, p8m_mlstm_out(fresh(c)); GRID_BAR());
    DUP(5, conv_moe_gu(fresh(c)); GRID_BAR());
    g2_outproj(fresh(c));             GRID_BAR();
    DUP(0, g2_outproj(fresh(c)); GRID_BAR());
    p10b_token(fresh(c));             GRID_BAR();
    g3_moe_up(fresh(c), ts);          GRID_BAR();
    DUP(0, g3_moe_up(fresh(c), ts); GRID_BAR());
    g4_moe_down(fresh(c), ts);        GRID_BAR();
    DUP(0, g4_moe_down(fresh(c), ts); GRID_BAR());
    DUP(8, GRID_BAR(); GRID_BAR(); GRID_BAR(); GRID_BAR(); GRID_BAR(); GRID_BAR(); GRID_BAR());
    p12b_final(fresh(c));
}

extern "C" void kernel_launch(void* const* d_in, const int* in_sizes, int n_in, void* d_out, int out_size, void* d_ws, size_t ws_size, hipStream_t stream) {
    static int grid = 0;
    if (grid == 0) {
        if (n_in != 31 || out_size != T * D || ws_size < 256 * MiB) { fprintf(stderr, "kernel_launch: unexpected shapes n_in %d out %d ws %zu\n", n_in, out_size, ws_size); grid = -1; return; }
        int dev = 0, cus = 0, per_cu = 0;
        (void)hipGetDevice(&dev); (void)hipDeviceGetAttribute(&cus, hipDeviceAttributeMultiprocessorCount, dev);
        if (hipFuncSetAttribute((const void*)fwd_kernel, hipFuncAttributeMaxDynamicSharedMemorySize, LDS_BYTES) != hipSuccess) { fprintf(stderr, "kernel_launch: hipFuncSetAttribute failed\n"); grid = -1; return; }
        if (hipOccupancyMaxActiveBlocksPerMultiprocessor(&per_cu, (const void*)fwd_kernel, NTHREADS, LDS_BYTES) != hipSuccess || per_cu < 1) { fprintf(stderr, "kernel_launch: occupancy query says %d blocks per CU\n", per_cu); (void)hipGetLastError(); per_cu = 1; }
        grid = (cus > 0 ? cus : 256);
        fprintf(stderr, "kernel_launch: cus %d occupancy %d grid %d\n", cus, per_cu, grid);
    }
    if (grid < 0) return;
    (void)hipMemsetAsync((char*)d_ws + WS_CTL, 0, 65536, stream);
    Args a{};
    for (int i = 0; i < 31; ++i) a.in[i] = (const float*)d_in[i];
    a.out = (float*)d_out; a.ws = (unsigned char*)d_ws; a.ph_lo = 0; a.ph_hi = 0;
    void* kargs[] = {&a};
    hipError_t e = hipLaunchCooperativeKernel((const void*)fwd_kernel, dim3(grid), dim3(NTHREADS), kargs, LDS_BYTES, stream);
    if (e != hipSuccess) fprintf(stderr, "kernel_launch: cooperative launch failed: %s (grid %d)\n", hipGetErrorString(e), grid);
}
```
